# Optimizing an MI355X kernel written in HIP

```python
import jax
import jax.numpy as jnp
from jax import lax
import numpy as np

D_MODEL = 4096
BATCH = 2
SEQ = 4096
DEPTH = 1
DEC_BATCH = 32
DEC_SEQ = 64
PAST_LEN = 4096

CHUNK = 64
MIX_WIDTH = D_MODEL
ATTN_WIDTH = MIX_WIDTH // 2
RET_WIDTH = MIX_WIDTH - ATTN_WIDTH
HEAD_DIM = 64
N_HEADS = ATTN_WIDTH // HEAD_DIM
N_KV_HEADS = 4
GROUP = N_HEADS // N_KV_HEADS
WINDOW = 128
WINDOW_CHUNKS = WINDOW // CHUNK
RET_HEADS = 8
RET_DV = RET_WIDTH // RET_HEADS
RET_DK = RET_DV // 2
ROPE_BASE = 10000.0
D_FF = 256 * ((8 * D_MODEL // 3 + 255) // 256)
PLE_DIM = 256
EPS = 1e-6

ATTN_Q_COLS = N_HEADS * HEAD_DIM
ATTN_KV_COLS = N_KV_HEADS * HEAD_DIM
RET_QK_COLS = RET_HEADS * RET_DK
SPLIT_POINTS = (
    ATTN_Q_COLS,
    ATTN_Q_COLS + ATTN_KV_COLS,
    ATTN_Q_COLS + 2 * ATTN_KV_COLS,
    ATTN_Q_COLS + 2 * ATTN_KV_COLS + RET_QK_COLS,
    ATTN_Q_COLS + 2 * ATTN_KV_COLS + 2 * RET_QK_COLS,
    ATTN_Q_COLS + 2 * ATTN_KV_COLS + 2 * RET_QK_COLS + RET_WIDTH,
)
IN_WIDTH = ATTN_Q_COLS + 2 * ATTN_KV_COLS + 2 * RET_QK_COLS + 2 * RET_WIDTH

kernel_name = "hymba_swa_sink_retention_macaron_ple_stream_step"


def rmsnorm(x, g):
    xf = x.astype(jnp.float32)
    y = xf * lax.rsqrt(jnp.mean(xf * xf, axis=-1, keepdims=True) + EPS)
    return (y * g.astype(jnp.float32)).astype(x.dtype)


def swiglu_half_step(h, g, w_gate, w_up, w_down):
    z = rmsnorm(h, g)
    return h + 0.5 * ((jax.nn.silu(z @ w_gate) * (z @ w_up)) @ w_down)


def ple_add(h, p, g, w_gate, w_proj):
    gate = jax.nn.sigmoid(rmsnorm(h, g) @ w_gate)
    return h + gate * (p @ w_proj)


def rotary(x, pos):
    half = x.shape[-1] // 2
    inv_freq = ROPE_BASE ** (-jnp.arange(half, dtype=jnp.float32) / half)
    ang = pos[:, None] * inv_freq[None, :]
    cos = jnp.cos(ang)[:, None, :]
    sin = jnp.sin(ang)[:, None, :]
    x1, x2 = x[..., :half], x[..., half:]
    return jnp.concatenate([x1 * cos - x2 * sin, x2 * cos + x1 * sin], axis=-1)


def retention_log_decay():
    return jnp.log(1.0 - 2.0 ** (-5.0 - jnp.arange(RET_HEADS, dtype=jnp.float32)))


def mixer_project(z, pos, w_in, g_q, g_k):
    B, L = z.shape[0], z.shape[1]
    qa, ka, va, qr, kr, vr, gr = jnp.split(z @ w_in, SPLIT_POINTS, axis=-1)
    qa = rmsnorm(qa.reshape(B, L, N_HEADS, HEAD_DIM), g_q)
    ka = rmsnorm(ka.reshape(B, L, N_KV_HEADS, HEAD_DIM), g_k)
    va = va.reshape(B, L, N_KV_HEADS, HEAD_DIM)
    qr = rotary(qr.reshape(B, L, RET_HEADS, RET_DK).astype(jnp.float32), pos)
    kr = rotary(kr.reshape(B, L, RET_HEADS, RET_DK).astype(jnp.float32), pos) * (RET_DK ** -0.5)
    vr = vr.reshape(B, L, RET_HEADS, RET_DV).astype(jnp.float32)
    return qa, ka, va, qr, kr, vr, gr


def sink_attend(q, k, v, sinks, mask):
    scores = jnp.einsum("...qkgd,...tkd->...kgqt", q, k).astype(jnp.float32) * (HEAD_DIM ** -0.5)
    if mask is not None:
        scores = jnp.where(mask, scores, -jnp.inf)
    sink = sinks.astype(jnp.float32).reshape(N_KV_HEADS, GROUP, 1, 1)
    m = jnp.maximum(scores.max(axis=-1, keepdims=True), sink)
    e = jnp.exp(scores - m)
    probs = e / (e.sum(axis=-1, keepdims=True) + jnp.exp(sink - m))
    return jnp.einsum("...kgqt,...tkd->...qkgd", probs.astype(v.dtype), v)


def attn_prompt(q, k, v, sinks):
    B, S = q.shape[0], q.shape[1]
    n_chunks = S // CHUNK
    qb = q.reshape(B, n_chunks, CHUNK, N_KV_HEADS, GROUP, HEAD_DIM)
    pad = ((0, 0), (WINDOW, 0), (0, 0), (0, 0))
    kp = jnp.pad(k, pad).reshape(B, n_chunks + WINDOW_CHUNKS, CHUNK, N_KV_HEADS, HEAD_DIM)
    vp = jnp.pad(v, pad).reshape(B, n_chunks + WINDOW_CHUNKS, CHUNK, N_KV_HEADS, HEAD_DIM)
    kb = jnp.concatenate([kp[:, j:j + n_chunks] for j in range(WINDOW_CHUNKS + 1)], axis=2)
    vb = jnp.concatenate([vp[:, j:j + n_chunks] for j in range(WINDOW_CHUNKS + 1)], axis=2)
    c = jnp.arange(n_chunks)[:, None]
    j = jnp.arange((WINDOW_CHUNKS + 1) * CHUNK)[None, :]
    valid = (c + j // CHUNK) >= WINDOW_CHUNKS
    mask = valid[:, None, None, None, :]
    o = sink_attend(qb, kb, vb, sinks, mask)
    return o.reshape(B, S, ATTN_WIDTH)


def retention_block(state, q, k, v, log_gamma):
    L = q.shape[1]
    idx = jnp.arange(L, dtype=jnp.float32)
    decay = jnp.exp(log_gamma[:, None, None] * jnp.abs(idx[:, None] - idx[None, :]))
    scores = jnp.einsum("blhd,bmhd->bhlm", q, k) * decay[None]
    out = jnp.einsum("bhlm,bmhv->blhv", scores, v)
    q_decay = jnp.exp(log_gamma[None, :] * (idx[:, None] + 1.0))
    out = out + jnp.einsum("blhd,bhdv->blhv", q, state) * q_decay[None, :, :, None]
    k_decay = jnp.exp(log_gamma[None, :] * (L - 1.0 - idx)[:, None])
    new_state = (jnp.exp(log_gamma * L)[None, :, None, None] * state
                 + jnp.einsum("blhd,blhv->bhdv", k * k_decay[None, :, :, None], v))
    return out, new_state


def retention_prompt(q, k, v, log_gamma):
    B, S = q.shape[0], q.shape[1]
    n_chunks = S // CHUNK

    def to_chunks(a):
        return jnp.swapaxes(a.reshape((B, n_chunks, CHUNK) + a.shape[2:]), 0, 1)

    state0 = jnp.zeros((B, RET_HEADS, RET_DK, RET_DV), jnp.float32)

    def step(state, xs):
        qc, kc, vc = xs
        out, state = retention_block(state, qc, kc, vc, log_gamma)
        return state, out

    state, out = lax.scan(step, state0, (to_chunks(q), to_chunks(k), to_chunks(v)))
    return jnp.swapaxes(out, 0, 1).reshape(B, S, RET_HEADS, RET_DV), state


def mixer_merge(attn_out, ret_out, gate, g_ret, w_out):
    B, L = gate.shape[0], gate.shape[1]
    mu = jnp.mean(ret_out, axis=-1, keepdims=True)
    var = jnp.mean(jnp.square(ret_out - mu), axis=-1, keepdims=True)
    normed = (ret_out - mu) * lax.rsqrt(var + EPS) * g_ret.astype(jnp.float32)
    ret = normed.reshape(B, L, RET_WIDTH).astype(gate.dtype) * jax.nn.silu(gate)
    return jnp.concatenate([attn_out, ret], axis=-1) @ w_out


def setup_inputs(seed: int = 0) -> dict:
    key = jax.random.key(seed)
    ks = jax.random.split(key, 32)
    f32 = jnp.float32

    def nrm(k, shape, scale=1.0):
        return jax.random.normal(k, shape, f32) * scale

    def gain(k, shape):
        return 1.0 + 0.05 * jax.random.normal(k, shape, f32)

    return {
        "x_prompt": nrm(ks[0], (BATCH, SEQ, D_MODEL)),
        "x_sample": nrm(ks[1], (DEC_BATCH, DEC_SEQ, D_MODEL)),
        "cache_attn_k": nrm(ks[2], (DEPTH, DEC_BATCH, WINDOW, N_KV_HEADS, HEAD_DIM)),
        "cache_attn_v": nrm(ks[3], (DEPTH, DEC_BATCH, WINDOW, N_KV_HEADS, HEAD_DIM)),
        "state_ret": nrm(ks[4], (DEPTH, DEC_BATCH, RET_HEADS, RET_DK, RET_DV)),
        "p_prompt": nrm(ks[5], (DEPTH, BATCH, SEQ, PLE_DIM)),
        "p_sample": nrm(ks[6], (DEPTH, DEC_BATCH, DEC_SEQ, PLE_DIM)),
        "g_ffn1": gain(ks[7], (DEPTH, D_MODEL)),
        "w_ffn1_gate": nrm(ks[8], (DEPTH, D_MODEL, D_FF), D_MODEL ** -0.5),
        "w_ffn1_up": nrm(ks[9], (DEPTH, D_MODEL, D_FF), D_MODEL ** -0.5),
        "w_ffn1_down": nrm(ks[10], (DEPTH, D_FF, D_MODEL), D_FF ** -0.5),
        "g_mix": gain(ks[11], (DEPTH, D_MODEL)),
        "w_in": nrm(ks[12], (DEPTH, D_MODEL, IN_WIDTH), D_MODEL ** -0.5),
        "g_q": gain(ks[13], (DEPTH, HEAD_DIM)),
        "g_k": gain(ks[14], (DEPTH, HEAD_DIM)),
        "attn_sinks": nrm(ks[15], (DEPTH, N_HEADS)),
        "g_ret": gain(ks[16], (DEPTH, RET_HEADS, RET_DV)),
        "w_out": nrm(ks[17], (DEPTH, MIX_WIDTH, D_MODEL), MIX_WIDTH ** -0.5),
        "g_ffn2": gain(ks[18], (DEPTH, D_MODEL)),
        "w_ffn2_gate": nrm(ks[19], (DEPTH, D_MODEL, D_FF), D_MODEL ** -0.5),
        "w_ffn2_up": nrm(ks[20], (DEPTH, D_MODEL, D_FF), D_MODEL ** -0.5),
        "w_ffn2_down": nrm(ks[21], (DEPTH, D_FF, D_MODEL), D_FF ** -0.5),
        "g_ple": gain(ks[22], (DEPTH, D_MODEL)),
        "w_ple_gate": nrm(ks[23], (DEPTH, D_MODEL, D_MODEL), D_MODEL ** -0.5),
        "w_ple_proj": nrm(ks[24], (DEPTH, PLE_DIM, D_MODEL), PLE_DIM ** -0.5),
    }


def reference(x_prompt, x_sample, cache_attn_k, cache_attn_v, state_ret, p_prompt, p_sample,
              g_ffn1, w_ffn1_gate, w_ffn1_up, w_ffn1_down, g_mix, w_in, g_q, g_k, attn_sinks,
              g_ret, w_out, g_ffn2, w_ffn2_gate, w_ffn2_up, w_ffn2_down, g_ple, w_ple_gate,
              w_ple_proj):
    log_gamma = retention_log_decay()
    dec_b, dec_len = x_sample.shape[0], x_sample.shape[1]
    pos_p = jnp.arange(x_prompt.shape[1], dtype=jnp.float32)
    pos_s = PAST_LEN + jnp.arange(dec_len, dtype=jnp.float32)

    hp, hs = x_prompt, x_sample
    kp_list, vp_list, sp_list, ks_list, vs_list, ss_list = [], [], [], [], [], []
    for i in range(DEPTH):
        hp = swiglu_half_step(hp, g_ffn1[i], w_ffn1_gate[i], w_ffn1_up[i], w_ffn1_down[i])
        hs = swiglu_half_step(hs, g_ffn1[i], w_ffn1_gate[i], w_ffn1_up[i], w_ffn1_down[i])

        qa, ka, va, qr, kr, vr, gr = mixer_project(rmsnorm(hp, g_mix[i]), pos_p, w_in[i], g_q[i], g_k[i])
        attn_o = attn_prompt(qa, ka, va, attn_sinks[i])
        ret_o, ret_state_p = retention_prompt(qr, kr, vr, log_gamma)
        hp = hp + mixer_merge(attn_o, ret_o, gr, g_ret[i], w_out[i])
        kp_list.append(ka[:, -WINDOW:])
        vp_list.append(va[:, -WINDOW:])
        sp_list.append(ret_state_p.astype(x_prompt.dtype))

        qa, ka, va, qr, kr, vr, gr = mixer_project(rmsnorm(hs, g_mix[i]), pos_s, w_in[i], g_q[i], g_k[i])
        k_all = jnp.concatenate([cache_attn_k[i], ka], axis=1)
        v_all = jnp.concatenate([cache_attn_v[i], va], axis=1)
        attn_o = sink_attend(qa.reshape(dec_b, dec_len, N_KV_HEADS, GROUP, HEAD_DIM), k_all, v_all,
                             attn_sinks[i], None).reshape(dec_b, dec_len, ATTN_WIDTH)
        ret_o, ret_state_s = retention_block(state_ret[i].astype(jnp.float32), qr, kr, vr, log_gamma)
        hs = hs + mixer_merge(attn_o, ret_o, gr, g_ret[i], w_out[i])
        ks_list.append(k_all[:, -WINDOW:])
        vs_list.append(v_all[:, -WINDOW:])
        ss_list.append(ret_state_s.astype(state_ret.dtype))

        hp = swiglu_half_step(hp, g_ffn2[i], w_ffn2_gate[i], w_ffn2_up[i], w_ffn2_down[i])
        hs = swiglu_half_step(hs, g_ffn2[i], w_ffn2_gate[i], w_ffn2_up[i], w_ffn2_down[i])

        hp = ple_add(hp, p_prompt[i], g_ple[i], w_ple_gate[i], w_ple_proj[i])
        hs = ple_add(hs, p_sample[i], g_ple[i], w_ple_gate[i], w_ple_proj[i])

    new_attn_k_prompt = jnp.stack(kp_list, axis=0)
    new_attn_v_prompt = jnp.stack(vp_list, axis=0)
    new_state_ret_prompt = jnp.stack(sp_list, axis=0)
    new_attn_k_sample = jnp.stack(ks_list, axis=0)
    new_attn_v_sample = jnp.stack(vs_list, axis=0)
    new_state_ret_sample = jnp.stack(ss_list, axis=0)
    return (hp, hs, new_attn_k_prompt, new_attn_v_prompt, new_state_ret_prompt,
            new_attn_k_sample, new_attn_v_sample, new_state_ret_sample)
```

```cpp
#include <hip/hip_runtime.h>
#include <cstdio>
#include <cstdint>
namespace pg8 {
#define PG8_LAS __attribute__((address_space(3)))
typedef unsigned short bf16_t;
typedef short bf16x8 __attribute__((ext_vector_type(8)));
typedef float f32x4 __attribute__((ext_vector_type(4)));
typedef unsigned u32x4 __attribute__((ext_vector_type(4)));
constexpr int BM = 256, BK = 64, HALF = 128, HTB = HALF * BK * 2  , STAGE_BYTES = 8 * HTB, NXCD = 8, WGM = 8;

__host__ __device__ __forceinline__ int lds_byte(int r, int c) { const int st = (r >> 4) * 2 + (c >> 5), rr = r & 15, cc = c & 31, ob = rr * 64 + cc * 2; return st * 1024 + (ob ^ (((ob >> 9) & 1) << 5)); }
__host__ __device__ __forceinline__ void stage_rc(int b, int& R, int& C) { const int st = b / 1024, sb = b % 1024, swz = sb ^ (((sb >> 9) & 1) << 5); R = (st >> 1) * 16 + swz / 64; C = (st & 1) * 32 + (swz % 64) / 2; }
__host__ __device__ __forceinline__ int perm32(int rho) { const int n = rho >> 4, i = rho & 15; return 8 * (i >> 2) + 4 * n + (i & 3); }

struct Unit { int pm, pn; };
struct Gemm { const bf16_t* A; const bf16_t* Bt; int M, N, K; };

struct StaticOrder {
    int nM, nN, nwg, G, c;
    __host__ __device__ void init(int M, int N, int G_, int c_) { nM = M / BM; nN = N / BM; nwg = nM * nN; G = G_; c = c_; }
    __host__ __device__ bool next(int i, Unit& u) const {
        const long L = (long)i * G + c; if (L >= nwg) return false;
        int wgid = (int)L; { const int q = nwg / NXCD, r = nwg % NXCD, xcd = wgid % NXCD, off = wgid / NXCD; wgid = (xcd < r ? xcd * (q + 1) : r * (q + 1) + (xcd - r) * q) + off; }
        const int nig = WGM * nN, gid = wgid / nig, fm = gid * WGM, gsz = (nM - fm) < WGM ? (nM - fm) : WGM;
        u.pm = fm + ((wgid % nig) % gsz); u.pn = (wgid % nig) / gsz; return true;
    }
    __device__ __forceinline__ void a_ready(const Unit&) const {}
    __device__ __forceinline__ void done(const Unit&) const {}
};

__device__ __forceinline__ unsigned cvt_pk_bf16(float lo, float hi) { unsigned r; asm volatile("v_cvt_pk_bf16_f32 %0, %1, %2" : "=v"(r) : "v"(lo), "v"(hi)); return r; }
typedef float f32x2 __attribute__((ext_vector_type(2)));
typedef __bf16 bf16x2_t __attribute__((ext_vector_type(2)));
__device__ __forceinline__ unsigned cvtpk(float lo, float hi) { f32x2 v = {lo, hi}; bf16x2_t b = __builtin_convertvector(v, bf16x2_t); return __builtin_bit_cast(unsigned, b); }
__device__ __forceinline__ float sigmoid_f(float g) { return __builtin_amdgcn_rcpf(1.0f + __builtin_amdgcn_exp2f(-1.4426950408889634f * g)); }
__device__ __forceinline__ float silu_f(float g) { return g * sigmoid_f(g); }

struct EpiBf16 {
    static constexpr bool PERM = true, AFTER_DRAIN = false;
    bf16_t* O; int ldc;
    __device__ __forceinline__ void operator()(const f32x4 (&acc)[2][2][4][2], const Unit& u, int wr, int wc, int fr, int fq) const {
        const int row0 = u.pm * BM + wr * 64 + fr, col0 = u.pn * BM + wc * 32 + 8 * fq;
#pragma unroll
        for (int ai = 0; ai < 2; ++ai)
#pragma unroll
            for (int m = 0; m < 4; ++m) { bf16_t* rowp = O + (size_t)(row0 + ai * HALF + m * 16) * ldc + col0;
#pragma unroll
                for (int bj = 0; bj < 2; ++bj) { const f32x4 v0 = acc[ai][bj][m][0], v1 = acc[ai][bj][m][1];
                    u32x4 w; w.x = cvtpk(v0[0], v0[1]); w.y = cvtpk(v0[2], v0[3]); w.z = cvtpk(v1[0], v1[1]); w.w = cvtpk(v1[2], v1[3]);
                    *(u32x4*)(rowp + bj * HALF) = w; } }
    }
};
struct EpiSwiGLU {
    static constexpr bool PERM = true, AFTER_DRAIN = false;
    bf16_t* O; int ldc;
    __device__ __forceinline__ void operator()(const f32x4 (&acc)[2][2][4][2], const Unit& u, int wr, int wc, int fr, int fq) const {
        const int row0 = u.pm * BM + wr * 64 + fr, col0 = u.pn * HALF + wc * 32 + 8 * fq;
#pragma unroll
        for (int ai = 0; ai < 2; ++ai)
#pragma unroll
            for (int m = 0; m < 4; ++m) { bf16_t* rowp = O + (size_t)(row0 + ai * HALF + m * 16) * ldc + col0;
                const f32x4 g0 = acc[ai][0][m][0], g1 = acc[ai][0][m][1], u0 = acc[ai][1][m][0], u1 = acc[ai][1][m][1];
                u32x4 w; w.x = cvtpk(silu_f(g0[0]) * u0[0], silu_f(g0[1]) * u0[1]); w.y = cvtpk(silu_f(g0[2]) * u0[2], silu_f(g0[3]) * u0[3]);
                w.z = cvtpk(silu_f(g1[0]) * u1[0], silu_f(g1[1]) * u1[1]); w.w = cvtpk(silu_f(g1[2]) * u1[2], silu_f(g1[3]) * u1[3]);
                *(u32x4*)rowp = w; }
    }
};
struct EpiRes {
    static constexpr bool PERM = false, AFTER_DRAIN = false;
    const float* resA; const float* resB; float* out; int ldc; int split; float scale;
    __device__ __forceinline__ void operator()(const f32x4 (&acc)[2][2][4][2], const Unit& u, int wr, int wc, int fr, int fq) const {
        const int row0 = u.pm * BM + wr * 64 + fr, col0 = u.pn * BM + wc * 32 + 4 * fq;
        const bool hi = (u.pm * BM >= split); const float* rb = hi ? resB : resA; const int radj = hi ? split : 0;
#pragma unroll
        for (int ai = 0; ai < 2; ++ai)
#pragma unroll
            for (int m = 0; m < 4; ++m) { const int row = row0 + ai * HALF + m * 16; const float* rp = rb + (size_t)(row - radj) * ldc + col0; float* op = out + (size_t)row * ldc + col0;
#pragma unroll
                for (int bj = 0; bj < 2; ++bj)
#pragma unroll
                    for (int n = 0; n < 2; ++n) { const f32x4 r = *(const f32x4*)(rp + bj * HALF + n * 16); *(f32x4*)(op + bj * HALF + n * 16) = r + acc[ai][bj][m][n] * scale; }
                asm volatile("" ::: "memory"); }
    }
};
struct EpiPLE {
    static constexpr bool PERM = false, AFTER_DRAIN = false;
    float* out; const bf16_t* T; int ldc;
    __device__ __forceinline__ void operator()(const f32x4 (&acc)[2][2][4][2], const Unit& u, int wr, int wc, int fr, int fq) const {
        typedef unsigned u32x2v __attribute__((ext_vector_type(2)));
        const int row0 = u.pm * BM + wr * 64 + fr, col0 = u.pn * BM + wc * 32 + 4 * fq;
#pragma unroll
        for (int ai = 0; ai < 2; ++ai)
#pragma unroll
            for (int m = 0; m < 4; ++m) { const size_t off = (size_t)(row0 + ai * HALF + m * 16) * ldc + col0;
#pragma unroll
                for (int bj = 0; bj < 2; ++bj)
#pragma unroll
                    for (int n = 0; n < 2; ++n) { const size_t o = off + bj * HALF + n * 16; const f32x4 h = *(const f32x4*)(out + o); const u32x2v t = *(const u32x2v*)(T + o); const f32x4 a = acc[ai][bj][m][n];
                        f32x4 y; y[0] = h[0] + sigmoid_f(a[0]) * __uint_as_float(t.x << 16); y[1] = h[1] + sigmoid_f(a[1]) * __uint_as_float(t.x & 0xffff0000u);
                        y[2] = h[2] + sigmoid_f(a[2]) * __uint_as_float(t.y << 16); y[3] = h[3] + sigmoid_f(a[3]) * __uint_as_float(t.y & 0xffff0000u);
                        *(f32x4*)(out + o) = y; }
                asm volatile("" ::: "memory"); }
    }
};

template <class Epi, class Sched, bool ALIGN_EPI = false, bool SP2 = false>
__device__ __forceinline__ void gemm_phase(PG8_LAS unsigned char* lds, const Gemm g, const Sched& S, const Epi& E) {
    const int tid = threadIdx.x, wid = __builtin_amdgcn_readfirstlane(tid >> 6), lane = tid & 63, wr = wid >> 2, wc = wid & 3, fr = lane & 15, fq = lane >> 4;
    const int K = g.K, nt = K / BK;
    unsigned voffA[2], voffB[2];
#pragma unroll
    for (int i = 0; i < 2; ++i) { int R, C; stage_rc(tid * 16 + i * 8192, R, C); const int Rb = Epi::PERM ? ((R & ~31) + perm32(R & 31)) : R;
        voffA[i] = (unsigned)(R * K + C) * 2u; voffB[i] = (unsigned)(Rb * K + C) * 2u; }
    const size_t kstep = (size_t)(BK * 2);
    const size_t hstep = (size_t)HALF * K * 2;
    const size_t tstep = 2 * hstep;
    const unsigned ldsw = (unsigned)wid * 1024u;
    const int aoff = lds_byte(wr * 64 + fr, fq * 8), boff = lds_byte(wc * 32 + fr, fq * 8);
#define PG8_SA(b, h) (((b) * 2 + (h)) * HTB)
#define PG8_SB(b, h) ((4 + (b) * 2 + (h)) * HTB)
#define PG8_STAGE(bufoff, gbase, voff) do { _Pragma("unroll") for (int _i = 0; _i < 2; ++_i) \
        __builtin_amdgcn_global_load_lds((const unsigned*)((const char*)(gbase) + (voff)[_i]), (PG8_LAS unsigned*)(lds + (bufoff) + ldsw + _i * 8192), 16, 0, 0); } while (0)
#define PG8_LDA(dst, b, h) do { _Pragma("unroll") for (int m = 0; m < 4; ++m) _Pragma("unroll") for (int k = 0; k < 2; ++k) dst[m][k] = *(const PG8_LAS bf16x8*)(lds + PG8_SA(b, h) + aoff + m * 2048 + k * 1024); } while (0)
#define PG8_LDB(dst, b, h) do { _Pragma("unroll") for (int n = 0; n < 2; ++n) _Pragma("unroll") for (int k = 0; k < 2; ++k) dst[n][k] = *(const PG8_LAS bf16x8*)(lds + PG8_SB(b, h) + boff + n * 2048 + k * 1024); } while (0)
#define PG8_MMA(ai, bj, At, Bt) do { __builtin_amdgcn_s_setprio(1); _Pragma("unroll") for (int m = 0; m < 4; ++m) _Pragma("unroll") for (int n = 0; n < 2; ++n) _Pragma("unroll") for (int k = 0; k < 2; ++k) \
        acc[ai][bj][m][n] = __builtin_amdgcn_mfma_f32_16x16x32_bf16(Bt[n][k], At[m][k], acc[ai][bj][m][n], 0, 0, 0); __builtin_amdgcn_s_setprio(0); } while (0)
#define PG8_WAIT_V(n) asm volatile("s_waitcnt vmcnt(" #n ")" ::: "memory")
#define PG8_WAIT_L(n) asm volatile("s_waitcnt lgkmcnt(" #n ")" ::: "memory")
#define PG8_BAR __builtin_amdgcn_s_barrier()
#define PG8_SCHED __builtin_amdgcn_sched_barrier(0)
    Unit cur, nxt; int ui = 0;
    if (!S.next(0, cur)) return;
    f32x4 acc[2][2][4][2];
#pragma unroll
    for (int a = 0; a < 2; ++a)
#pragma unroll
        for (int b = 0; b < 2; ++b)
#pragma unroll
            for (int m = 0; m < 4; ++m)
#pragma unroll
                for (int n = 0; n < 2; ++n) acc[a][b][m][n] = (f32x4){0.f, 0.f, 0.f, 0.f};
    bf16x8 At[4][2], B0[2][2], B1[2][2];
    const char* cA = (const char*)g.A + (size_t)cur.pm * tstep; const char* cB = (const char*)g.Bt + (size_t)cur.pn * tstep;
    S.a_ready(cur);
    if constexpr (SP2) {
        PG8_STAGE(PG8_SB(0, 0), cB, voffB); PG8_STAGE(PG8_SB(0, 1), cB + hstep, voffB); PG8_STAGE(PG8_SA(0, 0), cA, voffA); PG8_STAGE(PG8_SA(0, 1), cA + hstep, voffA);
        if (wr == 1) PG8_BAR;
        PG8_WAIT_V(2); PG8_BAR;
        PG8_STAGE(PG8_SB(1, 0), cB + kstep, voffB); PG8_STAGE(PG8_SA(1, 0), cA + kstep, voffA); PG8_STAGE(PG8_SB(1, 1), cB + hstep + kstep, voffB);
        PG8_WAIT_V(6); PG8_BAR;
    } else {
        PG8_STAGE(PG8_SB(0, 0), cB, voffB); PG8_STAGE(PG8_SA(0, 0), cA, voffA); PG8_STAGE(PG8_SB(0, 1), cB + hstep, voffB); PG8_STAGE(PG8_SA(0, 1), cA + hstep, voffA);
        if (wr == 1) PG8_BAR;
        PG8_WAIT_V(4); PG8_BAR;
        PG8_STAGE(PG8_SB(1, 0), cB + kstep, voffB); PG8_STAGE(PG8_SA(1, 0), cA + kstep, voffA); PG8_STAGE(PG8_SB(1, 1), cB + hstep + kstep, voffB);
        PG8_WAIT_V(6); PG8_BAR;
    }
    for (;;) {
        const bool has_next = S.next(ui + 1, nxt);
        const char* nA = has_next ? (const char*)g.A + (size_t)nxt.pm * tstep : cA; const char* nB = has_next ? (const char*)g.Bt + (size_t)nxt.pn * tstep : cB;
        for (int t = 0; t < nt; t += 2) {
            const bool last = (t == nt - 2);
            const char* a1 = cA + (size_t)(t + 1) * kstep;
            const char* a2 = last ? nA : cA + (size_t)(t + 2) * kstep; const char* b2 = last ? nB : cB + (size_t)(t + 2) * kstep;
            const char* a3 = a2 + kstep; const char* b3 = b2 + kstep;
            if (last && has_next) S.a_ready(nxt);
            if constexpr (SP2) {
            PG8_LDB(B0, 0, 0); PG8_LDB(B1, 0, 1); PG8_SCHED; PG8_LDA(At, 0, 0); PG8_STAGE(PG8_SA(1, 1), a1 + hstep, voffA);
            PG8_WAIT_V(8); PG8_WAIT_L(0); PG8_BAR; PG8_MMA(0, 0, At, B0); PG8_MMA(0, 1, At, B1); PG8_BAR; PG8_SCHED;
            PG8_LDA(At, 0, 1); PG8_STAGE(PG8_SB(0, 0), b2, voffB); PG8_STAGE(PG8_SB(0, 1), b2 + hstep, voffB); PG8_STAGE(PG8_SA(0, 0), a2, voffA);
            PG8_WAIT_V(8); PG8_WAIT_L(0); PG8_BAR; PG8_MMA(1, 0, At, B0); PG8_MMA(1, 1, At, B1); PG8_BAR; PG8_SCHED;
            PG8_LDB(B0, 1, 0); PG8_LDB(B1, 1, 1); PG8_SCHED; PG8_LDA(At, 1, 0); PG8_STAGE(PG8_SA(0, 1), a2 + hstep, voffA);
            PG8_WAIT_V(8); PG8_WAIT_L(0); PG8_BAR; PG8_MMA(0, 0, At, B0); PG8_MMA(0, 1, At, B1); PG8_BAR; PG8_SCHED;
            PG8_LDA(At, 1, 1); PG8_STAGE(PG8_SB(1, 0), b3, voffB); PG8_STAGE(PG8_SB(1, 1), b3 + hstep, voffB); PG8_STAGE(PG8_SA(1, 0), a3, voffA);
            PG8_WAIT_V(8); PG8_WAIT_L(0); PG8_BAR; PG8_MMA(1, 0, At, B0); PG8_MMA(1, 1, At, B1); PG8_BAR; PG8_SCHED;
            } else {
            PG8_LDB(B0, 0, 0); PG8_SCHED; PG8_LDA(At, 0, 0); PG8_STAGE(PG8_SA(1, 1), a1 + hstep, voffA);
            PG8_WAIT_L(8); PG8_BAR; PG8_WAIT_L(0); PG8_MMA(0, 0, At, B0); PG8_BAR; PG8_SCHED;
            PG8_LDB(B1, 0, 1); PG8_STAGE(PG8_SB(0, 0), b2, voffB);
            PG8_BAR; PG8_WAIT_L(0); PG8_MMA(0, 1, At, B1); PG8_BAR;
            PG8_LDA(At, 0, 1); PG8_STAGE(PG8_SA(0, 0), a2, voffA);
            PG8_BAR; PG8_WAIT_L(0); PG8_MMA(1, 0, At, B0); PG8_BAR; PG8_SCHED;
            PG8_STAGE(PG8_SB(0, 1), b2 + hstep, voffB);
            PG8_WAIT_V(6); PG8_BAR; PG8_MMA(1, 1, At, B1); PG8_BAR;
            PG8_LDB(B0, 1, 0); PG8_SCHED; PG8_LDA(At, 1, 0); PG8_STAGE(PG8_SA(0, 1), a2 + hstep, voffA);
            PG8_WAIT_L(8); PG8_BAR; PG8_WAIT_L(0); PG8_MMA(0, 0, At, B0); PG8_BAR; PG8_SCHED;
            PG8_LDB(B1, 1, 1); PG8_STAGE(PG8_SB(1, 0), b3, voffB);
            PG8_BAR; PG8_WAIT_L(0); PG8_MMA(0, 1, At, B1); PG8_BAR;
            PG8_LDA(At, 1, 1); PG8_STAGE(PG8_SA(1, 0), a3, voffA);
            PG8_BAR; PG8_WAIT_L(0); PG8_MMA(1, 0, At, B0); PG8_BAR; PG8_SCHED;
            PG8_STAGE(PG8_SB(1, 1), b3 + hstep, voffB);
            PG8_WAIT_V(6); PG8_BAR; PG8_MMA(1, 1, At, B1); PG8_BAR;
            }
        }
        if constexpr (ALIGN_EPI) { if (wr == 0) PG8_BAR; }
        if constexpr (!Epi::AFTER_DRAIN) { E(acc, cur, wr, wc, fr, fq); S.done(cur); }
        if (!has_next) break;
#pragma unroll
        for (int a = 0; a < 2; ++a)
#pragma unroll
            for (int b = 0; b < 2; ++b)
#pragma unroll
                for (int m = 0; m < 4; ++m)
#pragma unroll
                    for (int n = 0; n < 2; ++n) acc[a][b][m][n] = (f32x4){0.f, 0.f, 0.f, 0.f};
        cur = nxt; cA = nA; cB = nB; ++ui;
        if constexpr (ALIGN_EPI) { if (wr == 1) PG8_BAR; }
    }
    PG8_WAIT_V(0);
    if constexpr (!ALIGN_EPI) { if (wr == 0) PG8_BAR; }
    PG8_BAR;
    if constexpr (Epi::AFTER_DRAIN) { E.fused(acc, cur, wr, wc, fr, fq, lds, wid, lane); S.done(cur); }
#undef PG8_SA
#undef PG8_SB
#undef PG8_STAGE
#undef PG8_LDA
#undef PG8_LDB
#undef PG8_MMA
#undef PG8_WAIT_V
#undef PG8_WAIT_L
#undef PG8_BAR
#undef PG8_SCHED
}
}

constexpr int NWAVES = 8;
#ifndef MK_ONE_LAUNCH
#define MK_ONE_LAUNCH 1
#endif
constexpr int N_PHASES = 14;

constexpr int D = 4096, DFF = 11008, NTOK = 10240, NPR = 8192, SEQ = 4096, INW = 8704, PLE = 256;
constexpr int C_QA = 0, C_KA = 2048, C_VA = 2304, C_QR = 2560, C_KR = 3584, C_VR = 4608, C_GR = 6656;
constexpr int NPOS = 4160;
constexpr float EPS = 1e-6f;
constexpr size_t O_Y = 0, O_KP = 41943040, O_VP = 42008576, O_SP = 42074112, O_KS = 42598400, O_VS = 43646976, O_SS = 44695552, O_END = 53084160;

constexpr size_t MiB = 1u << 20;
constexpr size_t WS_CTL = 0, CTL_ZERO_BYTES = 1 * MiB;
constexpr size_t WS_ROPE = 2 * MiB;
constexpr size_t WS_PB = 6 * MiB;
constexpr size_t WS_W1GU = 16 * MiB, WS_W1D = 188 * MiB, WS_WIN = 274 * MiB, WS_WOUT = 342 * MiB, WS_W2GU = 374 * MiB, WS_W2D = 546 * MiB, WS_WPG = 632 * MiB, WS_WPP = 664 * MiB;
constexpr size_t WS_ZN = 666 * MiB;
constexpr size_t WS_HID = 746 * MiB;
constexpr size_t WS_MIX = 961 * MiB;
constexpr size_t WS_TP = 1041 * MiB;
constexpr size_t WS_RS = 1121 * MiB;
constexpr size_t WS_STB = 1249 * MiB;
constexpr size_t WS_END = 1313 * MiB;
static_assert(WS_W1GU + (size_t)2 * DFF * D * 2 == WS_W1D && WS_W1D + (size_t)D * DFF * 2 == WS_WIN && WS_WIN + (size_t)INW * D * 2 == WS_WOUT && WS_WOUT + (size_t)D * D * 2 == WS_W2GU, "ws map 1");
static_assert(WS_W2GU + (size_t)2 * DFF * D * 2 == WS_W2D && WS_W2D + (size_t)D * DFF * 2 == WS_WPG && WS_WPG + (size_t)D * D * 2 == WS_WPP && WS_WPP + (size_t)D * PLE * 2 == WS_ZN, "ws map 2");
static_assert(WS_ZN + (size_t)NTOK * D * 2 == WS_HID && WS_HID + (size_t)NTOK * DFF * 2 == WS_MIX && WS_MIX + (size_t)NTOK * D * 2 == WS_TP && WS_TP + (size_t)NTOK * D * 2 == WS_RS, "ws map 3");
static_assert(WS_RS + (size_t)1024 * 32768 * 4 == WS_STB && WS_STB + (size_t)1024 * 32768 * 2 == WS_END && WS_ROPE + (size_t)NPOS * 64 * 8 <= WS_PB && WS_PB + (size_t)NTOK * PLE * 2 <= WS_W1GU, "ws map 4");
constexpr int CW_BAR = 4096;

constexpr int RING_OFF = 0, RING_BYTES = 131072;
constexpr int LDSCTL_OFF = RING_BYTES, MISC_OFF = LDSCTL_OFF + 320;
constexpr int LDS_BYTES = 147456;
static_assert(MISC_OFF + 128 <= LDS_BYTES, "LDS map");

#define GAS __attribute__((address_space(1)))
#define LAS __attribute__((address_space(3)))
typedef unsigned short bf16;
typedef unsigned v4u __attribute__((ext_vector_type(4)));
typedef float f32x4 __attribute__((ext_vector_type(4)));
typedef short bf16x8 __attribute__((ext_vector_type(8)));
typedef GAS unsigned gu32;
typedef GAS unsigned long long gu64;
#define RLX_AGENT __ATOMIC_RELAXED, __HIP_MEMORY_SCOPE_AGENT
#define LDS_WAIT() asm volatile("s_waitcnt lgkmcnt(0)" ::: "memory")
#define VM_WAIT() asm volatile("s_waitcnt vmcnt(0)" ::: "memory")
__device__ __forceinline__ unsigned long long rt() { return __builtin_amdgcn_s_memrealtime(); }
__device__ __forceinline__ unsigned f2bf(float f) { unsigned u = __builtin_bit_cast(unsigned, f); return (u + 0x7fffu + ((u >> 16) & 1u)) >> 16; }
__device__ __forceinline__ unsigned pk2(float lo, float hi) { return f2bf(lo) | (f2bf(hi) << 16); }

#define XB_TMO      128
#define XB_XCNT(j)  (256  + 64 * (j))
#define XB_XSUB(j)  (1280 + 64 * (j))
#define XB_XGEN(j)  (2304 + 64 * (j))
#define XB_TOP      3328
#define XB_TOPGEN   3392
#define XCD_BAR_WORDS 3456
#define XB_SPIN_CAP (1u << 18)

__device__ __forceinline__ unsigned xb_ld(unsigned* p)              { return __hip_atomic_load(p, __ATOMIC_RELAXED, __HIP_MEMORY_SCOPE_AGENT); }
__device__ __forceinline__ unsigned xb_add(unsigned* p, unsigned v) { return __hip_atomic_fetch_add(p, v, __ATOMIC_RELAXED, __HIP_MEMORY_SCOPE_AGENT); }
__device__ __forceinline__ unsigned xb_xcc_id() { return (unsigned)__builtin_amdgcn_s_getreg((3 << 11) | 20) & 0xFu; }
#define XB_SPIN(cond, bar) do { unsigned _sp = 0; while (cond) { __builtin_amdgcn_s_sleep(1); \
    if ((++_sp & 255u) == 0u) { if (xb_ld(&(bar)[XB_TMO])) break; if (_sp > XB_SPIN_CAP) { atomicAdd(&(bar)[XB_TMO], 1u); break; } } } } while (0)

struct XcdBarrier {
    unsigned* bar; unsigned x;
    volatile LAS unsigned* st;
};

__device__ __forceinline__ XcdBarrier xcd_barrier_post(unsigned* bar, volatile LAS unsigned* st) {
    XcdBarrier b; b.bar = bar; b.x = xb_xcc_id(); b.st = st;
    if (threadIdx.x == 0) (void)xb_add(&bar[XB_XCNT(b.x)], 1u);
    return b;
}
__device__ __forceinline__ void xcd_barrier_complete(unsigned* bar, unsigned x, unsigned& nloc, unsigned& nx) {
    const unsigned G = gridDim.x * gridDim.y * gridDim.z;
    unsigned sum, cnt, mine, sp = 0u;
    for (;;) {
        sum = 0u; cnt = 0u; mine = 0u;
#pragma unroll
        for (unsigned j = 0; j < 16; ++j) { const unsigned c = xb_ld(&bar[XB_XCNT(j)]); sum += c; cnt += (c > 0u) ? 1u : 0u; mine = (j == x) ? c : mine; }
        if (sum == G) break;
        __builtin_amdgcn_s_sleep(1);
        if ((++sp & 255u) == 0u) { if (xb_ld(&bar[XB_TMO])) break; if (sp > XB_SPIN_CAP) { atomicAdd(&bar[XB_TMO], 1u); break; } }
    }
    nloc = mine > 0u ? mine : 1u; nx = cnt > 0u ? cnt : 1u;
}

__device__ __forceinline__ void xcd_barrier(const XcdBarrier& b) {
    asm volatile("s_waitcnt vmcnt(0)" ::: "memory");
    __syncthreads();
    if (threadIdx.x == 0) {
        unsigned* bar = b.bar;
        __builtin_amdgcn_s_waitcnt(0);
        unsigned nloc = b.st[0], nx = b.st[1];
        if (nloc == 0u) { xcd_barrier_complete(bar, b.x, nloc, nx); b.st[0] = nloc; b.st[1] = nx; }
        const unsigned old = xb_add(&bar[XB_XSUB(b.x)], 1u);
        const unsigned gen = old / nloc;
        if (old + 1u == (gen + 1u) * nloc) {
            __builtin_amdgcn_fence(__ATOMIC_RELEASE, "agent");
            asm volatile("s_waitcnt vmcnt(0)" ::: "memory");
            const unsigned og = xb_add(&bar[XB_TOP], 1u);
            const unsigned tg = og / nx;
            if (og + 1u == (tg + 1u) * nx) xb_add(&bar[XB_TOPGEN], 1u);
            else XB_SPIN(xb_ld(&bar[XB_TOPGEN]) == tg, bar);
            __builtin_amdgcn_fence(__ATOMIC_ACQUIRE, "agent");
            xb_add(&bar[XB_XGEN(b.x)], 1u);
            asm volatile("s_waitcnt vmcnt(0)" ::: "memory");
        } else {
            XB_SPIN(xb_ld(&bar[XB_XGEN(b.x)]) == gen, bar);
            __builtin_amdgcn_fence(__ATOMIC_ACQUIRE, "agent");
            asm volatile("s_waitcnt vmcnt(0)" ::: "memory");
        }
    }
    __syncthreads();
}


typedef float f32x16 __attribute__((ext_vector_type(16)));
typedef float f32x2 __attribute__((ext_vector_type(2)));
typedef short s16x4 __attribute__((ext_vector_type(4)));
typedef unsigned v2u __attribute__((ext_vector_type(2)));
#define MFMA32(a, b, c) __builtin_amdgcn_mfma_f32_32x32x16_bf16((a), (b), (c), 0, 0, 0)
#define MFMA16(a, b, c) __builtin_amdgcn_mfma_f32_16x16x32_bf16((a), (b), (c), 0, 0, 0)
using pg8::cvtpk;
using pg8::silu_f;

struct Args { const float* in[25]; float* out; unsigned char* ws; int ph_lo, ph_hi; };
struct Frame {
    LAS unsigned char* lds;
    volatile LAS unsigned* MISC;
    gu32* ctl;
    int tid, lane, wave;
    int vcu, G;
};
#define A_x_p      (A.in[0])
#define A_x_s      (A.in[1])
#define A_cache_k  (A.in[2])
#define A_cache_v  (A.in[3])
#define A_state_in (A.in[4])
#define A_p_p      (A.in[5])
#define A_p_s      (A.in[6])
#define A_g_ffn1   (A.in[7])
#define A_w1g      (A.in[8])
#define A_w1u      (A.in[9])
#define A_w1d      (A.in[10])
#define A_g_mix    (A.in[11])
#define A_w_in     (A.in[12])
#define A_g_q      (A.in[13])
#define A_g_k      (A.in[14])
#define A_sinks    (A.in[15])
#define A_g_ret    (A.in[16])
#define A_w_out    (A.in[17])
#define A_g_ffn2   (A.in[18])
#define A_w2g      (A.in[19])
#define A_w2u      (A.in[20])
#define A_w2d      (A.in[21])
#define A_g_ple    (A.in[22])
#define A_w_pg     (A.in[23])
#define A_w_pp     (A.in[24])
#define A_out      (A.out)
#define A_W1GU ((bf16*)(A.ws + WS_W1GU))
#define A_W1D  ((bf16*)(A.ws + WS_W1D))
#define A_WIN  ((bf16*)(A.ws + WS_WIN))
#define A_WOUT ((bf16*)(A.ws + WS_WOUT))
#define A_W2GU ((bf16*)(A.ws + WS_W2GU))
#define A_W2D  ((bf16*)(A.ws + WS_W2D))
#define A_WPG  ((bf16*)(A.ws + WS_WPG))
#define A_WPP  ((bf16*)(A.ws + WS_WPP))
#define A_ZN   ((bf16*)(A.ws + WS_ZN))
#define A_HID  ((bf16*)(A.ws + WS_HID))
#define A_U    ((bf16*)(A.ws + WS_HID))
#define A_MIX  ((bf16*)(A.ws + WS_MIX))
#define A_TP   ((bf16*)(A.ws + WS_TP))
#define A_PB   ((bf16*)(A.ws + WS_PB))
#define A_STB  ((bf16*)(A.ws + WS_STB))
#define A_RS   ((float*)(A.ws + WS_RS))
#define A_ROPE ((f32x2*)(A.ws + WS_ROPE))

__device__ __forceinline__ float wave_sum(float v) {
#pragma unroll
    for (int o = 1; o < 64; o <<= 1) v += __shfl_xor(v, o);
    return v;
}
__device__ __forceinline__ void unpack8(const v4u w, float (&f)[8]) {
    f[0] = __uint_as_float(w.x << 16); f[1] = __uint_as_float(w.x & 0xffff0000u); f[2] = __uint_as_float(w.y << 16); f[3] = __uint_as_float(w.y & 0xffff0000u);
    f[4] = __uint_as_float(w.z << 16); f[5] = __uint_as_float(w.z & 0xffff0000u); f[6] = __uint_as_float(w.w << 16); f[7] = __uint_as_float(w.w & 0xffff0000u);
}
__device__ __forceinline__ v4u pack8(const float (&f)[8]) { v4u w; w.x = cvtpk(f[0], f[1]); w.y = cvtpk(f[2], f[3]); w.z = cvtpk(f[4], f[5]); w.w = cvtpk(f[6], f[7]); return w; }
__device__ __forceinline__ unsigned short bf1(float f) { return (unsigned short)(cvtpk(f, 0.f) & 0xffffu); }
__device__ __forceinline__ float log2_gamma(int h) {
    float r = -0.04580368961312479f;
    r = (h == 1) ? -0.02272007650008353f : r; r = (h == 2) ? -0.011315313227834146f : r; r = (h == 3) ? -0.005646563141142063f : r;
    r = (h == 4) ? -0.0028205190623786626f : r; r = (h == 5) ? -0.0014095702546713536f : r; r = (h == 6) ? -0.0007046129765893727f : r; r = (h == 7) ? -0.0003522634716290214f : r;
    return r;
}

__device__ __forceinline__ void cvt_item(const float* W, int K, int N, bf16* WT, int mode, int item, int lane) {
    const int nn = N >> 7, kb = item / nn, nb = item - kb * nn, k0 = kb * 32, n0 = nb * 128;
    const int half = lane >> 5, c = lane & 31;
    const GAS f32x4* src = (const GAS f32x4*)(W + (size_t)(k0 + half * 16) * N + n0 + 4 * c);
    const size_t rs = (size_t)(N >> 2);
    f32x4 v[16];
#pragma unroll
    for (int j = 0; j < 16; ++j) v[j] = src[(size_t)j * rs];
    const int drow0 = (mode == 0 ? n0 : nb * 256 + (mode == 2 ? 128 : 0)) + 4 * c;
#pragma unroll
    for (int i = 0; i < 4; ++i) {
        bf16* dst = WT + (size_t)(drow0 + i) * K + k0 + half * 16;
        v4u o0, o1;
        o0.x = cvtpk(v[0][i], v[1][i]); o0.y = cvtpk(v[2][i], v[3][i]); o0.z = cvtpk(v[4][i], v[5][i]); o0.w = cvtpk(v[6][i], v[7][i]);
        o1.x = cvtpk(v[8][i], v[9][i]); o1.y = cvtpk(v[10][i], v[11][i]); o1.z = cvtpk(v[12][i], v[13][i]); o1.w = cvtpk(v[14][i], v[15][i]);
        *(GAS v4u*)dst = o0; *(GAS v4u*)(dst + 8) = o1;
    }
}
__device__ __forceinline__ void cvt_matrix(const Frame& F, const float* W, int K, int N, bf16* WT, int mode) {
    const int gw = F.vcu * NWAVES + F.wave, NGW = F.G * NWAVES, nitems = (K >> 5) * (N >> 7);
    for (int it = gw; it < nitems; it += NGW) cvt_item(W, K, N, WT, mode, it, F.lane);
}
__device__ __forceinline__ void rms_row(const float* xrow, const float* g, bf16* orow, int lane) {
    f32x4 a[8], b[8]; float s = 0.f;
#pragma unroll
    for (int j = 0; j < 8; ++j) { const GAS f32x4* p = (const GAS f32x4*)(xrow + 8 * lane + 512 * j); a[j] = p[0]; b[j] = p[1];
        s += (a[j][0] * a[j][0] + a[j][1] * a[j][1]) + (a[j][2] * a[j][2] + a[j][3] * a[j][3]) + (b[j][0] * b[j][0] + b[j][1] * b[j][1]) + (b[j][2] * b[j][2] + b[j][3] * b[j][3]); }
    const float rstd = 1.0f / sqrtf(wave_sum(s) * (1.0f / D) + EPS);
#pragma unroll
    for (int j = 0; j < 8; ++j) { const GAS f32x4* gp = (const GAS f32x4*)(g + 8 * lane + 512 * j); const f32x4 g0 = gp[0], g1 = gp[1];
        v4u o; o.x = cvtpk(a[j][0] * rstd * g0[0], a[j][1] * rstd * g0[1]); o.y = cvtpk(a[j][2] * rstd * g0[2], a[j][3] * rstd * g0[3]);
        o.z = cvtpk(b[j][0] * rstd * g1[0], b[j][1] * rstd * g1[1]); o.w = cvtpk(b[j][2] * rstd * g1[2], b[j][3] * rstd * g1[3]);
        *(GAS v4u*)(orow + 8 * lane + 512 * j) = o; }
}
__device__ __forceinline__ void norm_phase(const Frame& F, const Args& A, const float* srcA, const float* srcB, const float* g) {
    const int gw = F.vcu * NWAVES + F.wave, NGW = F.G * NWAVES;
    for (int m = gw; m < NTOK; m += NGW) { const float* xr = (m < NPR) ? srcA + (size_t)m * D : srcB + (size_t)(m - NPR) * D; rms_row(xr, g, A_ZN + (size_t)m * D, F.lane); }
}
__device__ __forceinline__ void p0_prologue(const Frame& F, const Args& A) {
    cvt_matrix(F, A_w1g, D, DFF, A_W1GU, 1); cvt_matrix(F, A_w1u, D, DFF, A_W1GU, 2); cvt_matrix(F, A_w1d, DFF, D, A_W1D, 0);
    cvt_matrix(F, A_w_in, D, INW, A_WIN, 0); cvt_matrix(F, A_w_out, D, D, A_WOUT, 0);
    cvt_matrix(F, A_w2g, D, DFF, A_W2GU, 1); cvt_matrix(F, A_w2u, D, DFF, A_W2GU, 2); cvt_matrix(F, A_w2d, DFF, D, A_W2D, 0);
    cvt_matrix(F, A_w_pg, D, D, A_WPG, 0); cvt_matrix(F, A_w_pp, PLE, D, A_WPP, 0);
    norm_phase(F, A, A_x_p, A_x_s, A_g_ffn1);
    const int gt = F.vcu * (NWAVES * 64) + F.tid, NGT = F.G * NWAVES * 64;
    for (int i = gt; i < NTOK * PLE / 8; i += NGT) { const size_t e = (size_t)i * 8; const float* src = (e < (size_t)NPR * PLE) ? A_p_p + e : A_p_s + (e - (size_t)NPR * PLE);
        const f32x4 a = *(const GAS f32x4*)src, b = *(const GAS f32x4*)(src + 4); v4u o; o.x = cvtpk(a[0], a[1]); o.y = cvtpk(a[2], a[3]); o.z = cvtpk(b[0], b[1]); o.w = cvtpk(b[2], b[3]);
        *(GAS v4u*)(A_PB + e) = o; }
    for (int e = gt; e < NPOS * 64; e += NGT) { const int pos = e >> 6, i = e & 63;
        const double ang = (double)pos * exp2((double)i * (-13.287712379549449 / 64.0));
        const double k = rint(ang * 0.63661977236758134); double r = fma(-k, 1.5707963267948966, ang); r = fma(-k, 6.123233995736766e-17, r);
        const int q = ((int)k) & 3; const double r2 = r * r;
        const double sn = r * (1.0 + r2 * (-1.0 / 6 + r2 * (1.0 / 120 + r2 * (-1.0 / 5040 + r2 * (1.0 / 362880 + r2 * (-1.0 / 39916800 + r2 * (1.0 / 6227020800.0)))))));
        const double cs = 1.0 + r2 * (-0.5 + r2 * (1.0 / 24 + r2 * (-1.0 / 720 + r2 * (1.0 / 40320 + r2 * (-1.0 / 3628800 + r2 * (1.0 / 479001600.0 + r2 * (-1.0 / 87178291200.0)))))));
        const double c = (q == 0) ? cs : (q == 1) ? -sn : (q == 2) ? -cs : sn, s = (q == 0) ? sn : (q == 1) ? cs : (q == 2) ? -sn : -cs;
        A_ROPE[e] = (f32x2){(float)c, (float)s}; }
}

constexpr int AT_KS = 0, AT_KP = 72, AT_VT = 27648, AT_VP = 200;
__device__ __forceinline__ void attn_unit(const Frame& F, const Args& A, int ua) {
    const int tid = F.tid, lane = F.lane, wave = F.wave;
    const bool prompt = ua < 512;
    const int b = prompt ? (ua >> 8) : ((ua - 512) >> 2), c = prompt ? ((ua >> 2) & 63) : 0, kvh = ua & 3;
    const int row0 = prompt ? b * SEQ + c * 64 : NPR + b * 64;
    LAS bf16* Ks = (LAS bf16*)(F.lds + AT_KS); LAS bf16* Vt = (LAS bf16*)(F.lds + AT_VT);
    __syncthreads();
    {   const int t = tid >> 3, dp = tid & 7;
        const f32x4 gk0 = *(const GAS f32x4*)(A_g_k + 8 * dp), gk1 = *(const GAS f32x4*)(A_g_k + 8 * dp + 4);
#pragma unroll
        for (int i = 0; i < 3; ++i) {
            float kv[8], vv[8]; bool donorm;
            if (prompt || i == 2) {
                const int kc = c - 2 + i; const bool valid = (!prompt) || kc >= 0;
                const int row = prompt ? b * SEQ + kc * 64 + t : row0 + t;
                if (valid) { const bf16* up = A_U + (size_t)row * INW + kvh * 64 + 8 * dp; unpack8(*(const GAS v4u*)(up + C_KA), kv); unpack8(*(const GAS v4u*)(up + C_VA), vv); }
                else {
#pragma unroll
                    for (int e = 0; e < 8; ++e) { kv[e] = 0.f; vv[e] = 0.f; } }
                donorm = true;
            } else {
                const size_t ci = ((size_t)(b * 128 + i * 64 + t) * 4 + kvh) * 64 + 8 * dp;
                const f32x4 k0 = *(const GAS f32x4*)(A_cache_k + ci), k1 = *(const GAS f32x4*)(A_cache_k + ci + 4), v0 = *(const GAS f32x4*)(A_cache_v + ci), v1 = *(const GAS f32x4*)(A_cache_v + ci + 4);
#pragma unroll
                for (int e = 0; e < 4; ++e) { kv[e] = k0[e]; kv[4 + e] = k1[e]; vv[e] = v0[e]; vv[4 + e] = v1[e]; }
                donorm = false;
            }
            float ss = 0.f;
#pragma unroll
            for (int e = 0; e < 8; ++e) ss += kv[e] * kv[e];
            ss += __shfl_xor(ss, 1); ss += __shfl_xor(ss, 2); ss += __shfl_xor(ss, 4);
            if (donorm) { const float rstd = 1.0f / sqrtf(ss * (1.0f / 64) + EPS);
#pragma unroll
                for (int e = 0; e < 4; ++e) { kv[e] = kv[e] * rstd * gk0[e]; kv[4 + e] = kv[4 + e] * rstd * gk1[e]; } }
            const int key = 64 * i + t;
            *(LAS v4u*)(Ks + key * AT_KP + 8 * dp) = pack8(kv);
#pragma unroll
            for (int e = 0; e < 8; ++e) Vt[(8 * dp + e) * AT_VP + key] = bf1(vv[e]);
            float* ok = nullptr; float* ov = nullptr;
            if (prompt) { if (i == 2 && c >= 62) { const size_t o = ((size_t)(b * 128 + (c - 62) * 64 + t) * 4 + kvh) * 64 + 8 * dp; ok = A_out + O_KP + o; ov = A_out + O_VP + o; } }
            else if (i >= 1) { const size_t o = ((size_t)(b * 128 + (i - 1) * 64 + t) * 4 + kvh) * 64 + 8 * dp; ok = A_out + O_KS + o; ov = A_out + O_VS + o; }
            if (ok) { *(GAS f32x4*)ok = (f32x4){kv[0], kv[1], kv[2], kv[3]}; *(GAS f32x4*)(ok + 4) = (f32x4){kv[4], kv[5], kv[6], kv[7]};
                      *(GAS f32x4*)ov = (f32x4){vv[0], vv[1], vv[2], vv[3]}; *(GAS f32x4*)(ov + 4) = (f32x4){vv[4], vv[5], vv[6], vv[7]}; }
        }
    }
    __syncthreads();
    const int hh = kvh * 8 + wave; const float sink = A_sinks[hh];
    const int r = lane & 31, h = lane >> 5;
    const int kt_first = prompt ? (c >= 2 ? 0 : (2 - c) * 2) : 0;
    constexpr float L2E = 1.4426950408889634f;
#pragma unroll 1
    for (int qb = 0; qb < 2; ++qb) {
        const bf16* qrow = A_U + (size_t)(row0 + qb * 32 + r) * INW + C_QA + hh * 64 + 8 * h;
        float qf[4][8]; float ss = 0.f;
#pragma unroll
        for (int ks = 0; ks < 4; ++ks) { unpack8(*(const GAS v4u*)(qrow + 16 * ks), qf[ks]);
#pragma unroll
            for (int e = 0; e < 8; ++e) ss += qf[ks][e] * qf[ks][e]; }
        ss += __shfl_xor(ss, 32);
        const float sc = 0.125f / sqrtf(ss * (1.0f / 64) + EPS);
        bf16x8 Qf[4];
#pragma unroll
        for (int ks = 0; ks < 4; ++ks) { float t8[8];
            const f32x4 g0 = *(const GAS f32x4*)(A_g_q + 16 * ks + 8 * h), g1 = *(const GAS f32x4*)(A_g_q + 16 * ks + 8 * h + 4);
#pragma unroll
            for (int e = 0; e < 4; ++e) { t8[e] = qf[ks][e] * sc * g0[e]; t8[4 + e] = qf[ks][4 + e] * sc * g1[e]; }
            Qf[ks] = __builtin_bit_cast(bf16x8, pack8(t8)); }
        __builtin_amdgcn_sched_barrier(0);
        f32x16 S[6];
#pragma unroll
        for (int kt = 0; kt < 6; ++kt) {
#pragma unroll
            for (int i = 0; i < 16; ++i) S[kt][i] = 0.f;
#pragma unroll
            for (int ks = 0; ks < 4; ++ks) { const bf16x8 Af = *(const LAS bf16x8*)(Ks + (32 * kt + r) * AT_KP + 16 * ks + 8 * h); S[kt] = MFMA32(Af, Qf[ks], S[kt]); } }
        float mx = sink;
#pragma unroll
        for (int kt = 0; kt < 6; ++kt) if (kt >= kt_first) {
#pragma unroll
            for (int i = 0; i < 16; ++i) mx = fmaxf(mx, S[kt][i]); }
        mx = fmaxf(mx, __shfl_xor(mx, 32));
        float sum = 0.f;
#pragma unroll
        for (int kt = 0; kt < 6; ++kt) { const bool on = kt >= kt_first;
#pragma unroll
            for (int i = 0; i < 16; ++i) { const float p = on ? __builtin_amdgcn_exp2f((S[kt][i] - mx) * L2E) : 0.f; S[kt][i] = p; sum += p; } }
        sum += __shfl_xor(sum, 32);
        const float inv = 1.0f / (sum + __builtin_amdgcn_exp2f((sink - mx) * L2E));
        f32x16 O[2];
#pragma unroll
        for (int dt = 0; dt < 2; ++dt)
#pragma unroll
            for (int i = 0; i < 16; ++i) O[dt][i] = 0.f;
#pragma unroll
        for (int kt = 0; kt < 6; ++kt)
#pragma unroll
            for (int s = 0; s < 2; ++s) {
                float t8[8];
#pragma unroll
                for (int e = 0; e < 8; ++e) t8[e] = S[kt][8 * s + e];
                const bf16x8 B = __builtin_bit_cast(bf16x8, pack8(t8));
#pragma unroll
                for (int dt = 0; dt < 2; ++dt) { const LAS bf16* vp = Vt + (32 * dt + r) * AT_VP + 32 * kt + 16 * s + 4 * h;
                    const s16x4 lo = *(const LAS s16x4*)vp, hi = *(const LAS s16x4*)(vp + 8);
                    const bf16x8 Af = __builtin_shufflevector(lo, hi, 0, 1, 2, 3, 4, 5, 6, 7); O[dt] = MFMA32(Af, B, O[dt]); }
                __builtin_amdgcn_sched_barrier(0);
            }
        bf16* orow = A_MIX + (size_t)(row0 + qb * 32 + r) * D + hh * 64 + 4 * h;
#pragma unroll
        for (int dt = 0; dt < 2; ++dt)
#pragma unroll
            for (int rg = 0; rg < 4; ++rg) { v2u w; w.x = cvtpk(O[dt][4 * rg] * inv, O[dt][4 * rg + 1] * inv); w.y = cvtpk(O[dt][4 * rg + 2] * inv, O[dt][4 * rg + 3] * inv);
                *(GAS v2u*)(orow + 32 * dt + 8 * rg) = w; }
    }
}

__device__ __forceinline__ void rot_load(const Args& A, const bf16* src  , int pos, int dp, float (&o1)[8], float (&o2)[8]) {
    float x1[8], x2[8]; unpack8(*(const GAS v4u*)(src + 8 * dp), x1); unpack8(*(const GAS v4u*)(src + 64 + 8 * dp), x2);
    const GAS f32x4* tp = (const GAS f32x4*)(A_ROPE + (size_t)pos * 64 + 8 * dp);
#pragma unroll
    for (int e2 = 0; e2 < 4; ++e2) { const f32x4 cs = tp[e2];
        o1[2 * e2] = x1[2 * e2] * cs[0] - x2[2 * e2] * cs[1]; o2[2 * e2] = x2[2 * e2] * cs[0] + x1[2 * e2] * cs[1];
        o1[2 * e2 + 1] = x1[2 * e2 + 1] * cs[2] - x2[2 * e2 + 1] * cs[3]; o2[2 * e2 + 1] = x2[2 * e2 + 1] * cs[2] + x1[2 * e2 + 1] * cs[3]; }
}
constexpr float KSCALE = 0.088388347648318441f;
constexpr int RL_KT = 0, RL_P = 72, RL_VT = 18432;
__device__ __forceinline__ void retloc_unit(const Frame& F, const Args& A, int ur) {
    const int tid = F.tid, lane = F.lane, wave = F.wave;
    const bool prompt = ur < 1024;
    const int b = prompt ? (ur >> 9) : ((ur - 1024) >> 3), c = prompt ? ((ur >> 3) & 63) : 0, hh = ur & 7;
    const int row0 = prompt ? b * SEQ + c * 64 : NPR + b * 64, pos0 = prompt ? c * 64 : SEQ;
    const float l2g = log2_gamma(hh);
    LAS bf16* KT = (LAS bf16*)(F.lds + RL_KT); LAS bf16* VT = (LAS bf16*)(F.lds + RL_VT);
    __syncthreads();
    {   const int m = tid >> 3, dp = tid & 7; float o1[8], o2[8];
        rot_load(A, A_U + (size_t)(row0 + m) * INW + C_KR + hh * 128, pos0 + m, dp, o1, o2);
        const float sc = KSCALE * __builtin_amdgcn_exp2f((float)(63 - m) * l2g);
#pragma unroll
        for (int e = 0; e < 8; ++e) { KT[(8 * dp + e) * RL_P + m] = bf1(o1[e] * sc); KT[(64 + 8 * dp + e) * RL_P + m] = bf1(o2[e] * sc); }
#pragma unroll
        for (int i = 0; i < 4; ++i) { const int q = tid + 512 * i, mm = q >> 5, vp = q & 31; float vv[8];
            unpack8(*(const GAS v4u*)(A_U + (size_t)(row0 + mm) * INW + C_VR + hh * 256 + 8 * vp), vv);
#pragma unroll
            for (int e = 0; e < 8; ++e) VT[(8 * vp + e) * RL_P + mm] = bf1(vv[e]); }
    }
    __syncthreads();
    const int c16 = lane & 15, q4 = lane >> 4;
    f32x4 acc[8][2];
#pragma unroll
    for (int dt = 0; dt < 8; ++dt)
#pragma unroll
        for (int vt = 0; vt < 2; ++vt) acc[dt][vt] = (f32x4){0.f, 0.f, 0.f, 0.f};
    if (prompt) {
#pragma unroll
        for (int ks = 0; ks < 2; ++ks) { bf16x8 Bv[2];
#pragma unroll
            for (int vt = 0; vt < 2; ++vt) Bv[vt] = *(const LAS bf16x8*)(VT + (32 * wave + 16 * vt + c16) * RL_P + 32 * ks + 8 * q4);
#pragma unroll
            for (int dt = 0; dt < 8; ++dt) { const bf16x8 Af = *(const LAS bf16x8*)(KT + (16 * dt + c16) * RL_P + 32 * ks + 8 * q4);
#pragma unroll
                for (int vt = 0; vt < 2; ++vt) acc[dt][vt] = MFMA16(Af, Bv[vt], acc[dt][vt]); } }
        float* rs = A_RS + (size_t)ur * 32768;
#pragma unroll
        for (int dt = 0; dt < 8; ++dt)
#pragma unroll
            for (int vt = 0; vt < 2; ++vt) *(GAS f32x4*)(rs + (32 * wave + 16 * vt + c16) * 128 + 16 * dt + 4 * q4) = acc[dt][vt];
    } else {
#pragma unroll
        for (int ks = 0; ks < 2; ++ks) { bf16x8 Av[2];
#pragma unroll
            for (int vt = 0; vt < 2; ++vt) Av[vt] = *(const LAS bf16x8*)(VT + (32 * wave + 16 * vt + c16) * RL_P + 32 * ks + 8 * q4);
#pragma unroll
            for (int dt = 0; dt < 8; ++dt) { const bf16x8 Bk = *(const LAS bf16x8*)(KT + (16 * dt + c16) * RL_P + 32 * ks + 8 * q4);
#pragma unroll
                for (int vt = 0; vt < 2; ++vt) acc[dt][vt] = MFMA16(Av[vt], Bk, acc[dt][vt]); } }
        const float g64 = __builtin_amdgcn_exp2f(64.0f * l2g);
        const size_t sb = (size_t)(b * 8 + hh) * 32768;
#pragma unroll
        for (int dt = 0; dt < 8; ++dt)
#pragma unroll
            for (int vt = 0; vt < 2; ++vt) { const size_t o = sb + (size_t)(16 * dt + c16) * 256 + 32 * wave + 16 * vt + 4 * q4;
                const f32x4 s = *(const GAS f32x4*)(A_state_in + o); *(GAS f32x4*)(A_out + O_SS + o) = s * g64 + acc[dt][vt]; }
    }
}
__device__ __forceinline__ void scan_phase(const Frame& F, const Args& A) {
    const int gt = F.vcu * (NWAVES * 64) + F.tid, NGT = F.G * NWAVES * 64;
    for (int i = gt; i < 16 * 8192; i += NGT) {
        const int ch = i >> 13, e4 = i & 8191, b = ch >> 3, hh = ch & 7;
        const float g64 = __builtin_amdgcn_exp2f(64.0f * log2_gamma(hh));
        f32x4 S = (f32x4){0.f, 0.f, 0.f, 0.f};
#pragma unroll 1
        for (int c0 = 0; c0 < 64; c0 += 8) {
            f32x4 loc[8];
#pragma unroll
            for (int j = 0; j < 8; ++j) loc[j] = *(const GAS f32x4*)(A_RS + (size_t)(b * 512 + (c0 + j) * 8 + hh) * 32768 + 4 * e4);
#pragma unroll
            for (int j = 0; j < 8; ++j) { v2u w; w.x = cvtpk(S[0], S[1]); w.y = cvtpk(S[2], S[3]);
                *(GAS v2u*)(A_STB + (size_t)(b * 512 + (c0 + j) * 8 + hh) * 32768 + 4 * e4) = w; S = S * g64 + loc[j]; }
        }
        const int v = e4 >> 5, d0 = (e4 & 31) * 4;
        float* o = A_out + O_SP + (size_t)ch * 32768 + (size_t)d0 * 256 + v;
        o[0] = S[0]; o[256] = S[1]; o[512] = S[2]; o[768] = S[3];
    }
}
constexpr int RO_QP = 0, RO_KP = 17408, RO_DP = 136, RO_VT = 34816, RO_VP = 72, RO_PS = 71680, RO_PP = 72, RO_RED = 80896;
__device__ __forceinline__ void retout_unit(const Frame& F, const Args& A, int ur) {
    const int tid = F.tid, lane = F.lane, wave = F.wave;
    const bool prompt = ur < 1024;
    const int b = prompt ? (ur >> 9) : ((ur - 1024) >> 3), c = prompt ? ((ur >> 3) & 63) : 0, hh = ur & 7;
    const int row0 = prompt ? b * SEQ + c * 64 : NPR + b * 64, pos0 = prompt ? c * 64 : SEQ;
    const float l2g = log2_gamma(hh);
    LAS bf16* QP = (LAS bf16*)(F.lds + RO_QP); LAS bf16* KP = (LAS bf16*)(F.lds + RO_KP); LAS bf16* VT = (LAS bf16*)(F.lds + RO_VT); LAS bf16* PS = (LAS bf16*)(F.lds + RO_PS);
    LAS f32x2* RED = (LAS f32x2*)(F.lds + RO_RED);
    __syncthreads();
    {   const int m = tid >> 3, dp = tid & 7; float o1[8], o2[8];
        const bf16* urow = A_U + (size_t)(row0 + m) * INW;
        rot_load(A, urow + C_QR + hh * 128, pos0 + m, dp, o1, o2);
        *(LAS v4u*)(QP + m * RO_DP + 8 * dp) = pack8(o1); *(LAS v4u*)(QP + m * RO_DP + 64 + 8 * dp) = pack8(o2);
        rot_load(A, urow + C_KR + hh * 128, pos0 + m, dp, o1, o2);
#pragma unroll
        for (int e = 0; e < 8; ++e) { o1[e] *= KSCALE; o2[e] *= KSCALE; }
        *(LAS v4u*)(KP + m * RO_DP + 8 * dp) = pack8(o1); *(LAS v4u*)(KP + m * RO_DP + 64 + 8 * dp) = pack8(o2);
#pragma unroll
        for (int i = 0; i < 4; ++i) { const int q = tid + 512 * i, mm = q >> 5, vp = q & 31; float vv[8];
            unpack8(*(const GAS v4u*)(A_U + (size_t)(row0 + mm) * INW + C_VR + hh * 256 + 8 * vp), vv);
#pragma unroll
            for (int e = 0; e < 8; ++e) VT[(8 * vp + e) * RO_VP + mm] = bf1(vv[e]); }
    }
    __syncthreads();
    const int c16 = lane & 15, q4 = lane >> 4;
    {
        const int mt = wave >> 1;
#pragma unroll
        for (int t2 = 0; t2 < 2; ++t2) { const int lt = (wave & 1) * 2 + t2; f32x4 s = (f32x4){0.f, 0.f, 0.f, 0.f};
#pragma unroll
            for (int ks = 0; ks < 4; ++ks) { const bf16x8 Af = *(const LAS bf16x8*)(KP + (16 * mt + c16) * RO_DP + 32 * ks + 8 * q4), B = *(const LAS bf16x8*)(QP + (16 * lt + c16) * RO_DP + 32 * ks + 8 * q4);
                s = MFMA16(Af, B, s); }
            const int l = 16 * lt + c16, m0 = 16 * mt + 4 * q4; float p[4];
#pragma unroll
            for (int e = 0; e < 4; ++e) { const int dist = (l > m0 + e) ? (l - m0 - e) : (m0 + e - l); p[e] = s[e] * __builtin_amdgcn_exp2f((float)dist * l2g); }
            v2u w; w.x = cvtpk(p[0], p[1]); w.y = cvtpk(p[2], p[3]); *(LAS v2u*)(PS + l * RO_PP + m0) = w; }
    }
    __syncthreads();
    f32x4 acc[2][4];
#pragma unroll
    for (int vt = 0; vt < 2; ++vt)
#pragma unroll
        for (int lt = 0; lt < 4; ++lt) acc[vt][lt] = (f32x4){0.f, 0.f, 0.f, 0.f};
#pragma unroll
    for (int ks = 0; ks < 4; ++ks) { bf16x8 Af[2];
#pragma unroll
        for (int vt = 0; vt < 2; ++vt) { const int v = 32 * wave + 16 * vt + c16;
            if (prompt) Af[vt] = *(const GAS bf16x8*)(A_STB + (size_t)ur * 32768 + v * 128 + 32 * ks + 8 * q4);
            else { const float* sp = A_state_in + (size_t)(b * 8 + hh) * 32768 + (size_t)(32 * ks + 8 * q4) * 256 + v; float t8[8];
#pragma unroll
                for (int j = 0; j < 8; ++j) t8[j] = sp[j * 256];
                Af[vt] = __builtin_bit_cast(bf16x8, pack8(t8)); } }
#pragma unroll
        for (int lt = 0; lt < 4; ++lt) { const bf16x8 B = *(const LAS bf16x8*)(QP + (16 * lt + c16) * RO_DP + 32 * ks + 8 * q4);
#pragma unroll
            for (int vt = 0; vt < 2; ++vt) acc[vt][lt] = MFMA16(Af[vt], B, acc[vt][lt]); } }
#pragma unroll
    for (int lt = 0; lt < 4; ++lt) { const float qd = __builtin_amdgcn_exp2f((float)(16 * lt + c16 + 1) * l2g);
#pragma unroll
        for (int vt = 0; vt < 2; ++vt) acc[vt][lt] = acc[vt][lt] * qd; }
#pragma unroll
    for (int ks = 0; ks < 2; ++ks) { bf16x8 Af[2];
#pragma unroll
        for (int vt = 0; vt < 2; ++vt) Af[vt] = *(const LAS bf16x8*)(VT + (32 * wave + 16 * vt + c16) * RO_VP + 32 * ks + 8 * q4);
#pragma unroll
        for (int lt = 0; lt < 4; ++lt) { const bf16x8 B = *(const LAS bf16x8*)(PS + (16 * lt + c16) * RO_PP + 32 * ks + 8 * q4);
#pragma unroll
            for (int vt = 0; vt < 2; ++vt) acc[vt][lt] = MFMA16(Af[vt], B, acc[vt][lt]); } }
#pragma unroll
    for (int lt = 0; lt < 4; ++lt) { float s1 = 0.f, s2 = 0.f;
#pragma unroll
        for (int vt = 0; vt < 2; ++vt)
#pragma unroll
            for (int e = 0; e < 4; ++e) { const float x = acc[vt][lt][e]; s1 += x; s2 += x * x; }
        s1 += __shfl_xor(s1, 16); s2 += __shfl_xor(s2, 16); s1 += __shfl_xor(s1, 32); s2 += __shfl_xor(s2, 32);
        if (q4 == 0) RED[wave * 64 + 16 * lt + c16] = (f32x2){s1, s2}; }
    __syncthreads();
#pragma unroll
    for (int lt = 0; lt < 4; ++lt) { const int l = 16 * lt + c16; float s1 = 0.f, s2 = 0.f;
#pragma unroll
        for (int w = 0; w < 8; ++w) { const f32x2 t = RED[w * 64 + l]; s1 += t[0]; s2 += t[1]; }
        const float mean = s1 * (1.0f / 256), var = fmaxf(s2 * (1.0f / 256) - mean * mean, 0.f), rstd = 1.0f / sqrtf(var + EPS);
#pragma unroll
        for (int vt = 0; vt < 2; ++vt) { const int v0 = 32 * wave + 16 * vt + 4 * q4;
            const f32x4 gr = *(const GAS f32x4*)(A_g_ret + hh * 256 + v0);
            const v2u gw = *(const GAS v2u*)(A_U + (size_t)(row0 + l) * INW + C_GR + hh * 256 + v0);
            const float g0 = __uint_as_float(gw.x << 16), g1 = __uint_as_float(gw.x & 0xffff0000u), g2 = __uint_as_float(gw.y << 16), g3 = __uint_as_float(gw.y & 0xffff0000u);
            const f32x4 a = acc[vt][lt];
            v2u w; w.x = cvtpk((a[0] - mean) * rstd * gr[0] * silu_f(g0), (a[1] - mean) * rstd * gr[1] * silu_f(g1));
            w.y = cvtpk((a[2] - mean) * rstd * gr[2] * silu_f(g2), (a[3] - mean) * rstd * gr[3] * silu_f(g3));
            *(GAS v2u*)(A_MIX + (size_t)(row0 + l) * D + 2048 + hh * 256 + v0) = w; } }
}

__global__ void __launch_bounds__(NWAVES * 64, 2) fwd(Args args) {
    extern __shared__ __attribute__((aligned(16))) unsigned char lds[];
    Frame F;
    F.lds = (LAS unsigned char*)lds;
    F.MISC = (volatile LAS unsigned*)(F.lds + MISC_OFF);
    F.tid = threadIdx.x; F.lane = F.tid & 63; F.wave = __builtin_amdgcn_readfirstlane(F.tid >> 6);
    F.G = gridDim.x; { const int bx = blockIdx.x; F.vcu = (F.G % 8 == 0) ? (bx % 8) * (F.G / 8) + bx / 8 : bx; }
    const Args& A = args;
    F.ctl = (gu32*)(args.ws + WS_CTL);
    for (int u = F.tid; u < (LDS_BYTES - LDSCTL_OFF) / 4; u += NWAVES * 64) ((LAS unsigned*)(F.lds + LDSCTL_OFF))[u] = 0u;
    __syncthreads();
    XcdBarrier bar; bar.bar = (unsigned*)(F.ctl + CW_BAR); bar.x = 0; bar.st = nullptr;
    if (MK_ONE_LAUNCH) bar = xcd_barrier_post((unsigned*)(F.ctl + CW_BAR), F.MISC + 8);
    const int lo = args.ph_lo, hi = args.ph_hi;
#ifndef ONLY_PHASE
#define ONLY_PHASE -1
#endif
#define IN(k) ((ONLY_PHASE < 0 || ONLY_PHASE == (k)) && lo <= (k) && (k) < hi)
#define SEAM(k) do { if (IN(k) && IN((k) + 1)) xcd_barrier(bar); } while (0)
    const int bx = (int)blockIdx.x;

    if (IN(0)) { p0_prologue(F, A); } SEAM(0);
    if (IN(1)) {
        { pg8::Gemm g{A_ZN, A_W1GU, NTOK, 2 * DFF, D}; pg8::StaticOrder S; S.init(NTOK, 2 * DFF, F.G, bx); pg8::EpiSwiGLU E{A_HID, DFF};
          pg8::gemm_phase<pg8::EpiSwiGLU, pg8::StaticOrder, true, true>(F.lds + RING_OFF, g, S, E); }
        __syncthreads();
        { int kple = PLE; asm volatile("" : "+s"(kple));
          pg8::Gemm g{A_PB, A_WPP, NTOK, D, kple}; pg8::StaticOrder S; S.init(NTOK, D, F.G, bx); pg8::EpiBf16 E{A_TP, D};
          pg8::gemm_phase<pg8::EpiBf16, pg8::StaticOrder, true, true>(F.lds + RING_OFF, g, S, E); }
    } SEAM(1);
    if (IN(2)) { pg8::Gemm g{A_HID, A_W1D, NTOK, D, DFF}; pg8::StaticOrder S; S.init(NTOK, D, F.G, bx); pg8::EpiRes E{A_x_p, A_x_s, A_out, D, NPR, 0.5f};
        pg8::gemm_phase<pg8::EpiRes, pg8::StaticOrder, true, true>(F.lds + RING_OFF, g, S, E); } SEAM(2);
    if (IN(3)) { norm_phase(F, A, A_out, A_out + (size_t)NPR * D, A_g_mix); } SEAM(3);
    if (IN(4)) { pg8::Gemm g{A_ZN, A_WIN, NTOK, INW, D}; pg8::StaticOrder S; S.init(NTOK, INW, F.G, bx); pg8::EpiBf16 E{A_U, INW};
        pg8::gemm_phase<pg8::EpiBf16, pg8::StaticOrder, true, true>(F.lds + RING_OFF, g, S, E); } SEAM(4);
    if (IN(5)) { for (int u = F.vcu; u < 1280; u += F.G) retloc_unit(F, A, u); for (int u = F.vcu; u < 640; u += F.G) attn_unit(F, A, u); } SEAM(5);
    if (IN(6)) { scan_phase(F, A); } SEAM(6);
    if (IN(7)) { for (int u = F.vcu; u < 1280; u += F.G) retout_unit(F, A, u); __syncthreads(); } SEAM(7);
    if (IN(8)) { pg8::Gemm g{A_MIX, A_WOUT, NTOK, D, D}; pg8::StaticOrder S; S.init(NTOK, D, F.G, bx); pg8::EpiRes E{A_out, A_out + (size_t)NPR * D, A_out, D, NPR, 1.0f};
        pg8::gemm_phase<pg8::EpiRes, pg8::StaticOrder, true, true>(F.lds + RING_OFF, g, S, E); } SEAM(8);
    if (IN(9)) { norm_phase(F, A, A_out, A_out + (size_t)NPR * D, A_g_ffn2); } SEAM(9);
    if (IN(10)) { pg8::Gemm g{A_ZN, A_W2GU, NTOK, 2 * DFF, D}; pg8::StaticOrder S; S.init(NTOK, 2 * DFF, F.G, bx); pg8::EpiSwiGLU E{A_HID, DFF};
        pg8::gemm_phase<pg8::EpiSwiGLU, pg8::StaticOrder, true, true>(F.lds + RING_OFF, g, S, E); } SEAM(10);
    if (IN(11)) { pg8::Gemm g{A_HID, A_W2D, NTOK, D, DFF}; pg8::StaticOrder S; S.init(NTOK, D, F.G, bx); pg8::EpiRes E{A_out, A_out + (size_t)NPR * D, A_out, D, NPR, 0.5f};
        pg8::gemm_phase<pg8::EpiRes, pg8::StaticOrder, true, true>(F.lds + RING_OFF, g, S, E); } SEAM(11);
    if (IN(12)) { norm_phase(F, A, A_out, A_out + (size_t)NPR * D, A_g_ple); } SEAM(12);
    if (IN(13)) { pg8::Gemm g{A_ZN, A_WPG, NTOK, D, D}; pg8::StaticOrder S; S.init(NTOK, D, F.G, bx); pg8::EpiPLE E{A_out, A_TP, D};
        pg8::gemm_phase<pg8::EpiPLE, pg8::StaticOrder, true, true>(F.lds + RING_OFF, g, S, E); }
#undef IN
#undef SEAM
}

extern "C" void kernel_launch(void* const* d_in, const int* in_sizes, int n_in, void* d_out, int out_size, void* d_ws, size_t ws_size, hipStream_t stream) {
    static int grid = 0;
    if (grid == 0) {
        if (n_in != 25 || (size_t)out_size != O_END || ws_size < WS_END) { fprintf(stderr, "kernel_launch: unexpected shapes (n_in %d, out %d, ws %zu); nothing launched\n", n_in, out_size, ws_size); grid = -1; return; }
        int dev = 0, cus = 0, per_cu = 0;
        if (hipGetDevice(&dev) != hipSuccess || hipDeviceGetAttribute(&cus, hipDeviceAttributeMultiprocessorCount, dev) != hipSuccess) { grid = -1; return; }
        if (hipFuncSetAttribute((const void*)fwd, hipFuncAttributeMaxDynamicSharedMemorySize, LDS_BYTES) != hipSuccess) { fprintf(stderr, "kernel_launch: hipFuncSetAttribute failed\n"); grid = -1; return; }
        if (hipOccupancyMaxActiveBlocksPerMultiprocessor(&per_cu, (const void*)fwd, NWAVES * 64, LDS_BYTES) != hipSuccess || per_cu < 1) { fprintf(stderr, "kernel_launch: occupancy query reports %d\n", per_cu); }
        (void)hipGetLastError();
        grid = cus;
    }
    if (grid < 0) return;
    if (hipMemsetAsync((char*)d_ws + WS_CTL, 0, CTL_ZERO_BYTES, stream) != hipSuccess) return;
    Args a{};
    for (int i = 0; i < 25; ++i) a.in[i] = (const float*)d_in[i];
    a.out = (float*)d_out; a.ws = (unsigned char*)d_ws;
#if MK_ONE_LAUNCH
    a.ph_lo = 0; a.ph_hi = N_PHASES;
    hipLaunchKernelGGL(fwd, dim3(grid), dim3(NWAVES * 64), LDS_BYTES, stream, a);
#else
    for (int p = 0; p < N_PHASES; ++p) { a.ph_lo = p; a.ph_hi = p + 1; hipLaunchKernelGGL(fwd, dim3(grid), dim3(NWAVES * 64), LDS_BYTES, stream, a); }
#endif
}
```

```cpp
#define CONV_PLACE 1
#include <hip/hip_runtime.h>
#include <cstdio>
#include <cstdint>
namespace pg8 {
#define PG8_LAS __attribute__((address_space(3)))
typedef unsigned short bf16_t;
typedef short bf16x8 __attribute__((ext_vector_type(8)));
typedef float f32x4 __attribute__((ext_vector_type(4)));
typedef unsigned u32x4 __attribute__((ext_vector_type(4)));
typedef int i32x8 __attribute__((ext_vector_type(8)));
typedef int i32x4 __attribute__((ext_vector_type(4)));
constexpr int BM = 256, BK = 64, HALF = 128, HTB = HALF * BK * 2  , STAGE_BYTES = 8 * HTB, NXCD = 8, WGM = 8;

__host__ __device__ __forceinline__ int lds_byte(int r, int c) { const int st = (r >> 4) * 2 + (c >> 5), rr = r & 15, cc = c & 31, ob = rr * 64 + cc * 2; return st * 1024 + (ob ^ (((ob >> 9) & 1) << 5)); }
__host__ __device__ __forceinline__ void stage_rc(int b, int& R, int& C) { const int st = b / 1024, sb = b % 1024, swz = sb ^ (((sb >> 9) & 1) << 5); R = (st >> 1) * 16 + swz / 64; C = (st & 1) * 32 + (swz % 64) / 2; }
__host__ __device__ __forceinline__ int perm32(int rho) { const int n = rho >> 4, i = rho & 15; return 8 * (i >> 2) + 4 * n + (i & 3); }

struct Unit { int pm, pn, kh, half; };
struct Gemm { const bf16_t* A; const bf16_t* Bt; int M, N, K, ld, ksplit; };

struct StaticOrder {
    int nM, nN, nwg, G, c;
    __host__ __device__ void init(int M, int N, int G_, int c_) { nM = M / BM; nN = N / BM; nwg = nM * nN; G = G_; c = c_; }
    __host__ __device__ bool next(int i, Unit& u) const {
        const long L = (long)i * G + c; if (L >= nwg) return false;
        int wgid = (int)L; { const int q = nwg / NXCD, r = nwg % NXCD, xcd = wgid % NXCD, off = wgid / NXCD; wgid = (xcd < r ? xcd * (q + 1) : r * (q + 1) + (xcd - r) * q) + off; }
        const int nig = WGM * nN, gid = wgid / nig, fm = gid * WGM, gsz = (nM - fm) < WGM ? (nM - fm) : WGM;
        u.pm = fm + ((wgid % nig) % gsz); u.pn = (wgid % nig) / gsz; u.kh = 0; u.half = 0; return true;
    }
    __device__ __forceinline__ void a_ready(const Unit&) const {}
    __device__ __forceinline__ void done(const Unit&) const {}
};

struct RangeOrder : StaticOrder {
    int i0, i1;
    __host__ __device__ bool next(int i, Unit& u) const { return (i0 + i < i1) && StaticOrder::next(i0 + i, u); }
};
struct HalfOrder : StaticOrder {
    __host__ __device__ bool next(int i, Unit& u) const { if (!StaticOrder::next(i, u)) return false; u.half = 1 + (u.pm & 1); u.pm >>= 1; return true; }
};
struct TailHalfOrder : StaticOrder {
    __host__ __device__ bool next(int i, Unit& u) const {
        const int nfull = nwg / G, R = nwg - nfull * G;
        if (i < nfull || R == 0 || 2 * R > G) return StaticOrder::next(i, u);
        if (i > nfull || c >= 2 * R) return false;
        StaticOrder t = *this; t.c = c >> 1; if (!t.StaticOrder::next(nfull, u)) return false; u.half = 1 + (c & 1); return true;
    }
};
struct SplitKOrder {
    int nN, G, c;
    __host__ __device__ void init(int N, int G_, int c_) { nN = N / BM; G = G_; c = c_; }
    __host__ __device__ bool next(int i, Unit& u) const { const long L = (long)i * G + c; if (L >= 16L * nN) return false; const int x = (int)(L & 7), j = (int)((L >> 3) & 31), blk = (int)(L >> 8); u.pm = j & 7; u.kh = x & 1; u.pn = 16 * blk + 4 * (x >> 1) + (j >> 3); u.half = 0; return true; }
    __device__ __forceinline__ void a_ready(const Unit&) const {}
    __device__ __forceinline__ void done(const Unit&) const {}
};

__device__ __forceinline__ unsigned cvt_pk_bf16(float lo, float hi) { unsigned r; asm volatile("v_cvt_pk_bf16_f32 %0, %1, %2" : "=v"(r) : "v"(lo), "v"(hi)); return r; }
typedef float f32x2 __attribute__((ext_vector_type(2)));
typedef __bf16 bf16x2_t __attribute__((ext_vector_type(2)));
__device__ __forceinline__ unsigned cvtpk(float lo, float hi) { f32x2 v = {lo, hi}; bf16x2_t b = __builtin_convertvector(v, bf16x2_t); return __builtin_bit_cast(unsigned, b); }
__device__ __forceinline__ float sigmoid_f(float g) { return __builtin_amdgcn_rcpf(1.0f + __builtin_amdgcn_exp2f(-1.4426950408889634f * g)); }
__device__ __forceinline__ float silu_f(float g) { return g * sigmoid_f(g); }
__device__ __forceinline__ f32x4 sigmoid4(const f32x4 g) {
    const f32x4 t = g * (-1.4426950408889634f); f32x4 e; e[0] = __builtin_amdgcn_exp2f(t[0]); e[1] = __builtin_amdgcn_exp2f(t[1]); e[2] = __builtin_amdgcn_exp2f(t[2]); e[3] = __builtin_amdgcn_exp2f(t[3]);
    const f32x4 d = e + 1.0f; f32x4 r; r[0] = __builtin_amdgcn_rcpf(d[0]); r[1] = __builtin_amdgcn_rcpf(d[1]); r[2] = __builtin_amdgcn_rcpf(d[2]); r[3] = __builtin_amdgcn_rcpf(d[3]); return r; }
__device__ __forceinline__ f32x4 swiglu4(const f32x4 g, const f32x4 u, float s) {
    const f32x4 t = g * (-1.4426950408889634f); f32x4 e; e[0] = __builtin_amdgcn_exp2f(t[0]); e[1] = __builtin_amdgcn_exp2f(t[1]); e[2] = __builtin_amdgcn_exp2f(t[2]); e[3] = __builtin_amdgcn_exp2f(t[3]);
    const f32x4 d = e + 1.0f; f32x4 r; r[0] = __builtin_amdgcn_rcpf(d[0]); r[1] = __builtin_amdgcn_rcpf(d[1]); r[2] = __builtin_amdgcn_rcpf(d[2]); r[3] = __builtin_amdgcn_rcpf(d[3]);
    return (g * r) * (u * s); }

struct EpiBf16 {
    static constexpr bool PERM = true, AFTER_DRAIN = false;
    bf16_t* O; int ldc; const float* rstd;
    __device__ __forceinline__ void operator()(const f32x4 (&acc)[2][2][4][2], const Unit& u, int wr, int wc, int fr, int fq) const {
        const int row0 = u.pm * BM + wr * 64 + fr, col0 = u.pn * BM + wc * 32 + 8 * fq;
        float rsv[2][4];
#pragma unroll
        for (int ai = 0; ai < 2; ++ai)
#pragma unroll
            for (int m = 0; m < 4; ++m) rsv[ai][m] = rstd ? rstd[row0 + ai * HALF + m * 16] : 1.0f;
#pragma unroll
        for (int ai = 0; ai < 2; ++ai)
#pragma unroll
            for (int m = 0; m < 4; ++m) { bf16_t* rowp = O + (size_t)(row0 + ai * HALF + m * 16) * ldc + col0; const float rs = rsv[ai][m];
#pragma unroll
                for (int bj = 0; bj < 2; ++bj) { const f32x4 v0 = acc[ai][bj][m][0] * rs, v1 = acc[ai][bj][m][1] * rs;
                    u32x4 w; w.x = cvtpk(v0[0], v0[1]); w.y = cvtpk(v0[2], v0[3]); w.z = cvtpk(v1[0], v1[1]); w.w = cvtpk(v1[2], v1[3]);
                    *(u32x4*)(rowp + bj * HALF) = w; } }
    }
};
template <bool I8IN> struct EpiU {
    static constexpr bool PERM = true, AFTER_DRAIN = false;
    bf16_t* O; int ldc; const float* rstd; const float* cs;
    __device__ __forceinline__ void operator()(const f32x4 (&acc)[2][2][4][2], const Unit& u, int wr, int wc, int fr, int fq) const {
        const int tile = I8IN ? (u.pn < 8 ? u.pn : (u.pn < 12 ? u.pn + 2 : u.pn + 14)) : (u.pn < 2 ? u.pn + 8 : u.pn + 12);
        const int row0 = u.pm * BM + wr * 64 + fr, cc0 = u.pn * BM + wc * 32 + 8 * fq, col0 = tile * BM + wc * 32 + 8 * fq;
        f32x4 csv[2][2]; float rsv[2][4];
        if constexpr (I8IN) {
#pragma unroll
            for (int bj = 0; bj < 2; ++bj) { csv[bj][0] = *(const f32x4*)(cs + cc0 + bj * HALF); csv[bj][1] = *(const f32x4*)(cs + cc0 + bj * HALF + 4); } }
#pragma unroll
        for (int ai = 0; ai < 2; ++ai)
#pragma unroll
            for (int m = 0; m < 4; ++m) rsv[ai][m] = rstd[row0 + ai * HALF + m * 16];
#pragma unroll
        for (int ai = 0; ai < 2; ++ai)
#pragma unroll
            for (int m = 0; m < 4; ++m) { bf16_t* rowp = O + (size_t)(row0 + ai * HALF + m * 16) * ldc + col0; const float rs = rsv[ai][m];
#pragma unroll
                for (int bj = 0; bj < 2; ++bj) { f32x4 v0, v1;
                    if constexpr (I8IN) { v0 = __builtin_convertvector(__builtin_bit_cast(i32x4, acc[ai][bj][m][0]), f32x4) * (csv[bj][0] * rs); v1 = __builtin_convertvector(__builtin_bit_cast(i32x4, acc[ai][bj][m][1]), f32x4) * (csv[bj][1] * rs); }
                    else { v0 = acc[ai][bj][m][0] * rs; v1 = acc[ai][bj][m][1] * rs; }
                    u32x4 w; w.x = cvtpk(v0[0], v0[1]); w.y = cvtpk(v0[2], v0[3]); w.z = cvtpk(v1[0], v1[1]); w.w = cvtpk(v1[2], v1[3]);
                    *(u32x4*)(rowp + bj * HALF) = w; } }
    }
};
constexpr float F8_HSCALE = 8.0f, F8_WSCALE = 256.0f, F8_MAX = 448.0f;
__device__ __forceinline__ unsigned cvt4_fp8(float a, float b, float c, float d) {
    a = __builtin_amdgcn_fmed3f(a, -F8_MAX, F8_MAX); b = __builtin_amdgcn_fmed3f(b, -F8_MAX, F8_MAX); c = __builtin_amdgcn_fmed3f(c, -F8_MAX, F8_MAX); d = __builtin_amdgcn_fmed3f(d, -F8_MAX, F8_MAX);
    int r = 0; r = __builtin_amdgcn_cvt_pk_fp8_f32(a, b, r, false); r = __builtin_amdgcn_cvt_pk_fp8_f32(c, d, r, true); return (unsigned)r; }
template <bool F8OUT, bool I8IN = false> struct EpiSwiGLU {
    static constexpr bool PERM = true, AFTER_DRAIN = false;
    bf16_t* O; int ldc; const float* rstd; const float* csg; const float* csu;
    __device__ __forceinline__ void operator()(const f32x4 (&acc)[2][2][4][2], const Unit& u, int wr, int wc, int fr, int fq) const {
        typedef unsigned u32x2v __attribute__((ext_vector_type(2)));
        const int row0 = u.pm * BM + (u.half == 2 ? HALF : 0) + wr * 64 + fr, col0 = u.pn * HALF + wc * 32 + 8 * fq;
        f32x4 cg0, cg1, cu0, cu1;
        if constexpr (I8IN) { cg0 = *(const f32x4*)(csg + col0); cg1 = *(const f32x4*)(csg + col0 + 4); cu0 = *(const f32x4*)(csu + col0); cu1 = *(const f32x4*)(csu + col0 + 4); }
        float rsv[2][4];
#pragma unroll
        for (int ai = 0; ai < 2; ++ai)
#pragma unroll
            for (int m = 0; m < 4; ++m) rsv[ai][m] = rstd[row0 + ai * HALF + m * 16];
#pragma unroll
        for (int ai = 0; ai < 2; ++ai) if (ai == 0 || u.half == 0)
#pragma unroll
            for (int m = 0; m < 4; ++m) {
                const float rs = rsv[ai][m];
                f32x4 g0, g1, u0, u1;
                if constexpr (I8IN) { const f32x4 sg0 = cg0 * rs, sg1 = cg1 * rs, su0 = cu0 * rs, su1 = cu1 * rs;
                    g0 = __builtin_convertvector(__builtin_bit_cast(i32x4, acc[ai][0][m][0]), f32x4) * sg0; g1 = __builtin_convertvector(__builtin_bit_cast(i32x4, acc[ai][0][m][1]), f32x4) * sg1;
                    u0 = __builtin_convertvector(__builtin_bit_cast(i32x4, acc[ai][1][m][0]), f32x4) * su0; u1 = __builtin_convertvector(__builtin_bit_cast(i32x4, acc[ai][1][m][1]), f32x4) * su1; }
                else { g0 = acc[ai][0][m][0] * rs; g1 = acc[ai][0][m][1] * rs; u0 = acc[ai][1][m][0] * rs; u1 = acc[ai][1][m][1] * rs; }
                if constexpr (F8OUT) { unsigned char* rowp = (unsigned char*)O + (size_t)(row0 + ai * HALF + m * 16) * ldc + col0; const f32x4 h0 = swiglu4(g0, u0, F8_HSCALE), h1 = swiglu4(g1, u1, F8_HSCALE);
                    u32x2v w; w.x = cvt4_fp8(h0[0], h0[1], h0[2], h0[3]); w.y = cvt4_fp8(h1[0], h1[1], h1[2], h1[3]);
                    *(u32x2v*)rowp = w; }
                else { bf16_t* rowp = O + (size_t)(row0 + ai * HALF + m * 16) * ldc + col0; const f32x4 h0 = swiglu4(g0, u0, 1.0f), h1 = swiglu4(g1, u1, 1.0f);
                    u32x4 w; w.x = cvtpk(h0[0], h0[1]); w.y = cvtpk(h0[2], h0[3]); w.z = cvtpk(h1[0], h1[1]); w.w = cvtpk(h1[2], h1[3]);
                    *(u32x4*)rowp = w; } }
    }
};
template <bool RES_BF16, int SPLIT = (1 << 30)> struct EpiRes {
    static constexpr bool PERM = true, AFTER_DRAIN = false;
    const float* resf; const bf16_t* resb; bf16_t* hb; bf16_t* sb; int ldc; float scale; const float* resf2;
    __device__ __forceinline__ void operator()(const f32x4 (&acc)[2][2][4][2], const Unit& u, int wr, int wc, int fr, int fq) const {
        const int row0 = u.pm * BM + (u.half == 2 ? HALF : 0) + wr * 64 + fr, col0 = u.pn * BM + wc * 32 + 8 * fq;
        if (u.kh == 0) {
#pragma unroll
            for (int ai = 0; ai < 2; ++ai) if (ai == 0 || u.half == 0)
#pragma unroll
                for (int m = 0; m < 4; ++m) { const size_t off = (size_t)(row0 + ai * HALF + m * 16) * ldc + col0;
#pragma unroll
                    for (int bj = 0; bj < 2; ++bj) { f32x4 r0, r1;
                        if (RES_BF16) { const u32x4 w = *(const u32x4*)(resb + off + bj * HALF);
                            r0 = (f32x4){__uint_as_float(w.x << 16), __uint_as_float(w.x & 0xffff0000u), __uint_as_float(w.y << 16), __uint_as_float(w.y & 0xffff0000u)};
                            r1 = (f32x4){__uint_as_float(w.z << 16), __uint_as_float(w.z & 0xffff0000u), __uint_as_float(w.w << 16), __uint_as_float(w.w & 0xffff0000u)}; }
                        else { const float* rp = resf + off; if constexpr (SPLIT < (1 << 30)) { if (u.pm * BM >= SPLIT) rp = resf2 + (off - (size_t)SPLIT * ldc); }
                            r0 = *(const f32x4*)(rp + bj * HALF); r1 = *(const f32x4*)(rp + bj * HALF + 4); }
                        const f32x4 h0 = r0 + acc[ai][bj][m][0] * scale, h1 = r1 + acc[ai][bj][m][1] * scale;
                        u32x4 o; o.x = cvtpk(h0[0], h0[1]); o.y = cvtpk(h0[2], h0[3]); o.z = cvtpk(h1[0], h1[1]); o.w = cvtpk(h1[2], h1[3]);
                        *(u32x4*)(hb + off + bj * HALF) = o; }
                    asm volatile("" ::: "memory"); }
        } else {
#pragma unroll
            for (int ai = 0; ai < 2; ++ai)
#pragma unroll
                for (int m = 0; m < 4; ++m) { bf16_t* op = sb + (size_t)(row0 + ai * HALF + m * 16) * ldc + col0;
#pragma unroll
                    for (int bj = 0; bj < 2; ++bj) { const f32x4 p0 = acc[ai][bj][m][0] * scale, p1 = acc[ai][bj][m][1] * scale;
                        u32x4 o; o.x = cvtpk(p0[0], p0[1]); o.y = cvtpk(p0[2], p0[3]); o.z = cvtpk(p1[0], p1[1]); o.w = cvtpk(p1[2], p1[3]); *(u32x4*)(op + bj * HALF) = o; } }
        }
    }
};
template <bool I8IN> struct EpiPLE {
    static constexpr bool PERM = true, AFTER_DRAIN = false;
    const bf16_t* hb; float* out; const bf16_t* T; int ldc; const float* rstd; float dscale; const float* cs;
    __device__ __forceinline__ void operator()(const f32x4 (&acc)[2][2][4][2], const Unit& u, int wr, int wc, int fr, int fq) const {
        const int row0 = u.pm * BM + (u.half == 2 ? HALF : 0) + wr * 64 + fr, col0 = u.pn * BM + wc * 32 + 8 * fq;
        f32x4 csv[2][2]; float rsv[2][4];
        if constexpr (I8IN) {
#pragma unroll
            for (int bj = 0; bj < 2; ++bj) { csv[bj][0] = *(const f32x4*)(cs + col0 + bj * HALF); csv[bj][1] = *(const f32x4*)(cs + col0 + bj * HALF + 4); } }
#pragma unroll
        for (int ai = 0; ai < 2; ++ai)
#pragma unroll
            for (int m = 0; m < 4; ++m) rsv[ai][m] = rstd[row0 + ai * HALF + m * 16] * dscale;
#pragma unroll
        for (int ai = 0; ai < 2; ++ai) if (ai == 0 || u.half == 0)
#pragma unroll
            for (int m = 0; m < 4; ++m) { const size_t off = (size_t)(row0 + ai * HALF + m * 16) * ldc + col0; const float rs = rsv[ai][m];
#pragma unroll
                for (int bj = 0; bj < 2; ++bj) { const size_t o = off + bj * HALF; const u32x4 hw = *(const u32x4*)(hb + o), tw = *(const u32x4*)(T + o); f32x4 a0, a1;
                    if constexpr (I8IN) { a0 = __builtin_convertvector(__builtin_bit_cast(i32x4, acc[ai][bj][m][0]), f32x4) * (csv[bj][0] * rs);
                                          a1 = __builtin_convertvector(__builtin_bit_cast(i32x4, acc[ai][bj][m][1]), f32x4) * (csv[bj][1] * rs); }
                    else { a0 = acc[ai][bj][m][0] * rs; a1 = acc[ai][bj][m][1] * rs; }
                    const f32x4 h0 = (f32x4){__uint_as_float(hw.x << 16), __uint_as_float(hw.x & 0xffff0000u), __uint_as_float(hw.y << 16), __uint_as_float(hw.y & 0xffff0000u)};
                    const f32x4 h1 = (f32x4){__uint_as_float(hw.z << 16), __uint_as_float(hw.z & 0xffff0000u), __uint_as_float(hw.w << 16), __uint_as_float(hw.w & 0xffff0000u)};
                    const f32x4 t0 = (f32x4){__uint_as_float(tw.x << 16), __uint_as_float(tw.x & 0xffff0000u), __uint_as_float(tw.y << 16), __uint_as_float(tw.y & 0xffff0000u)};
                    const f32x4 t1 = (f32x4){__uint_as_float(tw.z << 16), __uint_as_float(tw.z & 0xffff0000u), __uint_as_float(tw.w << 16), __uint_as_float(tw.w & 0xffff0000u)};
                    const f32x4 y0 = h0 + sigmoid4(a0) * t0, y1 = h1 + sigmoid4(a1) * t1;
                    *(f32x4*)(out + o) = y0; *(f32x4*)(out + o + 4) = y1; }
                asm volatile("" ::: "memory"); }
    }
};

template <class Epi, class Sched, bool ALIGN_EPI = false, bool SP2 = false, bool F8 = false, bool MH = false, bool I8 = false>
__device__ __forceinline__ void gemm_phase(PG8_LAS unsigned char* lds, const Gemm g, const Sched& S, const Epi& E) {
    const int tid = threadIdx.x, wid = __builtin_amdgcn_readfirstlane(tid >> 6), lane = tid & 63, wr = wid >> 2, wc = wid & 3, fr = lane & 15, fq = lane >> 4;
    const int K = g.K, ntot = K / BK, ld = g.ld;
    unsigned voffA[2], voffB[2];
#pragma unroll
    for (int i = 0; i < 2; ++i) { int R, C; stage_rc(tid * 16 + i * 8192, R, C); const int Rb = Epi::PERM ? ((R & ~31) + perm32(R & 31)) : R;
        voffA[i] = (unsigned)(R * ld + C) * 2u; voffB[i] = (unsigned)(Rb * ld + C) * 2u; }
    const size_t kstep = (size_t)(BK * 2);
    const size_t hstep = (size_t)HALF * ld * 2;
    const size_t tstep = 2 * hstep;
    const unsigned ldsw = (unsigned)wid * 1024u;
    const int aoff = lds_byte(wr * 64 + fr, fq * 8), boff = lds_byte(wc * 32 + fr, fq * 8);
#define PG8_SA(b, h) (((b) * 2 + (h)) * HTB)
#define PG8_SB(b, h) ((4 + (b) * 2 + (h)) * HTB)
#define PG8_STAGE(bufoff, gbase, voff) do { _Pragma("unroll") for (int _i = 0; _i < 2; ++_i) \
        __builtin_amdgcn_global_load_lds((const unsigned*)((const char*)(gbase) + (voff)[_i]), (PG8_LAS unsigned*)(lds + (bufoff) + ldsw + _i * 8192), 16, 0, 0); } while (0)
#define PG8_RD(off) (*(const PG8_LAS bf16x8*)(lds + (off)))
#define PG8_CAT(x, y) __builtin_bit_cast(i32x8, __builtin_shufflevector((x), (y), 0, 1, 2, 3, 4, 5, 6, 7, 8, 9, 10, 11, 12, 13, 14, 15))
#define PG8_LDA(dst, b, h) do { _Pragma("unroll") for (int m = 0; m < 4; ++m) { if constexpr (F8) dst##8[m] = PG8_CAT(PG8_RD(PG8_SA(b, h) + aoff + m * 2048), PG8_RD(PG8_SA(b, h) + aoff + m * 2048 + 1024)); \
        else { _Pragma("unroll") for (int k = 0; k < 2; ++k) dst[m][k] = PG8_RD(PG8_SA(b, h) + aoff + m * 2048 + k * 1024); } } } while (0)
#define PG8_LDB(dst, b, h) do { _Pragma("unroll") for (int n = 0; n < 2; ++n) { if constexpr (F8) dst##8[n] = PG8_CAT(PG8_RD(PG8_SB(b, h) + boff + n * 2048), PG8_RD(PG8_SB(b, h) + boff + n * 2048 + 1024)); \
        else { _Pragma("unroll") for (int k = 0; k < 2; ++k) dst[n][k] = PG8_RD(PG8_SB(b, h) + boff + n * 2048 + k * 1024); } } } while (0)
#define PG8_MMA(ai, bj, At, Bt) do { __builtin_amdgcn_s_setprio(1); _Pragma("unroll") for (int m = 0; m < 4; ++m) _Pragma("unroll") for (int n = 0; n < 2; ++n) { \
        if constexpr (F8) acc[ai][bj][m][n] = __builtin_amdgcn_mfma_scale_f32_16x16x128_f8f6f4(Bt##8[n], At##8[m], acc[ai][bj][m][n], 0, 0, 0, 0, 0, 0); \
        else if constexpr (I8) { _Pragma("unroll") for (int k = 0; k < 2; ++k) acc[ai][bj][m][n] = __builtin_bit_cast(f32x4, __builtin_amdgcn_mfma_i32_16x16x64_i8(__builtin_bit_cast(i32x4, Bt[n][k]), __builtin_bit_cast(i32x4, At[m][k]), __builtin_bit_cast(i32x4, acc[ai][bj][m][n]), 0, 0, 0)); } \
        else { _Pragma("unroll") for (int k = 0; k < 2; ++k) acc[ai][bj][m][n] = __builtin_amdgcn_mfma_f32_16x16x32_bf16(Bt[n][k], At[m][k], acc[ai][bj][m][n], 0, 0, 0); } } \
        __builtin_amdgcn_s_setprio(0); } while (0)
#define PG8_WAIT_V(n) asm volatile("s_waitcnt vmcnt(" #n ")" ::: "memory")
#define PG8_WAIT_L(n) asm volatile("s_waitcnt lgkmcnt(" #n ")" ::: "memory")
#define PG8_BAR __builtin_amdgcn_s_barrier()
#define PG8_SCHED __builtin_amdgcn_sched_barrier(0)
    Unit cur, nxt; int ui = 0;
    if (!S.next(0, cur)) return;
    f32x4 acc[2][2][4][2];
#pragma unroll
    for (int a = 0; a < 2; ++a)
#pragma unroll
        for (int b = 0; b < 2; ++b)
#pragma unroll
            for (int m = 0; m < 4; ++m)
#pragma unroll
                for (int n = 0; n < 2; ++n) acc[a][b][m][n] = (f32x4){0.f, 0.f, 0.f, 0.f};
    bf16x8 At[4][2], B0[2][2], B1[2][2]; i32x8 At8[4], B08[2], B18[2];
    const char* cA = (const char*)g.A + (size_t)cur.pm * tstep + (cur.kh ? (size_t)g.ksplit * (BK * 2) : (size_t)0) + (cur.half == 2 ? hstep : (size_t)0); const char* cB = (const char*)g.Bt + (size_t)cur.pn * tstep + (cur.kh ? (size_t)g.ksplit * (BK * 2) : (size_t)0);
    S.a_ready(cur);
    if constexpr (SP2) {
        PG8_STAGE(PG8_SB(0, 0), cB, voffB); PG8_STAGE(PG8_SB(0, 1), cB + hstep, voffB); PG8_STAGE(PG8_SA(0, 0), cA, voffA); PG8_STAGE(PG8_SA(0, 1), cA + hstep, voffA);
        if (wr == 1) PG8_BAR;
        PG8_WAIT_V(2); PG8_BAR;
        PG8_STAGE(PG8_SB(1, 0), cB + kstep, voffB); PG8_STAGE(PG8_SA(1, 0), cA + kstep, voffA); PG8_STAGE(PG8_SB(1, 1), cB + hstep + kstep, voffB);
        PG8_WAIT_V(6); PG8_BAR;
    } else {
        PG8_STAGE(PG8_SB(0, 0), cB, voffB); PG8_STAGE(PG8_SA(0, 0), cA, voffA); PG8_STAGE(PG8_SB(0, 1), cB + hstep, voffB); PG8_STAGE(PG8_SA(0, 1), cA + hstep, voffA);
        if (wr == 1) PG8_BAR;
        PG8_WAIT_V(4); PG8_BAR;
        PG8_STAGE(PG8_SB(1, 0), cB + kstep, voffB); PG8_STAGE(PG8_SA(1, 0), cA + kstep, voffA); PG8_STAGE(PG8_SB(1, 1), cB + hstep + kstep, voffB);
        PG8_WAIT_V(6); PG8_BAR;
    }
    for (;;) {
        const bool has_next = S.next(ui + 1, nxt); const int nt = g.ksplit ? (cur.kh ? ntot - g.ksplit : g.ksplit) : ntot; const bool mhalf = MH || cur.half != 0;
        const char* nA = has_next ? (const char*)g.A + (size_t)nxt.pm * tstep + (nxt.kh ? (size_t)g.ksplit * (BK * 2) : (size_t)0) + (nxt.half == 2 ? hstep : (size_t)0) : cA; const char* nB = has_next ? (const char*)g.Bt + (size_t)nxt.pn * tstep + (nxt.kh ? (size_t)g.ksplit * (BK * 2) : (size_t)0) : cB;
        for (int t = 0; t < nt; t += 2) {
            const bool last = (t == nt - 2);
            const char* a1 = cA + (size_t)(t + 1) * kstep;
            const char* a2 = last ? nA : cA + (size_t)(t + 2) * kstep; const char* b2 = last ? nB : cB + (size_t)(t + 2) * kstep;
            const char* a3 = a2 + kstep; const char* b3 = b2 + kstep;
            if (last && has_next) S.a_ready(nxt);
            if constexpr (SP2) {
            PG8_LDB(B0, 0, 0); PG8_LDB(B1, 0, 1); PG8_SCHED; PG8_LDA(At, 0, 0); PG8_STAGE(PG8_SA(1, 1), a1 + hstep, voffA);
            PG8_WAIT_V(8); PG8_WAIT_L(0); PG8_BAR; PG8_MMA(0, 0, At, B0); PG8_MMA(0, 1, At, B1); PG8_BAR; PG8_SCHED;
            if constexpr (!MH) PG8_LDA(At, 0, 1); PG8_STAGE(PG8_SB(0, 0), b2, voffB); PG8_STAGE(PG8_SB(0, 1), b2 + hstep, voffB); PG8_STAGE(PG8_SA(0, 0), a2, voffA);
            PG8_WAIT_V(8); PG8_WAIT_L(0); PG8_BAR; if constexpr (!MH) { if (!mhalf) { PG8_MMA(1, 0, At, B0); PG8_MMA(1, 1, At, B1); } } PG8_BAR; PG8_SCHED;
            PG8_LDB(B0, 1, 0); PG8_LDB(B1, 1, 1); PG8_SCHED; PG8_LDA(At, 1, 0); PG8_STAGE(PG8_SA(0, 1), a2 + hstep, voffA);
            PG8_WAIT_V(8); PG8_WAIT_L(0); PG8_BAR; PG8_MMA(0, 0, At, B0); PG8_MMA(0, 1, At, B1); PG8_BAR; PG8_SCHED;
            if constexpr (!MH) PG8_LDA(At, 1, 1); PG8_STAGE(PG8_SB(1, 0), b3, voffB); PG8_STAGE(PG8_SB(1, 1), b3 + hstep, voffB); PG8_STAGE(PG8_SA(1, 0), a3, voffA);
            PG8_WAIT_V(8); PG8_WAIT_L(0); PG8_BAR; if constexpr (!MH) { if (!mhalf) { PG8_MMA(1, 0, At, B0); PG8_MMA(1, 1, At, B1); } } PG8_BAR; PG8_SCHED;
            } else {
            PG8_LDB(B0, 0, 0); PG8_SCHED; PG8_LDA(At, 0, 0); PG8_STAGE(PG8_SA(1, 1), a1 + hstep, voffA);
            PG8_WAIT_L(8); PG8_BAR; PG8_WAIT_L(0); PG8_MMA(0, 0, At, B0); PG8_BAR; PG8_SCHED;
            PG8_LDB(B1, 0, 1); PG8_STAGE(PG8_SB(0, 0), b2, voffB);
            PG8_BAR; PG8_WAIT_L(0); PG8_MMA(0, 1, At, B1); PG8_BAR;
            PG8_LDA(At, 0, 1); PG8_STAGE(PG8_SA(0, 0), a2, voffA);
            PG8_BAR; PG8_WAIT_L(0); PG8_MMA(1, 0, At, B0); PG8_BAR; PG8_SCHED;
            PG8_STAGE(PG8_SB(0, 1), b2 + hstep, voffB);
            PG8_WAIT_V(6); PG8_BAR; PG8_MMA(1, 1, At, B1); PG8_BAR;
            PG8_LDB(B0, 1, 0); PG8_SCHED; PG8_LDA(At, 1, 0); PG8_STAGE(PG8_SA(0, 1), a2 + hstep, voffA);
            PG8_WAIT_L(8); PG8_BAR; PG8_WAIT_L(0); PG8_MMA(0, 0, At, B0); PG8_BAR; PG8_SCHED;
            PG8_LDB(B1, 1, 1); PG8_STAGE(PG8_SB(1, 0), b3, voffB);
            PG8_BAR; PG8_WAIT_L(0); PG8_MMA(0, 1, At, B1); PG8_BAR;
            PG8_LDA(At, 1, 1); PG8_STAGE(PG8_SA(1, 0), a3, voffA);
            PG8_BAR; PG8_WAIT_L(0); PG8_MMA(1, 0, At, B0); PG8_BAR; PG8_SCHED;
            PG8_STAGE(PG8_SB(1, 1), b3 + hstep, voffB);
            PG8_WAIT_V(6); PG8_BAR; PG8_MMA(1, 1, At, B1); PG8_BAR;
            }
        }
        if constexpr (ALIGN_EPI) { if (wr == 0) PG8_BAR; }
        if constexpr (!Epi::AFTER_DRAIN) { E(acc, cur, wr, wc, fr, fq); S.done(cur); }
        if (!has_next) break;
#pragma unroll
        for (int a = 0; a < 2; ++a)
#pragma unroll
            for (int b = 0; b < 2; ++b)
#pragma unroll
                for (int m = 0; m < 4; ++m)
#pragma unroll
                    for (int n = 0; n < 2; ++n) acc[a][b][m][n] = (f32x4){0.f, 0.f, 0.f, 0.f};
        cur = nxt; cA = nA; cB = nB; ++ui;
        if constexpr (ALIGN_EPI) { if (wr == 1) PG8_BAR; }
    }
    PG8_WAIT_V(0);
    if constexpr (!ALIGN_EPI) { if (wr == 0) PG8_BAR; }
    PG8_BAR;
    if constexpr (Epi::AFTER_DRAIN) { E.fused(acc, cur, wr, wc, fr, fq, lds, wid, lane); S.done(cur); }
#undef PG8_SA
#undef PG8_SB
#undef PG8_STAGE
#undef PG8_RD
#undef PG8_CAT
#undef PG8_LDA
#undef PG8_LDB
#undef PG8_MMA
#undef PG8_WAIT_V
#undef PG8_WAIT_L
#undef PG8_BAR
#undef PG8_SCHED
}

template <class Epi, class Sched>
__device__ __forceinline__ void gemm_phase_f8mh(PG8_LAS unsigned char* lds, const Gemm g, const Sched& S, const Epi& E) {
    const int tid = threadIdx.x, wid = __builtin_amdgcn_readfirstlane(tid >> 6), lane = tid & 63, wr = wid >> 2, wc = wid & 3, fr = lane & 15, fq = lane >> 4;
    const int nt = g.K / BK, ld = g.ld;
    unsigned voffA[2], voffB[2];
#pragma unroll
    for (int i = 0; i < 2; ++i) { int R, C; stage_rc(tid * 16 + i * 8192, R, C); const int Rb = Epi::PERM ? ((R & ~31) + perm32(R & 31)) : R;
        voffA[i] = (unsigned)(R * ld + C) * 2u; voffB[i] = (unsigned)(Rb * ld + C) * 2u; }
    const size_t kstep = (size_t)(BK * 2), hstep = (size_t)HALF * ld * 2, tstep = 2 * hstep;
    const unsigned ldsw = (unsigned)wid * 1024u;
    const int aoff = lds_byte(wr * 64 + fr, fq * 8), boff = lds_byte(wc * 32 + fr, fq * 8);
    constexpr unsigned SLOT = 3u * HTB;
#define F8_STAGE1(dstoff, gptr, voff) do { _Pragma("unroll") for (int _i = 0; _i < 2; ++_i) \
        __builtin_amdgcn_global_load_lds((const unsigned*)((const char*)(gptr) + (voff)[_i]), (PG8_LAS unsigned*)(lds + (dstoff) + ldsw + _i * 8192), 16, 0, 0); } while (0)
#define F8_STAGE3(so, gA, gB) do { F8_STAGE1((so), (gB), voffB); F8_STAGE1((so) + HTB, (gB) + hstep, voffB); F8_STAGE1((so) + 2 * HTB, (gA), voffA); } while (0)
#define F8_RD(off) (*(const PG8_LAS bf16x8*)(lds + (off)))
#define F8_CAT(x, y) __builtin_bit_cast(i32x8, __builtin_shufflevector((x), (y), 0, 1, 2, 3, 4, 5, 6, 7, 8, 9, 10, 11, 12, 13, 14, 15))
    Unit cur, nxt; int ui = 0;
    if (!S.next(0, cur)) return;
    f32x4 acc[2][2][4][2];
#pragma unroll
    for (int b = 0; b < 2; ++b)
#pragma unroll
        for (int m = 0; m < 4; ++m)
#pragma unroll
            for (int n = 0; n < 2; ++n) acc[0][b][m][n] = (f32x4){0.f, 0.f, 0.f, 0.f};
    const char* cA = (const char*)g.A + (size_t)cur.pm * tstep + (cur.half == 2 ? hstep : (size_t)0); const char* cB = (const char*)g.Bt + (size_t)cur.pn * tstep;
    F8_STAGE3(0u, cA, cB);
    if (wr == 1) __builtin_amdgcn_s_barrier();
    asm volatile("s_waitcnt vmcnt(0)" ::: "memory"); __builtin_amdgcn_s_barrier();
    F8_STAGE3(SLOT, cA + kstep, cB + kstep);
    __builtin_amdgcn_s_barrier();
    unsigned so = 0u;
    for (;;) {
        const bool has_next = S.next(ui + 1, nxt);
        const char* nA = has_next ? (const char*)g.A + (size_t)nxt.pm * tstep + (nxt.half == 2 ? hstep : (size_t)0) : cA; const char* nB = has_next ? (const char*)g.Bt + (size_t)nxt.pn * tstep : cB;
        for (int t = 0; t < nt; ++t) {
            const bool wrap = (t + 2 >= nt); const size_t k2 = (size_t)(wrap ? t + 2 - nt : t + 2) * kstep;
            const char* a2 = (wrap ? nA : cA) + k2; const char* b2 = (wrap ? nB : cB) + k2;
            const unsigned so2 = (so >= SLOT) ? so - SLOT : so + 2u * SLOT;
            i32x8 B08[2], B18[2], At8[4];
#pragma unroll
            for (int n = 0; n < 2; ++n) { B08[n] = F8_CAT(F8_RD(so + boff + n * 2048), F8_RD(so + boff + n * 2048 + 1024)); B18[n] = F8_CAT(F8_RD(so + HTB + boff + n * 2048), F8_RD(so + HTB + boff + n * 2048 + 1024)); }
            __builtin_amdgcn_sched_barrier(0);
#pragma unroll
            for (int m = 0; m < 4; ++m) At8[m] = F8_CAT(F8_RD(so + 2 * HTB + aoff + m * 2048), F8_RD(so + 2 * HTB + aoff + m * 2048 + 1024));
            F8_STAGE3(so2, a2, b2);
            asm volatile("s_waitcnt vmcnt(6)" ::: "memory"); asm volatile("s_waitcnt lgkmcnt(0)" ::: "memory"); __builtin_amdgcn_s_barrier();
            __builtin_amdgcn_s_setprio(1);
#pragma unroll
            for (int m = 0; m < 4; ++m)
#pragma unroll
                for (int n = 0; n < 2; ++n) { acc[0][0][m][n] = __builtin_amdgcn_mfma_scale_f32_16x16x128_f8f6f4(B08[n], At8[m], acc[0][0][m][n], 0, 0, 0, 0, 0, 0);
                    acc[0][1][m][n] = __builtin_amdgcn_mfma_scale_f32_16x16x128_f8f6f4(B18[n], At8[m], acc[0][1][m][n], 0, 0, 0, 0, 0, 0); }
            __builtin_amdgcn_s_setprio(0);
            __builtin_amdgcn_s_barrier(); __builtin_amdgcn_sched_barrier(0);
            so = (so >= 2u * SLOT) ? 0u : so + SLOT;
        }
        E(acc, cur, wr, wc, fr, fq);
        if (!has_next) break;
#pragma unroll
        for (int b = 0; b < 2; ++b)
#pragma unroll
            for (int m = 0; m < 4; ++m)
#pragma unroll
                for (int n = 0; n < 2; ++n) acc[0][b][m][n] = (f32x4){0.f, 0.f, 0.f, 0.f};
        cur = nxt; cA = nA; cB = nB; ++ui;
    }
    asm volatile("s_waitcnt vmcnt(0)" ::: "memory");
    if (wr == 0) __builtin_amdgcn_s_barrier();
    __builtin_amdgcn_s_barrier();
#undef F8_STAGE1
#undef F8_STAGE3
#undef F8_RD
#undef F8_CAT
}
}

constexpr int NWAVES = 8;
#ifndef MK_ONE_LAUNCH
#define MK_ONE_LAUNCH 1
#endif
constexpr int N_PHASES = 14;

constexpr int D = 4096, DFF = 11008, NTOK = 10240, NPR = 8192, SEQ = 4096, INW = 8704, PLE = 256;
constexpr int C_QA = 0, C_KA = 2048, C_VA = 2304, C_QR = 2560, C_KR = 3584, C_VR = 4608, C_GR = 6656;
constexpr int NPOS = 4160;
constexpr float EPS = 1e-6f;
constexpr size_t O_Y = 0, O_KP = 41943040, O_VP = 42008576, O_SP = 42074112, O_KS = 42598400, O_VS = 43646976, O_SS = 44695552, O_END = 53084160;

constexpr size_t MiB = 1u << 20;
constexpr size_t WS_CTL = 0, CTL_ZERO_BYTES = 1 * MiB;
constexpr size_t WS_ROPE = 2 * MiB;
constexpr size_t WS_PB = 6 * MiB;
constexpr size_t WS_CS = 14 * MiB;
constexpr size_t WS_RSTD = 12 * MiB;
constexpr size_t WS_W1GU = 16 * MiB, WS_W1D = 188 * MiB, WS_WIN = 274 * MiB, WS_WOUT = 342 * MiB, WS_W2GU = 374 * MiB, WS_W2D = 546 * MiB, WS_WPG = 632 * MiB, WS_WPP = 664 * MiB;
constexpr size_t WS_ZN = 666 * MiB;
constexpr size_t WS_HID = 746 * MiB;
constexpr size_t WS_MIX = 961 * MiB;
constexpr size_t WS_TP = 1041 * MiB;
constexpr size_t WS_RS = 1121 * MiB;
constexpr size_t WS_STB = 1249 * MiB;
constexpr size_t WS_SB = 1313 * MiB;
constexpr size_t WS_HB = 1345 * MiB;
constexpr size_t WS_END = 1425 * MiB;
static_assert(WS_W1GU + (size_t)2 * DFF * D * 2 == WS_W1D && WS_W1D + (size_t)D * DFF * 2 == WS_WIN && WS_WIN + (size_t)INW * D * 2 == WS_WOUT && WS_WOUT + (size_t)D * D * 2 == WS_W2GU, "ws map 1");
static_assert(WS_W2GU + (size_t)2 * DFF * D * 2 == WS_W2D && WS_W2D + (size_t)D * DFF * 2 == WS_WPG && WS_WPG + (size_t)D * D * 2 == WS_WPP && WS_WPP + (size_t)D * PLE * 2 == WS_ZN, "ws map 2");
static_assert(WS_ZN + (size_t)NTOK * D * 2 == WS_HID && WS_HID + (size_t)NTOK * DFF * 2 == WS_MIX && WS_MIX + (size_t)NTOK * D * 2 == WS_TP && WS_TP + (size_t)NTOK * D * 2 == WS_RS, "ws map 3");
static_assert(WS_RS + (size_t)1024 * 32768 * 4 == WS_STB && WS_STB + (size_t)1024 * 32768 * 2 == WS_SB && WS_SB + (size_t)(NTOK - NPR) * D * 4 == WS_HB && WS_HB + (size_t)NTOK * D * 2 == WS_END && WS_ROPE + (size_t)NPOS * 64 * 8 <= WS_PB && WS_PB + (size_t)NTOK * PLE * 2 <= WS_RSTD && WS_RSTD + (size_t)NTOK * 4 <= WS_W1GU, "ws map 4");
constexpr int CW_BAR = 4096;
constexpr int CW_CM = 32768;

constexpr int RING_OFF = 0, RING_BYTES = 147456;
constexpr int LDSCTL_OFF = RING_BYTES, MISC_OFF = LDSCTL_OFF + 320;
constexpr int LDS_BYTES = 148480;
static_assert(MISC_OFF + 128 <= LDS_BYTES, "LDS map");

#define GAS __attribute__((address_space(1)))
#define LAS __attribute__((address_space(3)))
typedef unsigned short bf16;
typedef unsigned v4u __attribute__((ext_vector_type(4)));
typedef float f32x4 __attribute__((ext_vector_type(4)));
typedef short bf16x8 __attribute__((ext_vector_type(8)));
typedef GAS unsigned gu32;
typedef GAS unsigned long long gu64;
#define RLX_AGENT __ATOMIC_RELAXED, __HIP_MEMORY_SCOPE_AGENT
#define LDS_WAIT() asm volatile("s_waitcnt lgkmcnt(0)" ::: "memory")
#define VM_WAIT() asm volatile("s_waitcnt vmcnt(0)" ::: "memory")
__device__ __forceinline__ unsigned long long rt() { return __builtin_amdgcn_s_memrealtime(); }
__device__ __forceinline__ unsigned f2bf(float f) { unsigned u = __builtin_bit_cast(unsigned, f); return (u + 0x7fffu + ((u >> 16) & 1u)) >> 16; }
__device__ __forceinline__ unsigned pk2(float lo, float hi) { return f2bf(lo) | (f2bf(hi) << 16); }

#define XB_TMO      128
#define XB_XCNT(j)  (256  + 64 * (j))
#define XB_XSUB(j)  (1280 + 64 * (j))
#define XB_XGEN(j)  (2304 + 64 * (j))
#define XB_TOP      3328
#define XB_TOPGEN   3392
#define XCD_BAR_WORDS 3456
#define XB_SPIN_CAP (1u << 18)

__device__ __forceinline__ unsigned xb_ld(unsigned* p)              { return __hip_atomic_load(p, __ATOMIC_RELAXED, __HIP_MEMORY_SCOPE_AGENT); }
__device__ __forceinline__ unsigned xb_add(unsigned* p, unsigned v) { return __hip_atomic_fetch_add(p, v, __ATOMIC_RELAXED, __HIP_MEMORY_SCOPE_AGENT); }
__device__ __forceinline__ unsigned xb_xcc_id() { return (unsigned)__builtin_amdgcn_s_getreg((3 << 11) | 20) & 0xFu; }
#define XB_SPIN(cond, bar) do { unsigned _sp = 0; while (cond) { __builtin_amdgcn_s_sleep(1); \
    if ((++_sp & 255u) == 0u) { if (xb_ld(&(bar)[XB_TMO])) break; if (_sp > XB_SPIN_CAP) { atomicAdd(&(bar)[XB_TMO], 1u); break; } } } } while (0)

struct XcdBarrier {
    unsigned* bar; unsigned x;
    volatile LAS unsigned* st;
};

__device__ __forceinline__ XcdBarrier xcd_barrier_post(unsigned* bar, volatile LAS unsigned* st) {
    XcdBarrier b; b.bar = bar; b.x = xb_xcc_id(); b.st = st;
    if (threadIdx.x == 0) (void)xb_add(&bar[XB_XCNT(b.x)], 1u);
    return b;
}
__device__ __forceinline__ void xcd_barrier_complete(unsigned* bar, unsigned x, unsigned& nloc, unsigned& nx) {
    const unsigned G = gridDim.x * gridDim.y * gridDim.z;
    unsigned sum, cnt, mine, sp = 0u;
    for (;;) {
        sum = 0u; cnt = 0u; mine = 0u;
#pragma unroll
        for (unsigned j = 0; j < 16; ++j) { const unsigned c = xb_ld(&bar[XB_XCNT(j)]); sum += c; cnt += (c > 0u) ? 1u : 0u; mine = (j == x) ? c : mine; }
        if (sum == G) break;
        __builtin_amdgcn_s_sleep(1);
        if ((++sp & 255u) == 0u) { if (xb_ld(&bar[XB_TMO])) break; if (sp > XB_SPIN_CAP) { atomicAdd(&bar[XB_TMO], 1u); break; } }
    }
    nloc = mine > 0u ? mine : 1u; nx = cnt > 0u ? cnt : 1u;
}

__device__ __forceinline__ void xcd_barrier(const XcdBarrier& b) {
    asm volatile("s_waitcnt vmcnt(0)" ::: "memory");
    __syncthreads();
    if (threadIdx.x == 0) {
        unsigned* bar = b.bar;
        __builtin_amdgcn_s_waitcnt(0);
        unsigned nloc = b.st[0], nx = b.st[1];
        if (nloc == 0u) { xcd_barrier_complete(bar, b.x, nloc, nx); b.st[0] = nloc; b.st[1] = nx; }
        const unsigned old = xb_add(&bar[XB_XSUB(b.x)], 1u);
        const unsigned gen = old / nloc;
        if (old + 1u == (gen + 1u) * nloc) {
            __builtin_amdgcn_fence(__ATOMIC_RELEASE, "agent");
            asm volatile("s_waitcnt vmcnt(0)" ::: "memory");
            const unsigned og = xb_add(&bar[XB_TOP], 1u);
            const unsigned tg = og / nx;
            if (og + 1u == (tg + 1u) * nx) xb_add(&bar[XB_TOPGEN], 1u);
            else XB_SPIN(xb_ld(&bar[XB_TOPGEN]) == tg, bar);
            __builtin_amdgcn_fence(__ATOMIC_ACQUIRE, "agent");
            xb_add(&bar[XB_XGEN(b.x)], 1u);
            asm volatile("s_waitcnt vmcnt(0)" ::: "memory");
        } else {
            XB_SPIN(xb_ld(&bar[XB_XGEN(b.x)]) == gen, bar);
            __builtin_amdgcn_fence(__ATOMIC_ACQUIRE, "agent");
            asm volatile("s_waitcnt vmcnt(0)" ::: "memory");
        }
    }
    __syncthreads();
}


typedef float f32x16 __attribute__((ext_vector_type(16)));
typedef float f32x2 __attribute__((ext_vector_type(2)));
typedef short s16x4 __attribute__((ext_vector_type(4)));
typedef unsigned v2u __attribute__((ext_vector_type(2)));
#define MFMA32(a, b, c) __builtin_amdgcn_mfma_f32_32x32x16_bf16((a), (b), (c), 0, 0, 0)
#define MFMA16(a, b, c) __builtin_amdgcn_mfma_f32_16x16x32_bf16((a), (b), (c), 0, 0, 0)
using pg8::cvtpk;
using pg8::silu_f;

struct Args { const float* in[25]; float* out; unsigned char* ws; int ph_lo, ph_hi; };
struct Frame {
    LAS unsigned char* lds;
    volatile LAS unsigned* MISC;
    gu32* ctl;
    int tid, lane, wave;
    int vcu, G;
};
#define A_x_p      (A.in[0])
#define A_x_s      (A.in[1])
#define A_cache_k  (A.in[2])
#define A_cache_v  (A.in[3])
#define A_state_in (A.in[4])
#define A_p_p      (A.in[5])
#define A_p_s      (A.in[6])
#define A_g_ffn1   (A.in[7])
#define A_w1g      (A.in[8])
#define A_w1u      (A.in[9])
#define A_w1d      (A.in[10])
#define A_g_mix    (A.in[11])
#define A_w_in     (A.in[12])
#define A_g_q      (A.in[13])
#define A_g_k      (A.in[14])
#define A_sinks    (A.in[15])
#define A_g_ret    (A.in[16])
#define A_w_out    (A.in[17])
#define A_g_ffn2   (A.in[18])
#define A_w2g      (A.in[19])
#define A_w2u      (A.in[20])
#define A_w2d      (A.in[21])
#define A_g_ple    (A.in[22])
#define A_w_pg     (A.in[23])
#define A_w_pp     (A.in[24])
#define A_out      (A.out)
#define A_W1GU ((bf16*)(A.ws + WS_W1GU))
#define A_W1D  ((bf16*)(A.ws + WS_W1D))
#define A_WIN  ((bf16*)(A.ws + WS_WIN))
#define A_WOUT ((bf16*)(A.ws + WS_WOUT))
#define A_W2GU ((bf16*)(A.ws + WS_W2GU))
#define A_W2D  ((bf16*)(A.ws + WS_W2D))
#define A_WPG  ((bf16*)(A.ws + WS_WPG))
#define A_WPP  ((bf16*)(A.ws + WS_WPP))
#define A_ZN   ((bf16*)(A.ws + WS_ZN))
#define A_HID  ((bf16*)(A.ws + WS_HID))
#define A_U    ((bf16*)(A.ws + WS_HID))
#define A_MIX  ((bf16*)(A.ws + WS_MIX))
#define A_TP   ((bf16*)(A.ws + WS_TP))
#define A_PB   ((bf16*)(A.ws + WS_PB))
#define A_STB  ((bf16*)(A.ws + WS_STB))
#define A_RS   ((bf16*)(A.ws + WS_RS))
#define A_ROPE ((f32x2*)(A.ws + WS_ROPE))
#define A_SB   ((bf16*)(A.ws + WS_SB))
#define A_HB   ((bf16*)(A.ws + WS_HB))
#define A_RSTD ((float*)(A.ws + WS_RSTD))
#define A_CM2G ((unsigned*)(A.ws + WS_CTL) + CW_CM)
#define A_CM2U ((unsigned*)(A.ws + WS_CTL) + CW_CM + 11264)
#define A_CMPG ((unsigned*)(A.ws + WS_CTL) + CW_CM + 22528)
#define A_CM1G ((unsigned*)(A.ws + WS_CTL) + CW_CM + 26624)
#define A_CM1U ((unsigned*)(A.ws + WS_CTL) + CW_CM + 26624 + 11264)
#define A_CS1G ((float*)(A.ws + WS_CS) + 26624)
#define A_CS1U ((float*)(A.ws + WS_CS) + 26624 + 11264)
#define A_CSPG ((float*)(A.ws + WS_CS) + 22528)
#define A_CS2G ((float*)(A.ws + WS_CS))
#define A_CS2U ((float*)(A.ws + WS_CS) + 11264)
#define A_WINB ((bf16*)(A.ws + WS_WIN))
#define A_WINQ ((unsigned char*)(A.ws + WS_WIN + (size_t)3584 * D * 2))
#define A_CMWIN ((unsigned*)(A.ws + WS_CTL) + CW_CM + 49152)
#define A_CSWIN ((float*)(A.ws + WS_CS) + 49152)
#define A_RSTDQ ((float*)(A.ws + WS_RSTD) + 16384)

__device__ __forceinline__ float wave_sum(float v) {
#pragma unroll
    for (int o = 1; o < 64; o <<= 1) v += __shfl_xor(v, o);
    return v;
}
__device__ __forceinline__ void unpack8(const v4u w, float (&f)[8]) {
    f[0] = __uint_as_float(w.x << 16); f[1] = __uint_as_float(w.x & 0xffff0000u); f[2] = __uint_as_float(w.y << 16); f[3] = __uint_as_float(w.y & 0xffff0000u);
    f[4] = __uint_as_float(w.z << 16); f[5] = __uint_as_float(w.z & 0xffff0000u); f[6] = __uint_as_float(w.w << 16); f[7] = __uint_as_float(w.w & 0xffff0000u);
}
__device__ __forceinline__ v4u pack8(const float (&f)[8]) { v4u w; w.x = cvtpk(f[0], f[1]); w.y = cvtpk(f[2], f[3]); w.z = cvtpk(f[4], f[5]); w.w = cvtpk(f[6], f[7]); return w; }
__device__ __forceinline__ unsigned short bf1(float f) { return (unsigned short)(cvtpk(f, 0.f) & 0xffffu); }
__device__ __forceinline__ unsigned pack4_i8(float a, float b, float c, float d) {
    const int ia = (int)rintf(fminf(fmaxf(a, -127.f), 127.f)), ib = (int)rintf(fminf(fmaxf(b, -127.f), 127.f)), ic = (int)rintf(fminf(fmaxf(c, -127.f), 127.f)), id = (int)rintf(fminf(fmaxf(d, -127.f), 127.f));
    return (unsigned)(ia & 0xff) | ((unsigned)(ib & 0xff) << 8) | ((unsigned)(ic & 0xff) << 16) | ((unsigned)id << 24); }
__device__ __forceinline__ float log2_gamma(int h) {
    float r = -0.04580368961312479f;
    r = (h == 1) ? -0.02272007650008353f : r; r = (h == 2) ? -0.011315313227834146f : r; r = (h == 3) ? -0.005646563141142063f : r;
    r = (h == 4) ? -0.0028205190623786626f : r; r = (h == 5) ? -0.0014095702546713536f : r; r = (h == 6) ? -0.0007046129765893727f : r; r = (h == 7) ? -0.0003522634716290214f : r;
    return r;
}

constexpr int CVT_TP = 72, CVT_TBYTES = 64 * CVT_TP * 2;
__device__ __forceinline__ void cvt_load(const float* W, int N, int item, int lane, f32x4 (&v)[16], const float* g, int ldw = 0) {
    const int nn = N >> 6, kb = item / nn, nb = item - kb * nn, k0 = kb * 64, n0 = nb * 64; if (ldw == 0) ldw = N;
    const GAS f32x4* src = (const GAS f32x4*)(W + (size_t)(k0 + (lane >> 4) * 16) * ldw + n0 + 4 * (lane & 15));
    const size_t rs = (size_t)(ldw >> 2);
#pragma unroll
    for (int j = 0; j < 16; ++j) v[j] = src[(size_t)j * rs];
    if (g) { const GAS f32x4* gp = (const GAS f32x4*)(g + k0 + (lane >> 4) * 16);
#pragma unroll
        for (int j4 = 0; j4 < 4; ++j4) { const f32x4 gv = gp[j4]; v[4 * j4] = v[4 * j4] * gv[0]; v[4 * j4 + 1] = v[4 * j4 + 1] * gv[1]; v[4 * j4 + 2] = v[4 * j4 + 2] * gv[2]; v[4 * j4 + 3] = v[4 * j4 + 3] * gv[3]; } }
}
__device__ __forceinline__ void cvt_store(int K, int N, bf16* WT, int mode, int item, int lane, const f32x4 (&v)[16], LAS bf16* T) {
    const int nn = N >> 6, kb = item / nn, nb = item - kb * nn, k0 = kb * 64, n0 = nb * 64;
    const int kk = lane >> 4, c = lane & 15;
#pragma unroll
    for (int i = 0; i < 4; ++i) {
        v4u o0, o1;
        o0.x = cvtpk(v[0][i], v[1][i]); o0.y = cvtpk(v[2][i], v[3][i]); o0.z = cvtpk(v[4][i], v[5][i]); o0.w = cvtpk(v[6][i], v[7][i]);
        o1.x = cvtpk(v[8][i], v[9][i]); o1.y = cvtpk(v[10][i], v[11][i]); o1.z = cvtpk(v[12][i], v[13][i]); o1.w = cvtpk(v[14][i], v[15][i]);
        LAS bf16* t = T + (4 * c + i) * CVT_TP + 16 * kk;
        *(LAS v4u*)t = o0; *(LAS v4u*)(t + 8) = o1;
    }
    const int r8 = lane >> 3, p = lane & 7;
#pragma unroll
    for (int q = 0; q < 8; ++q) { const int n = 8 * q + r8, nabs = n0 + n;
        const v4u val = *(const LAS v4u*)(T + n * CVT_TP + 8 * p);
        const int drow = (mode == 0) ? nabs : ((nabs >> 7) * 256 + (nabs & 127) + (mode == 2 ? 128 : 0));
        *(GAS v4u*)(WT + (size_t)drow * K + k0 + 8 * p) = val; }
}
constexpr int CVT_TP8 = 80;
__device__ __forceinline__ void cvt_store_f8(int K, int N, unsigned char* WT, int item, int lane, const f32x4 (&v)[16], LAS unsigned char* T) {
    const int nn = N >> 6, kb = item / nn, nb = item - kb * nn, k0 = kb * 64, n0 = nb * 64;
    const int kk = lane >> 4, c = lane & 15; constexpr float S = pg8::F8_WSCALE;
#pragma unroll
    for (int i = 0; i < 4; ++i) { v4u o;
        o.x = pg8::cvt4_fp8(v[0][i] * S, v[1][i] * S, v[2][i] * S, v[3][i] * S); o.y = pg8::cvt4_fp8(v[4][i] * S, v[5][i] * S, v[6][i] * S, v[7][i] * S);
        o.z = pg8::cvt4_fp8(v[8][i] * S, v[9][i] * S, v[10][i] * S, v[11][i] * S); o.w = pg8::cvt4_fp8(v[12][i] * S, v[13][i] * S, v[14][i] * S, v[15][i] * S);
        *(LAS v4u*)(T + (4 * c + i) * CVT_TP8 + 16 * kk) = o; }
    const int r16 = lane >> 2, p = lane & 3;
#pragma unroll
    for (int q = 0; q < 4; ++q) { const int n = 16 * q + r16; const v4u val = *(const LAS v4u*)(T + n * CVT_TP8 + 16 * p);
        *(GAS v4u*)(WT + (size_t)(n0 + n) * K + k0 + 16 * p) = val; }
}
__device__ __forceinline__ void cvt_matrix_f8(const Frame& F, const float* W, int K, int N, unsigned char* WT, int gw, int NGW, const float* g = nullptr) {
    const int nitems = (K >> 6) * (N >> 6); LAS unsigned char* T = (LAS unsigned char*)(F.lds + RING_OFF + F.wave * CVT_TBYTES);
    for (int it = gw; it < nitems; it += 2 * NGW) { f32x4 v0[16], v1[16]; const bool two = it + NGW < nitems;
        cvt_load(W, N, it, F.lane, v0, g); if (two) cvt_load(W, N, it + NGW, F.lane, v1, g);
        cvt_store_f8(K, N, WT, it, F.lane, v0, T); if (two) cvt_store_f8(K, N, WT, it + NGW, F.lane, v1, T); }
}
__device__ __forceinline__ void colmax_matrix(const Frame& F, const float* W, int K, int N, unsigned* cm, int gw, int NGW, const float* g, int ldw = 0) {
    const int nitems = (K >> 6) * (N >> 6);
    for (int it = gw; it < nitems; it += NGW) { f32x4 v[16]; cvt_load(W, N, it, F.lane, v, g, ldw);
        const int nn = N >> 6, kb = it / nn, nb = it - kb * nn, n0 = nb * 64; f32x4 mx = (f32x4){0.f, 0.f, 0.f, 0.f};
#pragma unroll
        for (int j = 0; j < 16; ++j) { mx[0] = fmaxf(mx[0], fabsf(v[j][0])); mx[1] = fmaxf(mx[1], fabsf(v[j][1])); mx[2] = fmaxf(mx[2], fabsf(v[j][2])); mx[3] = fmaxf(mx[3], fabsf(v[j][3])); }
#pragma unroll
        for (int i = 0; i < 4; ++i) { mx[i] = fmaxf(mx[i], __shfl_xor(mx[i], 16)); mx[i] = fmaxf(mx[i], __shfl_xor(mx[i], 32)); }
        if (F.lane < 16) {
#pragma unroll
            for (int i = 0; i < 4; ++i) atomicMax(cm + n0 + 4 * F.lane + i, __float_as_uint(mx[i])); } }
}
__device__ __forceinline__ void cvt_store_i8(int K, int N, unsigned char* WT, int mode, int item, int lane, const f32x4 (&v)[16], LAS unsigned char* T, const unsigned* cm, float* cs) {
    const int nn = N >> 6, kb = item / nn, nb = item - kb * nn, k0 = kb * 64, n0 = nb * 64;
    const int kk = lane >> 4, c = lane & 15;
#pragma unroll
    for (int i = 0; i < 4; ++i) { const float mxv = fmaxf(__uint_as_float(cm[n0 + 4 * c + i]), 1e-30f), S = 127.0f / mxv; v4u o;
        if (kb == 0 && kk == 0) cs[n0 + 4 * c + i] = mxv * (1.0f / 127.0f);
        o.x = pack4_i8(v[0][i] * S, v[1][i] * S, v[2][i] * S, v[3][i] * S); o.y = pack4_i8(v[4][i] * S, v[5][i] * S, v[6][i] * S, v[7][i] * S);
        o.z = pack4_i8(v[8][i] * S, v[9][i] * S, v[10][i] * S, v[11][i] * S); o.w = pack4_i8(v[12][i] * S, v[13][i] * S, v[14][i] * S, v[15][i] * S);
        *(LAS v4u*)(T + (4 * c + i) * CVT_TP8 + 16 * kk) = o; }
    const int r16 = lane >> 2, p = lane & 3;
#pragma unroll
    for (int q = 0; q < 4; ++q) { const int n = 16 * q + r16, nabs = n0 + n; const v4u val = *(const LAS v4u*)(T + n * CVT_TP8 + 16 * p);
        const int drow = (mode == 0) ? nabs : ((nabs >> 7) * 256 + (nabs & 127) + (mode == 2 ? 128 : 0));
        *(GAS v4u*)(WT + (size_t)drow * K + k0 + 16 * p) = val; }
}
__device__ __forceinline__ void cvt_matrix_i8(const Frame& F, const float* W, int K, int N, unsigned char* WT, int mode, int gw, int NGW, const float* g, const unsigned* cm, float* cs, int ldw = 0) {
    const int nitems = (K >> 6) * (N >> 6); LAS unsigned char* T = (LAS unsigned char*)(F.lds + RING_OFF + F.wave * CVT_TBYTES);
    for (int it = gw; it < nitems; it += 2 * NGW) { f32x4 v0[16], v1[16]; const bool two = it + NGW < nitems;
        cvt_load(W, N, it, F.lane, v0, g, ldw); if (two) cvt_load(W, N, it + NGW, F.lane, v1, g, ldw);
        cvt_store_i8(K, N, WT, mode, it, F.lane, v0, T, cm, cs); if (two) cvt_store_i8(K, N, WT, mode, it + NGW, F.lane, v1, T, cm, cs); }
}
__device__ __forceinline__ void cvt_matrix(const Frame& F, const float* W, int K, int N, bf16* WT, int mode, int gw, int NGW, const float* g = nullptr, int ldw = 0) {
    const int nitems = (K >> 6) * (N >> 6); LAS bf16* T = (LAS bf16*)(F.lds + RING_OFF + F.wave * CVT_TBYTES);
    for (int it = gw; it < nitems; it += 2 * NGW) { f32x4 v0[16], v1[16]; const bool two = it + NGW < nitems;
        cvt_load(W, N, it, F.lane, v0, g, ldw); if (two) cvt_load(W, N, it + NGW, F.lane, v1, g, ldw);
        cvt_store(K, N, WT, mode, it, F.lane, v0, T); if (two) cvt_store(K, N, WT, mode, it + NGW, F.lane, v1, T); }
}
__device__ __forceinline__ void row_q8_rstd(const float* xrow, unsigned char* qrow, float* rstd, int lane) {
    f32x4 a[8], b[8]; float s = 0.f, amax = 0.f;
#pragma unroll
    for (int j = 0; j < 8; ++j) { const GAS f32x4* p = (const GAS f32x4*)(xrow + 8 * lane + 512 * j); a[j] = p[0]; b[j] = p[1];
        s += (a[j][0] * a[j][0] + a[j][1] * a[j][1]) + (a[j][2] * a[j][2] + a[j][3] * a[j][3]) + (b[j][0] * b[j][0] + b[j][1] * b[j][1]) + (b[j][2] * b[j][2] + b[j][3] * b[j][3]);
        amax = fmaxf(amax, fmaxf(fmaxf(fmaxf(fabsf(a[j][0]), fabsf(a[j][1])), fmaxf(fabsf(a[j][2]), fabsf(a[j][3]))), fmaxf(fmaxf(fabsf(b[j][0]), fabsf(b[j][1])), fmaxf(fabsf(b[j][2]), fabsf(b[j][3]))))); }
    s = wave_sum(s);
#pragma unroll
    for (int o = 1; o < 64; o <<= 1) amax = fmaxf(amax, __shfl_xor(amax, o));
    amax = fmaxf(amax, 1e-20f); const float inv = 127.0f / amax;
#pragma unroll
    for (int j = 0; j < 8; ++j) { v2u w; w.x = pack4_i8(a[j][0] * inv, a[j][1] * inv, a[j][2] * inv, a[j][3] * inv); w.y = pack4_i8(b[j][0] * inv, b[j][1] * inv, b[j][2] * inv, b[j][3] * inv);
        *(GAS v2u*)(qrow + 8 * lane + 512 * j) = w; }
    if (lane == 0) *rstd = amax * (1.0f / 127.0f) / sqrtf(s * (1.0f / D) + EPS);
}
__device__ __forceinline__ void x_rows_phase(const Frame& F, const Args& A) {
    const int gw = F.vcu * NWAVES + F.wave, NGW = F.G * NWAVES;
    for (int m = gw; m < NTOK; m += NGW) { const float* xr = (m < NPR) ? A_x_p + (size_t)m * D : A_x_s + (size_t)(m - NPR) * D; row_q8_rstd(xr, (unsigned char*)A_ZN + (size_t)m * D, A_RSTD + m, F.lane); }
}
constexpr float F8_ASCALE = 16.0f;
__device__ __forceinline__ void rstd_phase(const Frame& F, const Args& A, bool fix, unsigned char* a8 = nullptr, unsigned char* q8 = nullptr, float* rq = nullptr) {
    const int gw = F.vcu * NWAVES + F.wave, NGW = F.G * NWAVES, lane = F.lane;
    for (int m = gw; m < NTOK; m += NGW) { bf16* hrow = A_HB + (size_t)m * D; float s = 0.f, amax = 0.f; float x[8][8];
#pragma unroll
        for (int j = 0; j < 8; ++j) unpack8(*(const GAS v4u*)(hrow + 8 * lane + 512 * j), x[j]);
        if (fix && m >= NPR) { const bf16* sbrow = A_SB + (size_t)(m - NPR) * D;
#pragma unroll
            for (int j = 0; j < 8; ++j) { float p[8]; unpack8(*(const GAS v4u*)(sbrow + 8 * lane + 512 * j), p);
#pragma unroll
                for (int e = 0; e < 8; ++e) x[j][e] += p[e];
                const v4u w = pack8(x[j]); *(GAS v4u*)(hrow + 8 * lane + 512 * j) = w; unpack8(w, x[j]); } }
#pragma unroll
        for (int j = 0; j < 8; ++j)
#pragma unroll
            for (int e = 0; e < 8; ++e) { s += x[j][e] * x[j][e]; amax = fmaxf(amax, fabsf(x[j][e])); }
        s = wave_sum(s);
        float rs = 1.0f / sqrtf(s * (1.0f / D) + EPS); const float rs0 = rs;
        if (a8) {
#pragma unroll
            for (int j = 0; j < 8; ++j) { constexpr float S8 = F8_ASCALE; v2u w; w.x = pg8::cvt4_fp8(x[j][0] * S8, x[j][1] * S8, x[j][2] * S8, x[j][3] * S8); w.y = pg8::cvt4_fp8(x[j][4] * S8, x[j][5] * S8, x[j][6] * S8, x[j][7] * S8);
                *(GAS v2u*)(a8 + (size_t)m * D + 8 * lane + 512 * j) = w; } }
        if (q8) {
#pragma unroll
            for (int o = 1; o < 64; o <<= 1) amax = fmaxf(amax, __shfl_xor(amax, o));
            amax = fmaxf(amax, 1e-20f); const float inv = 127.0f / amax; rs *= amax * (1.0f / 127.0f);
#pragma unroll
            for (int j = 0; j < 8; ++j) { v2u w; w.x = pack4_i8(x[j][0] * inv, x[j][1] * inv, x[j][2] * inv, x[j][3] * inv); w.y = pack4_i8(x[j][4] * inv, x[j][5] * inv, x[j][6] * inv, x[j][7] * inv);
                *(GAS v2u*)(q8 + (size_t)m * D + 8 * lane + 512 * j) = w; } }
        if (lane == 0) { if (rq) { A_RSTD[m] = rs0; rq[m] = rs; } else A_RSTD[m] = rs; } }
}
#ifndef CONV_PLACE
#define CONV_PLACE 1
#endif
__device__ __forceinline__ void convert_set1(const Frame& F, const Args& A, int gw, int NGW) {
    cvt_matrix(F, A_w1d, DFF, D, A_W1D, 0, gw, NGW); cvt_matrix(F, A_w_in + C_KA, D, 512, A_WINB, 0, gw, NGW, A_g_mix, INW); cvt_matrix(F, A_w_in + C_KR, D, 3072, A_WINB + (size_t)512 * D, 0, gw, NGW, A_g_mix, INW);
    cvt_matrix_i8(F, A_w_in + C_QA, D, 2048, A_WINQ, 0, gw, NGW, A_g_mix, A_CMWIN, A_CSWIN, INW); cvt_matrix_i8(F, A_w_in + C_QR, D, 1024, A_WINQ + (size_t)2048 * D, 0, gw, NGW, A_g_mix, A_CMWIN + 2048, A_CSWIN + 2048, INW);
    cvt_matrix_i8(F, A_w_in + C_GR, D, 2048, A_WINQ + (size_t)3072 * D, 0, gw, NGW, A_g_mix, A_CMWIN + 3072, A_CSWIN + 3072, INW); cvt_matrix(F, A_w_out, D, D, A_WOUT, 0, gw, NGW);
    colmax_matrix(F, A_w2g, D, DFF, A_CM2G, gw, NGW, A_g_ffn2); colmax_matrix(F, A_w2u, D, DFF, A_CM2U, gw, NGW, A_g_ffn2);
    colmax_matrix(F, A_w_pg, D, D, A_CMPG, gw, NGW, A_g_ple); }
__device__ __forceinline__ void convert_set2(const Frame& F, const Args& A, int gw, int NGW) {
    cvt_matrix_i8(F, A_w2g, D, DFF, (unsigned char*)A_W2GU, 1, gw, NGW, A_g_ffn2, A_CM2G, A_CS2G); cvt_matrix_i8(F, A_w2u, D, DFF, (unsigned char*)A_W2GU, 2, gw, NGW, A_g_ffn2, A_CM2U, A_CS2U); }
__device__ __forceinline__ void convert_set4(const Frame& F, const Args& A, int gw, int NGW, bool wpg) {
    cvt_matrix_f8(F, A_w2d, DFF, D, (unsigned char*)A_W2D, gw, NGW); if (wpg) cvt_matrix_i8(F, A_w_pg, D, D, (unsigned char*)A_WPG, 0, gw, NGW, A_g_ple, A_CMPG, A_CSPG); }
__device__ __forceinline__ void p0_stage1(const Frame& F, const Args& A) { const int gw0 = F.vcu * NWAVES + F.wave, NGW0 = F.G * NWAVES; colmax_matrix(F, A_w1g, D, DFF, A_CM1G, gw0, NGW0, A_g_ffn1); }
__device__ __forceinline__ void p0_stage2(const Frame& F, const Args& A) { const int gw0 = F.vcu * NWAVES + F.wave, NGW0 = F.G * NWAVES;
    cvt_matrix_i8(F, A_w1g, D, DFF, (unsigned char*)A_W1GU, 1, gw0, NGW0, A_g_ffn1, A_CM1G, A_CS1G); colmax_matrix(F, A_w1u, D, DFF, A_CM1U, gw0, NGW0, A_g_ffn1); }
__device__ __forceinline__ void p0_prologue(const Frame& F, const Args& A) {
    const int gw0 = F.vcu * NWAVES + F.wave, NGW0 = F.G * NWAVES;
    cvt_matrix_i8(F, A_w1u, D, DFF, (unsigned char*)A_W1GU, 2, gw0, NGW0, A_g_ffn1, A_CM1U, A_CS1U); cvt_matrix(F, A_w_pp, PLE, D, A_WPP, 0, gw0, NGW0);
    colmax_matrix(F, A_w_in + C_QA, D, 2048, A_CMWIN, gw0, NGW0, A_g_mix, INW); colmax_matrix(F, A_w_in + C_QR, D, 1024, A_CMWIN + 2048, gw0, NGW0, A_g_mix, INW); colmax_matrix(F, A_w_in + C_GR, D, 2048, A_CMWIN + 3072, gw0, NGW0, A_g_mix, INW);
    x_rows_phase(F, A);
    const int gt = F.vcu * (NWAVES * 64) + F.tid, NGT = F.G * NWAVES * 64;
    for (int i = gt; i < NTOK * PLE / 8; i += NGT) { const size_t e = (size_t)i * 8; const float* src = (e < (size_t)NPR * PLE) ? A_p_p + e : A_p_s + (e - (size_t)NPR * PLE);
        const f32x4 a = *(const GAS f32x4*)src, b = *(const GAS f32x4*)(src + 4); v4u o; o.x = cvtpk(a[0], a[1]); o.y = cvtpk(a[2], a[3]); o.z = cvtpk(b[0], b[1]); o.w = cvtpk(b[2], b[3]);
        *(GAS v4u*)(A_PB + e) = o; }
    for (int e = gt; e < NPOS * 64; e += NGT) { const int pos = e >> 6, i = e & 63;
        const double ang = (double)pos * exp2((double)i * (-13.287712379549449 / 64.0));
        const double k = rint(ang * 0.63661977236758134); double r = fma(-k, 1.5707963267948966, ang); r = fma(-k, 6.123233995736766e-17, r);
        const int q = ((int)k) & 3; const double r2 = r * r;
        const double sn = r * (1.0 + r2 * (-1.0 / 6 + r2 * (1.0 / 120 + r2 * (-1.0 / 5040 + r2 * (1.0 / 362880 + r2 * (-1.0 / 39916800 + r2 * (1.0 / 6227020800.0)))))));
        const double cs = 1.0 + r2 * (-0.5 + r2 * (1.0 / 24 + r2 * (-1.0 / 720 + r2 * (1.0 / 40320 + r2 * (-1.0 / 3628800 + r2 * (1.0 / 479001600.0 + r2 * (-1.0 / 87178291200.0)))))));
        const double c = (q == 0) ? cs : (q == 1) ? -sn : (q == 2) ? -cs : sn, s = (q == 0) ? sn : (q == 1) ? cs : (q == 2) ? -sn : -cs;
        A_ROPE[e] = (f32x2){(float)c, (float)s}; }
}

constexpr int AT_KS = 0, AT_KP = 72, AT_VT = 27648, AT_VP = 200;
__device__ __forceinline__ void attn_unit(const Frame& F, const Args& A, int ua) {
    const int tid = F.tid, lane = F.lane, wave = F.wave;
    const bool prompt = ua < 512;
    const int b = prompt ? (ua >> 8) : ((ua - 512) >> 2), c = prompt ? ((ua >> 2) & 63) : 0, kvh = ua & 3;
    const int row0 = prompt ? b * SEQ + c * 64 : NPR + b * 64;
    LAS bf16* Ks = (LAS bf16*)(F.lds + AT_KS); LAS bf16* Vt = (LAS bf16*)(F.lds + AT_VT);
    __syncthreads();
    {   const int t = tid >> 3, dp = tid & 7;
        const f32x4 gk0 = *(const GAS f32x4*)(A_g_k + 8 * dp), gk1 = *(const GAS f32x4*)(A_g_k + 8 * dp + 4);
#pragma unroll
        for (int i = 0; i < 3; ++i) {
            float kv[8], vv[8]; bool donorm;
            if (prompt || i == 2) {
                const int kc = c - 2 + i; const bool valid = (!prompt) || kc >= 0;
                const int row = prompt ? b * SEQ + kc * 64 + t : row0 + t;
                if (valid) { const bf16* up = A_U + (size_t)row * INW + kvh * 64 + 8 * dp; unpack8(*(const GAS v4u*)(up + C_KA), kv); unpack8(*(const GAS v4u*)(up + C_VA), vv); }
                else {
#pragma unroll
                    for (int e = 0; e < 8; ++e) { kv[e] = 0.f; vv[e] = 0.f; } }
                donorm = true;
            } else {
                const size_t ci = ((size_t)(b * 128 + i * 64 + t) * 4 + kvh) * 64 + 8 * dp;
                const f32x4 k0 = *(const GAS f32x4*)(A_cache_k + ci), k1 = *(const GAS f32x4*)(A_cache_k + ci + 4), v0 = *(const GAS f32x4*)(A_cache_v + ci), v1 = *(const GAS f32x4*)(A_cache_v + ci + 4);
#pragma unroll
                for (int e = 0; e < 4; ++e) { kv[e] = k0[e]; kv[4 + e] = k1[e]; vv[e] = v0[e]; vv[4 + e] = v1[e]; }
                donorm = false;
            }
            float ss = 0.f;
#pragma unroll
            for (int e = 0; e < 8; ++e) ss += kv[e] * kv[e];
            ss += __shfl_xor(ss, 1); ss += __shfl_xor(ss, 2); ss += __shfl_xor(ss, 4);
            if (donorm) { const float rstd = 1.0f / sqrtf(ss * (1.0f / 64) + EPS);
#pragma unroll
                for (int e = 0; e < 4; ++e) { kv[e] = kv[e] * rstd * gk0[e]; kv[4 + e] = kv[4 + e] * rstd * gk1[e]; } }
            const int key = 64 * i + t;
            *(LAS v4u*)(Ks + key * AT_KP + 8 * dp) = pack8(kv);
#pragma unroll
            for (int e = 0; e < 8; ++e) Vt[(8 * dp + e) * AT_VP + (key ^ (8 * dp))] = bf1(vv[e]);
            float* ok = nullptr; float* ov = nullptr;
            if (prompt) { if (i == 2 && c >= 62) { const size_t o = ((size_t)(b * 128 + (c - 62) * 64 + t) * 4 + kvh) * 64 + 8 * dp; ok = A_out + O_KP + o; ov = A_out + O_VP + o; } }
            else if (i >= 1) { const size_t o = ((size_t)(b * 128 + (i - 1) * 64 + t) * 4 + kvh) * 64 + 8 * dp; ok = A_out + O_KS + o; ov = A_out + O_VS + o; }
            if (ok) { *(GAS f32x4*)ok = (f32x4){kv[0], kv[1], kv[2], kv[3]}; *(GAS f32x4*)(ok + 4) = (f32x4){kv[4], kv[5], kv[6], kv[7]};
                      *(GAS f32x4*)ov = (f32x4){vv[0], vv[1], vv[2], vv[3]}; *(GAS f32x4*)(ov + 4) = (f32x4){vv[4], vv[5], vv[6], vv[7]}; }
        }
    }
    __syncthreads();
    const int hh = kvh * 8 + wave; const float sink = A_sinks[hh];
    const int r = lane & 31, h = lane >> 5;
    const int kt_first = prompt ? (c >= 2 ? 0 : (2 - c) * 2) : 0;
    constexpr float L2E = 1.4426950408889634f;
#pragma unroll 1
    for (int qb = 0; qb < 2; ++qb) {
        const bf16* qrow = A_U + (size_t)(row0 + qb * 32 + r) * INW + C_QA + hh * 64 + 8 * h;
        float qf[4][8]; float ss = 0.f;
#pragma unroll
        for (int ks = 0; ks < 4; ++ks) { unpack8(*(const GAS v4u*)(qrow + 16 * ks), qf[ks]);
#pragma unroll
            for (int e = 0; e < 8; ++e) ss += qf[ks][e] * qf[ks][e]; }
        ss += __shfl_xor(ss, 32);
        const float sc = 0.125f / sqrtf(ss * (1.0f / 64) + EPS);
        bf16x8 Qf[4];
#pragma unroll
        for (int ks = 0; ks < 4; ++ks) { float t8[8];
            const f32x4 g0 = *(const GAS f32x4*)(A_g_q + 16 * ks + 8 * h), g1 = *(const GAS f32x4*)(A_g_q + 16 * ks + 8 * h + 4);
#pragma unroll
            for (int e = 0; e < 4; ++e) { t8[e] = qf[ks][e] * sc * g0[e]; t8[4 + e] = qf[ks][4 + e] * sc * g1[e]; }
            Qf[ks] = __builtin_bit_cast(bf16x8, pack8(t8)); }
        __builtin_amdgcn_sched_barrier(0);
        f32x16 S[6];
#pragma unroll
        for (int kt = 0; kt < 6; ++kt) {
#pragma unroll
            for (int i = 0; i < 16; ++i) S[kt][i] = 0.f;
#pragma unroll
            for (int ks = 0; ks < 4; ++ks) { const bf16x8 Af = *(const LAS bf16x8*)(Ks + (32 * kt + r) * AT_KP + 16 * ks + 8 * h); S[kt] = MFMA32(Af, Qf[ks], S[kt]); } }
        float mx = sink;
#pragma unroll
        for (int kt = 0; kt < 6; ++kt) if (kt >= kt_first) {
#pragma unroll
            for (int i = 0; i < 16; ++i) mx = fmaxf(mx, S[kt][i]); }
        mx = fmaxf(mx, __shfl_xor(mx, 32));
        float sum = 0.f;
#pragma unroll
        for (int kt = 0; kt < 6; ++kt) { const bool on = kt >= kt_first;
#pragma unroll
            for (int i = 0; i < 16; ++i) { const float p = on ? __builtin_amdgcn_exp2f((S[kt][i] - mx) * L2E) : 0.f; S[kt][i] = p; sum += p; } }
        sum += __shfl_xor(sum, 32);
        const float inv = 1.0f / (sum + __builtin_amdgcn_exp2f((sink - mx) * L2E));
        f32x16 O[2];
#pragma unroll
        for (int dt = 0; dt < 2; ++dt)
#pragma unroll
            for (int i = 0; i < 16; ++i) O[dt][i] = 0.f;
#pragma unroll
        for (int kt = 0; kt < 6; ++kt)
#pragma unroll
            for (int s = 0; s < 2; ++s) {
                float t8[8];
#pragma unroll
                for (int e = 0; e < 8; ++e) t8[e] = S[kt][8 * s + e];
                const bf16x8 B = __builtin_bit_cast(bf16x8, pack8(t8));
#pragma unroll
                for (int dt = 0; dt < 2; ++dt) { const LAS bf16* vp = Vt + (32 * dt + r) * AT_VP; const int sw = 8 * (((32 * dt + r) >> 3) & 7), k0 = 32 * kt + 16 * s + 4 * h;
                    const s16x4 lo = *(const LAS s16x4*)(vp + (k0 ^ sw)), hi = *(const LAS s16x4*)(vp + ((k0 + 8) ^ sw));
                    const bf16x8 Af = __builtin_shufflevector(lo, hi, 0, 1, 2, 3, 4, 5, 6, 7); O[dt] = MFMA32(Af, B, O[dt]); }
                __builtin_amdgcn_sched_barrier(0);
            }
        bf16* orow = A_MIX + (size_t)(row0 + qb * 32 + r) * D + hh * 64 + 4 * h;
#pragma unroll
        for (int dt = 0; dt < 2; ++dt)
#pragma unroll
            for (int rg = 0; rg < 4; ++rg) { v2u w; w.x = cvtpk(O[dt][4 * rg] * inv, O[dt][4 * rg + 1] * inv); w.y = cvtpk(O[dt][4 * rg + 2] * inv, O[dt][4 * rg + 3] * inv);
                *(GAS v2u*)(orow + 32 * dt + 8 * rg) = w; }
    }
}

__device__ __forceinline__ void rot_load(const Args& A, const bf16* src  , int pos, int dp, float (&o1)[8], float (&o2)[8]) {
    float x1[8], x2[8]; unpack8(*(const GAS v4u*)(src + 8 * dp), x1); unpack8(*(const GAS v4u*)(src + 64 + 8 * dp), x2);
    const GAS f32x4* tp = (const GAS f32x4*)(A_ROPE + (size_t)pos * 64 + 8 * dp);
#pragma unroll
    for (int e2 = 0; e2 < 4; ++e2) { const f32x4 cs = tp[e2];
        o1[2 * e2] = x1[2 * e2] * cs[0] - x2[2 * e2] * cs[1]; o2[2 * e2] = x2[2 * e2] * cs[0] + x1[2 * e2] * cs[1];
        o1[2 * e2 + 1] = x1[2 * e2 + 1] * cs[2] - x2[2 * e2 + 1] * cs[3]; o2[2 * e2 + 1] = x2[2 * e2 + 1] * cs[2] + x1[2 * e2 + 1] * cs[3]; }
}
constexpr float KSCALE = 0.088388347648318441f;
constexpr int RL_KT = 0, RL_P = 72, RL_VT = 18432;
__device__ __forceinline__ void retloc_unit(const Frame& F, const Args& A, int ur) {
    const int tid = F.tid, lane = F.lane, wave = F.wave;
    const bool prompt = ur < 1024;
    const int b = prompt ? (ur >> 9) : ((ur - 1024) >> 3), c = prompt ? ((ur >> 3) & 63) : 0, hh = ur & 7;
    const int row0 = prompt ? b * SEQ + c * 64 : NPR + b * 64, pos0 = prompt ? c * 64 : SEQ;
    const float l2g = log2_gamma(hh);
    LAS bf16* KT = (LAS bf16*)(F.lds + RL_KT); LAS bf16* VT = (LAS bf16*)(F.lds + RL_VT);
    __syncthreads();
    {   const int m = tid >> 3, dp = tid & 7; float o1[8], o2[8];
        rot_load(A, A_U + (size_t)(row0 + m) * INW + C_KR + hh * 128, pos0 + m, dp, o1, o2);
        const float sc = KSCALE * __builtin_amdgcn_exp2f((float)(63 - m) * l2g);
#pragma unroll
        for (int e = 0; e < 8; ++e) { KT[(8 * dp + e) * RL_P + (m ^ (8 * dp))] = bf1(o1[e] * sc); KT[(64 + 8 * dp + e) * RL_P + (m ^ (8 * dp))] = bf1(o2[e] * sc); }
#pragma unroll
        for (int i = 0; i < 4; ++i) { const int mm = 8 * wave + (lane & 7), vp = (lane >> 3) + 8 * i; float vv[8];
            unpack8(*(const GAS v4u*)(A_U + (size_t)(row0 + mm) * INW + C_VR + hh * 256 + 8 * vp), vv);
#pragma unroll
            for (int e = 0; e < 8; ++e) VT[(8 * vp + e) * RL_P + (mm ^ (8 * (lane >> 3)))] = bf1(vv[e]); }
    }
    __syncthreads();
    const int c16 = lane & 15, q4 = lane >> 4;
    f32x4 acc[8][2];
#pragma unroll
    for (int dt = 0; dt < 8; ++dt)
#pragma unroll
        for (int vt = 0; vt < 2; ++vt) acc[dt][vt] = (f32x4){0.f, 0.f, 0.f, 0.f};
    if (prompt) {
#pragma unroll
        for (int ks = 0; ks < 2; ++ks) { bf16x8 Bv[2];
#pragma unroll
            for (int vt = 0; vt < 2; ++vt) Bv[vt] = *(const LAS bf16x8*)(VT + (32 * wave + 16 * vt + c16) * RL_P + ((32 * ks + 8 * q4) ^ (8 * (((32 * wave + 16 * vt + c16) >> 3) & 7))));
#pragma unroll
            for (int dt = 0; dt < 8; ++dt) { const bf16x8 Af = *(const LAS bf16x8*)(KT + (16 * dt + c16) * RL_P + ((32 * ks + 8 * q4) ^ (8 * (((16 * dt + c16) >> 3) & 7))));
#pragma unroll
                for (int vt = 0; vt < 2; ++vt) acc[dt][vt] = MFMA16(Af, Bv[vt], acc[dt][vt]); } }
        bf16* rs = A_RS + (size_t)ur * 32768;
#pragma unroll
        for (int dt = 0; dt < 8; ++dt)
#pragma unroll
            for (int vt = 0; vt < 2; ++vt) { v2u w; w.x = cvtpk(acc[dt][vt][0], acc[dt][vt][1]); w.y = cvtpk(acc[dt][vt][2], acc[dt][vt][3]);
                *(GAS v2u*)(rs + (32 * wave + 16 * vt + c16) * 128 + 16 * dt + 4 * q4) = w; }
    } else {
#pragma unroll
        for (int ks = 0; ks < 2; ++ks) { bf16x8 Av[2];
#pragma unroll
            for (int vt = 0; vt < 2; ++vt) Av[vt] = *(const LAS bf16x8*)(VT + (32 * wave + 16 * vt + c16) * RL_P + ((32 * ks + 8 * q4) ^ (8 * (((32 * wave + 16 * vt + c16) >> 3) & 7))));
#pragma unroll
            for (int dt = 0; dt < 8; ++dt) { const bf16x8 Bk = *(const LAS bf16x8*)(KT + (16 * dt + c16) * RL_P + ((32 * ks + 8 * q4) ^ (8 * (((16 * dt + c16) >> 3) & 7))));
#pragma unroll
                for (int vt = 0; vt < 2; ++vt) acc[dt][vt] = MFMA16(Av[vt], Bk, acc[dt][vt]); } }
        const float g64 = __builtin_amdgcn_exp2f(64.0f * l2g);
        const size_t sb = (size_t)(b * 8 + hh) * 32768;
#pragma unroll
        for (int dt = 0; dt < 8; ++dt)
#pragma unroll
            for (int vt = 0; vt < 2; ++vt) { const size_t o = sb + (size_t)(16 * dt + c16) * 256 + 32 * wave + 16 * vt + 4 * q4;
                const f32x4 s = *(const GAS f32x4*)(A_state_in + o); *(GAS f32x4*)(A_out + O_SS + o) = s * g64 + acc[dt][vt]; }
    }
}
__device__ __forceinline__ void scan_phase(const Frame& F, const Args& A) {
    const int gt = F.vcu * (NWAVES * 64) + F.tid, NGT = F.G * NWAVES * 64;
    for (int i = gt; i < 16 * 8192; i += NGT) {
        const int ch = i >> 13, e4 = i & 8191, b = ch >> 3, hh = ch & 7;
        const float g64 = __builtin_amdgcn_exp2f(64.0f * log2_gamma(hh));
        f32x4 S = (f32x4){0.f, 0.f, 0.f, 0.f};
#pragma unroll 1
        for (int c0 = 0; c0 < 64; c0 += 8) {
            f32x4 loc[8];
#pragma unroll
            for (int j = 0; j < 8; ++j) { const v2u w = *(const GAS v2u*)(A_RS + (size_t)(b * 512 + (c0 + j) * 8 + hh) * 32768 + 4 * e4);
                loc[j] = (f32x4){__uint_as_float(w.x << 16), __uint_as_float(w.x & 0xffff0000u), __uint_as_float(w.y << 16), __uint_as_float(w.y & 0xffff0000u)}; }
#pragma unroll
            for (int j = 0; j < 8; ++j) { v2u w; w.x = cvtpk(S[0], S[1]); w.y = cvtpk(S[2], S[3]);
                *(GAS v2u*)(A_STB + (size_t)(b * 512 + (c0 + j) * 8 + hh) * 32768 + 4 * e4) = w; S = S * g64 + loc[j]; }
        }
        const int v = e4 >> 5, d0 = (e4 & 31) * 4;
        float* o = A_out + O_SP + (size_t)ch * 32768 + (size_t)d0 * 256 + v;
        o[0] = S[0]; o[256] = S[1]; o[512] = S[2]; o[768] = S[3];
    }
}
constexpr int RO_QP = 0, RO_KP = 17408, RO_DP = 136, RO_VT = 34816, RO_VP = 72, RO_PS = 71680, RO_PP = 72, RO_RED = 80896;
__device__ __forceinline__ void retout_unit(const Frame& F, const Args& A, int ur) {
    const int tid = F.tid, lane = F.lane, wave = F.wave;
    const bool prompt = ur < 1024;
    const int b = prompt ? (ur >> 9) : ((ur - 1024) >> 3), c = prompt ? ((ur >> 3) & 63) : 0, hh = ur & 7;
    const int row0 = prompt ? b * SEQ + c * 64 : NPR + b * 64, pos0 = prompt ? c * 64 : SEQ;
    const float l2g = log2_gamma(hh);
    LAS bf16* QP = (LAS bf16*)(F.lds + RO_QP); LAS bf16* KP = (LAS bf16*)(F.lds + RO_KP); LAS bf16* VT = (LAS bf16*)(F.lds + RO_VT); LAS bf16* PS = (LAS bf16*)(F.lds + RO_PS);
    LAS f32x2* RED = (LAS f32x2*)(F.lds + RO_RED);
    __syncthreads();
    {   const int m = tid >> 3, dp = tid & 7; float o1[8], o2[8];
        const bf16* urow = A_U + (size_t)(row0 + m) * INW;
        rot_load(A, urow + C_QR + hh * 128, pos0 + m, dp, o1, o2);
        *(LAS v4u*)(QP + m * RO_DP + 8 * dp) = pack8(o1); *(LAS v4u*)(QP + m * RO_DP + 64 + 8 * dp) = pack8(o2);
        rot_load(A, urow + C_KR + hh * 128, pos0 + m, dp, o1, o2);
#pragma unroll
        for (int e = 0; e < 8; ++e) { o1[e] *= KSCALE; o2[e] *= KSCALE; }
        *(LAS v4u*)(KP + m * RO_DP + 8 * dp) = pack8(o1); *(LAS v4u*)(KP + m * RO_DP + 64 + 8 * dp) = pack8(o2);
#pragma unroll
        for (int i = 0; i < 4; ++i) { const int mm = 8 * wave + (lane & 7), vp = (lane >> 3) + 8 * i; float vv[8];
            unpack8(*(const GAS v4u*)(A_U + (size_t)(row0 + mm) * INW + C_VR + hh * 256 + 8 * vp), vv);
#pragma unroll
            for (int e = 0; e < 8; ++e) VT[(8 * vp + e) * RO_VP + (mm ^ (8 * (lane >> 3)))] = bf1(vv[e]); }
    }
    __syncthreads();
    const int c16 = lane & 15, q4 = lane >> 4;
    {
        const int mt = wave >> 1;
#pragma unroll
        for (int t2 = 0; t2 < 2; ++t2) { const int lt = (wave & 1) * 2 + t2; f32x4 s = (f32x4){0.f, 0.f, 0.f, 0.f};
#pragma unroll
            for (int ks = 0; ks < 4; ++ks) { const bf16x8 Af = *(const LAS bf16x8*)(KP + (16 * mt + c16) * RO_DP + 32 * ks + 8 * q4), B = *(const LAS bf16x8*)(QP + (16 * lt + c16) * RO_DP + 32 * ks + 8 * q4);
                s = MFMA16(Af, B, s); }
            const int l = 16 * lt + c16, m0 = 16 * mt + 4 * q4; float p[4];
#pragma unroll
            for (int e = 0; e < 4; ++e) { const int dist = (l > m0 + e) ? (l - m0 - e) : (m0 + e - l); p[e] = s[e] * __builtin_amdgcn_exp2f((float)dist * l2g); }
            v2u w; w.x = cvtpk(p[0], p[1]); w.y = cvtpk(p[2], p[3]); *(LAS v2u*)(PS + l * RO_PP + m0) = w; }
    }
    __syncthreads();
    f32x4 acc[2][4];
#pragma unroll
    for (int vt = 0; vt < 2; ++vt)
#pragma unroll
        for (int lt = 0; lt < 4; ++lt) acc[vt][lt] = (f32x4){0.f, 0.f, 0.f, 0.f};
#pragma unroll
    for (int ks = 0; ks < 4; ++ks) { bf16x8 Af[2];
#pragma unroll
        for (int vt = 0; vt < 2; ++vt) { const int v = 32 * wave + 16 * vt + c16;
            if (prompt) Af[vt] = *(const GAS bf16x8*)(A_STB + (size_t)ur * 32768 + v * 128 + 32 * ks + 8 * q4);
            else { const float* sp = A_state_in + (size_t)(b * 8 + hh) * 32768 + (size_t)(32 * ks + 8 * q4) * 256 + v; float t8[8];
#pragma unroll
                for (int j = 0; j < 8; ++j) t8[j] = sp[j * 256];
                Af[vt] = __builtin_bit_cast(bf16x8, pack8(t8)); } }
#pragma unroll
        for (int lt = 0; lt < 4; ++lt) { const bf16x8 B = *(const LAS bf16x8*)(QP + (16 * lt + c16) * RO_DP + 32 * ks + 8 * q4);
#pragma unroll
            for (int vt = 0; vt < 2; ++vt) acc[vt][lt] = MFMA16(Af[vt], B, acc[vt][lt]); } }
#pragma unroll
    for (int lt = 0; lt < 4; ++lt) { const float qd = __builtin_amdgcn_exp2f((float)(16 * lt + c16 + 1) * l2g);
#pragma unroll
        for (int vt = 0; vt < 2; ++vt) acc[vt][lt] = acc[vt][lt] * qd; }
#pragma unroll
    for (int ks = 0; ks < 2; ++ks) { bf16x8 Af[2];
#pragma unroll
        for (int vt = 0; vt < 2; ++vt) Af[vt] = *(const LAS bf16x8*)(VT + (32 * wave + 16 * vt + c16) * RO_VP + ((32 * ks + 8 * q4) ^ (8 * (((32 * wave + 16 * vt + c16) >> 3) & 7))));
#pragma unroll
        for (int lt = 0; lt < 4; ++lt) { const bf16x8 B = *(const LAS bf16x8*)(PS + (16 * lt + c16) * RO_PP + 32 * ks + 8 * q4);
#pragma unroll
            for (int vt = 0; vt < 2; ++vt) acc[vt][lt] = MFMA16(Af[vt], B, acc[vt][lt]); } }
#pragma unroll
    for (int lt = 0; lt < 4; ++lt) { float s1 = 0.f, s2 = 0.f;
#pragma unroll
        for (int vt = 0; vt < 2; ++vt)
#pragma unroll
            for (int e = 0; e < 4; ++e) { const float x = acc[vt][lt][e]; s1 += x; s2 += x * x; }
        s1 += __shfl_xor(s1, 16); s2 += __shfl_xor(s2, 16); s1 += __shfl_xor(s1, 32); s2 += __shfl_xor(s2, 32);
        if (q4 == 0) RED[wave * 64 + 16 * lt + c16] = (f32x2){s1, s2}; }
    __syncthreads();
#pragma unroll
    for (int lt = 0; lt < 4; ++lt) { const int l = 16 * lt + c16; float s1 = 0.f, s2 = 0.f;
#pragma unroll
        for (int w = 0; w < 8; ++w) { const f32x2 t = RED[w * 64 + l]; s1 += t[0]; s2 += t[1]; }
        const float mean = s1 * (1.0f / 256), var = fmaxf(s2 * (1.0f / 256) - mean * mean, 0.f), rstd = 1.0f / sqrtf(var + EPS);
#pragma unroll
        for (int vt = 0; vt < 2; ++vt) { const int v0 = 32 * wave + 16 * vt + 4 * q4;
            const f32x4 gr = *(const GAS f32x4*)(A_g_ret + hh * 256 + v0);
            const v2u gw = *(const GAS v2u*)(A_U + (size_t)(row0 + l) * INW + C_GR + hh * 256 + v0);
            const float g0 = __uint_as_float(gw.x << 16), g1 = __uint_as_float(gw.x & 0xffff0000u), g2 = __uint_as_float(gw.y << 16), g3 = __uint_as_float(gw.y & 0xffff0000u);
            const f32x4 a = acc[vt][lt];
            v2u w; w.x = cvtpk((a[0] - mean) * rstd * gr[0] * silu_f(g0), (a[1] - mean) * rstd * gr[1] * silu_f(g1));
            w.y = cvtpk((a[2] - mean) * rstd * gr[2] * silu_f(g2), (a[3] - mean) * rstd * gr[3] * silu_f(g3));
            *(GAS v2u*)(A_MIX + (size_t)(row0 + l) * D + 2048 + hh * 256 + v0) = w; } }
}

__global__ void __launch_bounds__(NWAVES * 64, 2) fwd(Args args) {
    extern __shared__ __attribute__((aligned(16))) unsigned char lds[];
    Frame F;
    F.lds = (LAS unsigned char*)lds;
    F.MISC = (volatile LAS unsigned*)(F.lds + MISC_OFF);
    F.tid = threadIdx.x; F.lane = F.tid & 63; F.wave = __builtin_amdgcn_readfirstlane(F.tid >> 6);
    F.G = gridDim.x; { const int bx = blockIdx.x; F.vcu = (F.G % 8 == 0) ? (bx % 8) * (F.G / 8) + bx / 8 : bx; }
    const Args& A = args;
    F.ctl = (gu32*)(args.ws + WS_CTL);
    for (int u = F.tid; u < (LDS_BYTES - LDSCTL_OFF) / 4; u += NWAVES * 64) ((LAS unsigned*)(F.lds + LDSCTL_OFF))[u] = 0u;
    __syncthreads();
    XcdBarrier bar; bar.bar = (unsigned*)(F.ctl + CW_BAR); bar.x = 0; bar.st = nullptr;
    if (MK_ONE_LAUNCH) bar = xcd_barrier_post((unsigned*)(F.ctl + CW_BAR), F.MISC + 8);
    const int lo = args.ph_lo, hi = args.ph_hi;
#ifndef ONLY_PHASE
#define ONLY_PHASE -1
#endif
#define IN(k) ((ONLY_PHASE < 0 || ONLY_PHASE == (k)) && lo <= (k) && (k) < hi)
#define SEAM(k) do { if (IN(k) && IN((k) + 1)) xcd_barrier(bar); } while (0)
    const int bx = (int)blockIdx.x;

    if (IN(0)) { p0_stage1(F, A); xcd_barrier(bar); p0_stage2(F, A); xcd_barrier(bar); p0_prologue(F, A); } SEAM(0);
    if (IN(1)) {
        { pg8::Gemm g{A_ZN, A_W1GU, NTOK, 2 * DFF, D / 2, D / 2, 0}; pg8::StaticOrder S; S.init(NTOK, 2 * DFF, F.G, bx); pg8::EpiSwiGLU<false, true> E{A_HID, DFF, A_RSTD, A_CS1G, A_CS1U};
          pg8::gemm_phase<pg8::EpiSwiGLU<false, true>, pg8::StaticOrder, true, true, false, false, true>(F.lds + RING_OFF, g, S, E); }
        __syncthreads();
#if CONV_PLACE != 0
        {
          const int nwg1 = (NTOK / 256) * (2 * DFF / 256), rem = nwg1 % F.G; const bool conv = (rem == 0) || (bx >= rem); const int jc = (rem == 0) ? bx : bx - rem, nconv = (rem == 0) ? F.G : F.G - rem;
          if (conv) convert_set1(F, A, jc * NWAVES + F.wave, nconv * NWAVES);
          if (!conv) {
            int kple = PLE; asm volatile("" : "+s"(kple));
            pg8::Gemm g{A_PB, A_WPP, NTOK, D, kple, kple, 0}; pg8::StaticOrder S; S.init(NTOK, D, rem, bx); pg8::EpiBf16 E{A_TP, D, nullptr};
            pg8::gemm_phase<pg8::EpiBf16, pg8::StaticOrder, true, true>(F.lds + RING_OFF, g, S, E); } }
#endif
    } SEAM(1);
    if (IN(2)) { { pg8::Gemm g{A_HID, A_W1D, NPR, D, DFF, DFF, 0}; pg8::StaticOrder S; S.init(NPR, D, F.G, bx); pg8::EpiRes<false> E{A_x_p, nullptr, A_HB, nullptr, D, 0.5f, nullptr};
          pg8::gemm_phase<pg8::EpiRes<false>, pg8::StaticOrder, true, true>(F.lds + RING_OFF, g, S, E); }
        __syncthreads();
        { pg8::Gemm g{A_HID + (size_t)NPR * DFF, A_W1D, NTOK - NPR, D, DFF, DFF, ((DFF / 64 / 2 + 1) & ~1)}; pg8::SplitKOrder S; S.init(D, F.G, bx); pg8::EpiRes<false> E{A_x_s, nullptr, A_HB + (size_t)NPR * D, A_SB, D, 0.5f, nullptr};
          pg8::gemm_phase<pg8::EpiRes<false>, pg8::SplitKOrder, true, true>(F.lds + RING_OFF, g, S, E); } } SEAM(2);
    if (IN(3)) { rstd_phase(F, A, true, nullptr, (unsigned char*)A_ZN, A_RSTDQ); } SEAM(3);
    if (IN(4)) {
        const int nb4 = (NTOK / 256) * 14, ni4 = (NTOK / 256) * 20, rb = nb4 % F.G, ri = ni4 % F.G; const int bxi = (rb % 8 == 0) ? (bx + F.G - rb) % F.G : bx;
        { pg8::Gemm g{A_HB, A_WINB, NTOK, 3584, D, D, 0}; pg8::StaticOrder S; S.init(NTOK, 3584, F.G, bx); pg8::EpiU<false> E{A_U, INW, A_RSTD, nullptr};
          pg8::gemm_phase<pg8::EpiU<false>, pg8::StaticOrder, true, true>(F.lds + RING_OFF, g, S, E); }
        __syncthreads();
        { pg8::Gemm g{A_ZN, (const bf16*)A_WINQ, NTOK, 5120, D / 2, D / 2, 0}; pg8::StaticOrder S; S.init(NTOK, 5120, F.G, bxi); pg8::EpiU<true> E{A_U, INW, A_RSTDQ, A_CSWIN};
          pg8::gemm_phase<pg8::EpiU<true>, pg8::StaticOrder, true, true, false, false, true>(F.lds + RING_OFF, g, S, E); }
        __syncthreads();
#if CONV_PLACE != 0
        { const bool conv = (bx >= rb) && (bxi >= ri); int jc = 0, nconv = 0;
          for (int b = 0; b < F.G; ++b) { const int bi = (rb % 8 == 0) ? (b + F.G - rb) % F.G : b; const bool cv = (b >= rb) && (bi >= ri); if (cv) { if (b < bx) ++jc; ++nconv; } }
          if (conv) convert_set2(F, A, jc * NWAVES + F.wave, nconv * NWAVES);
          if (rb > 0 && ri > 0 && rb % 8 == 0) {
            if (bx < rb) cvt_matrix_i8(F, A_w_pg + 2688, D, 1408, (unsigned char*)A_WPG + (size_t)2688 * D, 0, bx * NWAVES + F.wave, rb * NWAVES, A_g_ple, A_CMPG + 2688, A_CSPG + 2688, D);
            else if (bxi < ri) cvt_matrix_i8(F, A_w_pg, D, 2688, (unsigned char*)A_WPG, 0, bxi * NWAVES + F.wave, ri * NWAVES, A_g_ple, A_CMPG, A_CSPG, D); } }
#endif
    } SEAM(4);
    if (IN(5)) { for (int u = F.vcu; u < 1280; u += F.G) retloc_unit(F, A, u); for (int u = F.vcu; u < 640; u += F.G) attn_unit(F, A, u); } SEAM(5);
    if (IN(6)) { scan_phase(F, A); } SEAM(6);
    if (IN(7)) { for (int u = F.vcu; u < 1280; u += F.G) retout_unit(F, A, u); __syncthreads(); } SEAM(7);
    if (IN(8)) { { pg8::Gemm g{A_MIX, A_WOUT, NPR, D, D, D, 0}; pg8::StaticOrder S; S.init(NPR, D, F.G, bx); pg8::EpiRes<true> E{nullptr, A_HB, A_HB, nullptr, D, 1.0f, nullptr};
          pg8::gemm_phase<pg8::EpiRes<true>, pg8::StaticOrder, true, true>(F.lds + RING_OFF, g, S, E); }
        __syncthreads();
        { pg8::Gemm g{A_MIX + (size_t)NPR * D, A_WOUT, NTOK - NPR, D, D, D, ((D / 64 / 2 + 1) & ~1)}; pg8::SplitKOrder S; S.init(D, F.G, bx); pg8::EpiRes<true> E{nullptr, A_HB + (size_t)NPR * D, A_HB + (size_t)NPR * D, A_SB, D, 1.0f, nullptr};
          pg8::gemm_phase<pg8::EpiRes<true>, pg8::SplitKOrder, true, true>(F.lds + RING_OFF, g, S, E); } } SEAM(8);
    if (IN(9)) { rstd_phase(F, A, true, nullptr, (unsigned char*)A_ZN); } SEAM(9);
    if (IN(10)) { { pg8::Gemm g{A_ZN, A_W2GU, NTOK, 2 * DFF, D / 2, D / 2, 0}; pg8::StaticOrder S; S.init(NTOK, 2 * DFF, F.G, bx); pg8::EpiSwiGLU<true, true> E{A_HID, DFF, A_RSTD, A_CS2G, A_CS2U};
        pg8::gemm_phase<pg8::EpiSwiGLU<true, true>, pg8::StaticOrder, true, true, false, false, true>(F.lds + RING_OFF, g, S, E); }
        __syncthreads();
        { const int nwg10 = (NTOK / 256) * (2 * DFF / 256), rem = nwg10 % F.G; const bool conv = (rem == 0) || (bx >= rem); const int jc = (rem == 0) ? bx : bx - rem, nconv = (rem == 0) ? F.G : F.G - rem;
          const int rb4 = ((NTOK / 256) * 14) % F.G, ri4 = ((NTOK / 256) * 20) % F.G;
          if (conv) convert_set4(F, A, jc * NWAVES + F.wave, nconv * NWAVES, !(rb4 > 0 && ri4 > 0 && rb4 % 8 == 0)); }
        if (((NTOK / 256) * (2 * DFF / 256)) % F.G == 0) {
          __syncthreads(); int kple = PLE; asm volatile("" : "+s"(kple));
          pg8::Gemm g{A_PB, A_WPP, NTOK, D, kple, kple, 0}; pg8::StaticOrder S; S.init(NTOK, D, F.G, bx); pg8::EpiBf16 E{A_TP, D, nullptr};
          pg8::gemm_phase<pg8::EpiBf16, pg8::StaticOrder, true, true>(F.lds + RING_OFF, g, S, E); }
    } SEAM(10);
    if (IN(11)) { constexpr float DS = 0.5f / (pg8::F8_HSCALE * pg8::F8_WSCALE);
        pg8::Gemm g{A_HID, A_W2D, NTOK, D, DFF / 2, DFF / 2, 0}; pg8::HalfOrder S; S.init(2 * NTOK, D, F.G, bx); pg8::EpiRes<true> E{nullptr, A_HB, A_HB, nullptr, D, DS, nullptr};
        pg8::gemm_phase_f8mh<pg8::EpiRes<true>, pg8::HalfOrder>(F.lds + RING_OFF, g, S, E); } SEAM(11);
    if (IN(12)) { rstd_phase(F, A, false, nullptr, (unsigned char*)A_ZN); } SEAM(12);
    if (IN(13)) {
        pg8::Gemm g{A_ZN, A_WPG, NTOK, D, D / 2, D / 2, 0}; pg8::TailHalfOrder S; S.init(NTOK, D, F.G, bx); pg8::EpiPLE<true> E{A_HB, A_out, A_TP, D, A_RSTD, 1.0f, A_CSPG};
        pg8::gemm_phase<pg8::EpiPLE<true>, pg8::TailHalfOrder, true, true, false, false, true>(F.lds + RING_OFF, g, S, E); }
#undef IN
#undef SEAM
}

extern "C" void kernel_launch(void* const* d_in, const int* in_sizes, int n_in, void* d_out, int out_size, void* d_ws, size_t ws_size, hipStream_t stream) {
    static int grid = 0;
    if (grid == 0) {
        if (n_in != 25 || (size_t)out_size != O_END || ws_size < WS_END) { fprintf(stderr, "kernel_launch: unexpected shapes (n_in %d, out %d, ws %zu); nothing launched\n", n_in, out_size, ws_size); grid = -1; return; }
        int dev = 0, cus = 0, per_cu = 0;
        if (hipGetDevice(&dev) != hipSuccess || hipDeviceGetAttribute(&cus, hipDeviceAttributeMultiprocessorCount, dev) != hipSuccess) { grid = -1; return; }
        if (hipFuncSetAttribute((const void*)fwd, hipFuncAttributeMaxDynamicSharedMemorySize, LDS_BYTES) != hipSuccess) { fprintf(stderr, "kernel_launch: hipFuncSetAttribute failed\n"); grid = -1; return; }
        if (hipOccupancyMaxActiveBlocksPerMultiprocessor(&per_cu, (const void*)fwd, NWAVES * 64, LDS_BYTES) != hipSuccess || per_cu < 1) { fprintf(stderr, "kernel_launch: occupancy query reports %d\n", per_cu); }
        (void)hipGetLastError();
        grid = cus;
    }
    if (grid < 0) return;
    if (hipMemsetAsync((char*)d_ws + WS_CTL, 0, CTL_ZERO_BYTES, stream) != hipSuccess) return;
    Args a{};
    for (int i = 0; i < 25; ++i) a.in[i] = (const float*)d_in[i];
    a.out = (float*)d_out; a.ws = (unsigned char*)d_ws;
#if MK_ONE_LAUNCH
    a.ph_lo = 0; a.ph_hi = N_PHASES;
    hipLaunchKernelGGL(fwd, dim3(grid), dim3(NWAVES * 64), LDS_BYTES, stream, a);
#else
    for (int p = 0; p < N_PHASES; ++p) { a.ph_lo = p; a.ph_hi = p + 1; hipLaunchKernelGGL(fwd, dim3(grid), dim3(NWAVES * 64), LDS_BYTES, stream, a); }
#endif
}
```

```cpp
#define CONV_PLACE 1
#include <hip/hip_runtime.h>
#include <cstdio>
#include <cstdint>
namespace pg8 {
#define PG8_LAS __attribute__((address_space(3)))
typedef unsigned short bf16_t;
typedef short bf16x8 __attribute__((ext_vector_type(8)));
typedef float f32x4 __attribute__((ext_vector_type(4)));
typedef unsigned u32x4 __attribute__((ext_vector_type(4)));
typedef int i32x8 __attribute__((ext_vector_type(8)));
typedef int i32x4 __attribute__((ext_vector_type(4)));
constexpr int BM = 256, BK = 64, HALF = 128, HTB = HALF * BK * 2  , STAGE_BYTES = 8 * HTB, NXCD = 8, WGM = 8;

__host__ __device__ __forceinline__ int lds_byte(int r, int c) { const int st = (r >> 4) * 2 + (c >> 5), rr = r & 15, cc = c & 31, ob = rr * 64 + cc * 2; return st * 1024 + (ob ^ (((ob >> 9) & 1) << 5)); }
__host__ __device__ __forceinline__ void stage_rc(int b, int& R, int& C) { const int st = b / 1024, sb = b % 1024, swz = sb ^ (((sb >> 9) & 1) << 5); R = (st >> 1) * 16 + swz / 64; C = (st & 1) * 32 + (swz % 64) / 2; }
__host__ __device__ __forceinline__ int perm32(int rho) { const int n = rho >> 4, i = rho & 15; return 8 * (i >> 2) + 4 * n + (i & 3); }

struct Unit { int pm, pn, kh, half; };
struct Gemm { const bf16_t* A; const bf16_t* Bt; int M, N, K, ld, ksplit; };

struct StaticOrder {
    int nM, nN, nwg, G, c;
    __host__ __device__ void init(int M, int N, int G_, int c_) { nM = M / BM; nN = N / BM; nwg = nM * nN; G = G_; c = c_; }
    __host__ __device__ bool next(int i, Unit& u) const {
        const long L = (long)i * G + c; if (L >= nwg) return false;
        int wgid = (int)L; { const int q = nwg / NXCD, r = nwg % NXCD, xcd = wgid % NXCD, off = wgid / NXCD; wgid = (xcd < r ? xcd * (q + 1) : r * (q + 1) + (xcd - r) * q) + off; }
        const int nig = WGM * nN, gid = wgid / nig, fm = gid * WGM, gsz = (nM - fm) < WGM ? (nM - fm) : WGM;
        u.pm = fm + ((wgid % nig) % gsz); u.pn = (wgid % nig) / gsz; u.kh = 0; u.half = 0; return true;
    }
    __device__ __forceinline__ void a_ready(const Unit&) const {}
    __device__ __forceinline__ void done(const Unit&) const {}
};

struct RangeOrder : StaticOrder {
    int i0, i1;
    __host__ __device__ bool next(int i, Unit& u) const { return (i0 + i < i1) && StaticOrder::next(i0 + i, u); }
};
struct HalfOrder : StaticOrder {
    __host__ __device__ bool next(int i, Unit& u) const { if (!StaticOrder::next(i, u)) return false; u.half = 1 + (u.pm & 1); u.pm >>= 1; return true; }
};
struct TailHalfOrder : StaticOrder {
    __host__ __device__ bool next(int i, Unit& u) const {
        const int nfull = nwg / G, R = nwg - nfull * G;
        if (i < nfull || R == 0 || 2 * R > G) return StaticOrder::next(i, u);
        if (i > nfull || c >= 2 * R) return false;
        StaticOrder t = *this; t.c = c >> 1; if (!t.StaticOrder::next(nfull, u)) return false; u.half = 1 + (c & 1); return true;
    }
};
struct SplitKOrder {
    int nN, G, c;
    __host__ __device__ void init(int N, int G_, int c_) { nN = N / BM; G = G_; c = c_; }
    __host__ __device__ bool next(int i, Unit& u) const { const long L = (long)i * G + c; if (L >= 16L * nN) return false; const int x = (int)(L & 7), j = (int)((L >> 3) & 31), blk = (int)(L >> 8); u.pm = j & 7; u.kh = x & 1; u.pn = 16 * blk + 4 * (x >> 1) + (j >> 3); u.half = 0; return true; }
    __device__ __forceinline__ void a_ready(const Unit&) const {}
    __device__ __forceinline__ void done(const Unit&) const {}
};

__device__ __forceinline__ unsigned cvt_pk_bf16(float lo, float hi) { unsigned r; asm volatile("v_cvt_pk_bf16_f32 %0, %1, %2" : "=v"(r) : "v"(lo), "v"(hi)); return r; }
typedef float f32x2 __attribute__((ext_vector_type(2)));
typedef __bf16 bf16x2_t __attribute__((ext_vector_type(2)));
__device__ __forceinline__ unsigned cvtpk(float lo, float hi) { f32x2 v = {lo, hi}; bf16x2_t b = __builtin_convertvector(v, bf16x2_t); return __builtin_bit_cast(unsigned, b); }
__device__ __forceinline__ float sigmoid_f(float g) { return __builtin_amdgcn_rcpf(1.0f + __builtin_amdgcn_exp2f(-1.4426950408889634f * g)); }
__device__ __forceinline__ float silu_f(float g) { return g * sigmoid_f(g); }
__device__ __forceinline__ f32x4 sigmoid4(const f32x4 g) {
    const f32x4 t = g * (-1.4426950408889634f); f32x4 e; e[0] = __builtin_amdgcn_exp2f(t[0]); e[1] = __builtin_amdgcn_exp2f(t[1]); e[2] = __builtin_amdgcn_exp2f(t[2]); e[3] = __builtin_amdgcn_exp2f(t[3]);
    const f32x4 d = e + 1.0f; f32x4 r; r[0] = __builtin_amdgcn_rcpf(d[0]); r[1] = __builtin_amdgcn_rcpf(d[1]); r[2] = __builtin_amdgcn_rcpf(d[2]); r[3] = __builtin_amdgcn_rcpf(d[3]); return r; }
__device__ __forceinline__ f32x4 swiglu4(const f32x4 g, const f32x4 u, float s) {
    const f32x4 t = g * (-1.4426950408889634f); f32x4 e; e[0] = __builtin_amdgcn_exp2f(t[0]); e[1] = __builtin_amdgcn_exp2f(t[1]); e[2] = __builtin_amdgcn_exp2f(t[2]); e[3] = __builtin_amdgcn_exp2f(t[3]);
    const f32x4 d = e + 1.0f; f32x4 r; r[0] = __builtin_amdgcn_rcpf(d[0]); r[1] = __builtin_amdgcn_rcpf(d[1]); r[2] = __builtin_amdgcn_rcpf(d[2]); r[3] = __builtin_amdgcn_rcpf(d[3]);
    return (g * r) * (u * s); }

struct EpiBf16 {
    static constexpr bool PERM = true, AFTER_DRAIN = false;
    bf16_t* O; int ldc; const float* rstd;
    __device__ __forceinline__ void operator()(const f32x4 (&acc)[2][2][4][2], const Unit& u, int wr, int wc, int fr, int fq) const {
        const int row0 = u.pm * BM + wr * 64 + fr, col0 = u.pn * BM + wc * 32 + 8 * fq;
        float rsv[2][4];
#pragma unroll
        for (int ai = 0; ai < 2; ++ai)
#pragma unroll
            for (int m = 0; m < 4; ++m) rsv[ai][m] = rstd ? rstd[row0 + ai * HALF + m * 16] : 1.0f;
#pragma unroll
        for (int ai = 0; ai < 2; ++ai)
#pragma unroll
            for (int m = 0; m < 4; ++m) { bf16_t* rowp = O + (size_t)(row0 + ai * HALF + m * 16) * ldc + col0; const float rs = rsv[ai][m];
#pragma unroll
                for (int bj = 0; bj < 2; ++bj) { const f32x4 v0 = acc[ai][bj][m][0] * rs, v1 = acc[ai][bj][m][1] * rs;
                    u32x4 w; w.x = cvtpk(v0[0], v0[1]); w.y = cvtpk(v0[2], v0[3]); w.z = cvtpk(v1[0], v1[1]); w.w = cvtpk(v1[2], v1[3]);
                    *(u32x4*)(rowp + bj * HALF) = w; } }
    }
};
template <bool I8IN> struct EpiU {
    static constexpr bool PERM = true, AFTER_DRAIN = false;
    bf16_t* O; int ldc; const float* rstd; const float* cs;
    __device__ __forceinline__ void operator()(const f32x4 (&acc)[2][2][4][2], const Unit& u, int wr, int wc, int fr, int fq) const {
        const int tile = I8IN ? (u.pn < 8 ? u.pn : (u.pn < 12 ? u.pn + 2 : u.pn + 14)) : (u.pn < 2 ? u.pn + 8 : u.pn + 12);
        const int row0 = u.pm * BM + wr * 64 + fr, cc0 = u.pn * BM + wc * 32 + 8 * fq, col0 = tile * BM + wc * 32 + 8 * fq;
        f32x4 csv[2][2]; float rsv[2][4];
        if constexpr (I8IN) {
#pragma unroll
            for (int bj = 0; bj < 2; ++bj) { csv[bj][0] = *(const f32x4*)(cs + cc0 + bj * HALF); csv[bj][1] = *(const f32x4*)(cs + cc0 + bj * HALF + 4); } }
#pragma unroll
        for (int ai = 0; ai < 2; ++ai)
#pragma unroll
            for (int m = 0; m < 4; ++m) rsv[ai][m] = rstd[row0 + ai * HALF + m * 16];
#pragma unroll
        for (int ai = 0; ai < 2; ++ai)
#pragma unroll
            for (int m = 0; m < 4; ++m) { bf16_t* rowp = O + (size_t)(row0 + ai * HALF + m * 16) * ldc + col0; const float rs = rsv[ai][m];
#pragma unroll
                for (int bj = 0; bj < 2; ++bj) { f32x4 v0, v1;
                    if constexpr (I8IN) { v0 = __builtin_convertvector(__builtin_bit_cast(i32x4, acc[ai][bj][m][0]), f32x4) * (csv[bj][0] * rs); v1 = __builtin_convertvector(__builtin_bit_cast(i32x4, acc[ai][bj][m][1]), f32x4) * (csv[bj][1] * rs); }
                    else { v0 = acc[ai][bj][m][0] * rs; v1 = acc[ai][bj][m][1] * rs; }
                    u32x4 w; w.x = cvtpk(v0[0], v0[1]); w.y = cvtpk(v0[2], v0[3]); w.z = cvtpk(v1[0], v1[1]); w.w = cvtpk(v1[2], v1[3]);
                    *(u32x4*)(rowp + bj * HALF) = w; } }
    }
};
constexpr float F8_HSCALE = 8.0f, F8_WSCALE = 256.0f, F8_MAX = 448.0f;
__device__ __forceinline__ unsigned cvt4_fp8(float a, float b, float c, float d) {
    a = __builtin_amdgcn_fmed3f(a, -F8_MAX, F8_MAX); b = __builtin_amdgcn_fmed3f(b, -F8_MAX, F8_MAX); c = __builtin_amdgcn_fmed3f(c, -F8_MAX, F8_MAX); d = __builtin_amdgcn_fmed3f(d, -F8_MAX, F8_MAX);
    int r = 0; r = __builtin_amdgcn_cvt_pk_fp8_f32(a, b, r, false); r = __builtin_amdgcn_cvt_pk_fp8_f32(c, d, r, true); return (unsigned)r; }
template <bool F8OUT, bool I8IN = false> struct EpiSwiGLU {
    static constexpr bool PERM = true, AFTER_DRAIN = false;
    bf16_t* O; int ldc; const float* rstd; const float* csg; const float* csu;
    __device__ __forceinline__ void operator()(const f32x4 (&acc)[2][2][4][2], const Unit& u, int wr, int wc, int fr, int fq) const {
        typedef unsigned u32x2v __attribute__((ext_vector_type(2)));
        const int row0 = u.pm * BM + (u.half == 2 ? HALF : 0) + wr * 64 + fr, col0 = u.pn * HALF + wc * 32 + 8 * fq;
        f32x4 cg0, cg1, cu0, cu1;
        if constexpr (I8IN) { cg0 = *(const f32x4*)(csg + col0); cg1 = *(const f32x4*)(csg + col0 + 4); cu0 = *(const f32x4*)(csu + col0); cu1 = *(const f32x4*)(csu + col0 + 4); }
        float rsv[2][4];
#pragma unroll
        for (int ai = 0; ai < 2; ++ai)
#pragma unroll
            for (int m = 0; m < 4; ++m) rsv[ai][m] = rstd[row0 + ai * HALF + m * 16];
#pragma unroll
        for (int ai = 0; ai < 2; ++ai) if (ai == 0 || u.half == 0)
#pragma unroll
            for (int m = 0; m < 4; ++m) {
                const float rs = rsv[ai][m];
                f32x4 g0, g1, u0, u1;
                if constexpr (I8IN) { const f32x4 sg0 = cg0 * rs, sg1 = cg1 * rs, su0 = cu0 * rs, su1 = cu1 * rs;
                    g0 = __builtin_convertvector(__builtin_bit_cast(i32x4, acc[ai][0][m][0]), f32x4) * sg0; g1 = __builtin_convertvector(__builtin_bit_cast(i32x4, acc[ai][0][m][1]), f32x4) * sg1;
                    u0 = __builtin_convertvector(__builtin_bit_cast(i32x4, acc[ai][1][m][0]), f32x4) * su0; u1 = __builtin_convertvector(__builtin_bit_cast(i32x4, acc[ai][1][m][1]), f32x4) * su1; }
                else { g0 = acc[ai][0][m][0] * rs; g1 = acc[ai][0][m][1] * rs; u0 = acc[ai][1][m][0] * rs; u1 = acc[ai][1][m][1] * rs; }
                if constexpr (F8OUT) { unsigned char* rowp = (unsigned char*)O + (size_t)(row0 + ai * HALF + m * 16) * ldc + col0; const f32x4 h0 = swiglu4(g0, u0, F8_HSCALE), h1 = swiglu4(g1, u1, F8_HSCALE);
                    u32x2v w; w.x = cvt4_fp8(h0[0], h0[1], h0[2], h0[3]); w.y = cvt4_fp8(h1[0], h1[1], h1[2], h1[3]);
                    *(u32x2v*)rowp = w; }
                else { bf16_t* rowp = O + (size_t)(row0 + ai * HALF + m * 16) * ldc + col0; const f32x4 h0 = swiglu4(g0, u0, 1.0f), h1 = swiglu4(g1, u1, 1.0f);
                    u32x4 w; w.x = cvtpk(h0[0], h0[1]); w.y = cvtpk(h0[2], h0[3]); w.z = cvtpk(h1[0], h1[1]); w.w = cvtpk(h1[2], h1[3]);
                    *(u32x4*)rowp = w; } }
    }
};
template <bool RES_BF16, int SPLIT = (1 << 30)> struct EpiRes {
    static constexpr bool PERM = true, AFTER_DRAIN = false;
    const float* resf; const bf16_t* resb; bf16_t* hb; bf16_t* sb; int ldc; float scale; const float* resf2;
    __device__ __forceinline__ void operator()(const f32x4 (&acc)[2][2][4][2], const Unit& u, int wr, int wc, int fr, int fq) const {
        const int row0 = u.pm * BM + (u.half == 2 ? HALF : 0) + wr * 64 + fr, col0 = u.pn * BM + wc * 32 + 8 * fq;
        if (u.kh == 0) {
#pragma unroll
            for (int ai = 0; ai < 2; ++ai) if (ai == 0 || u.half == 0)
#pragma unroll
                for (int m = 0; m < 4; ++m) { const size_t off = (size_t)(row0 + ai * HALF + m * 16) * ldc + col0;
#pragma unroll
                    for (int bj = 0; bj < 2; ++bj) { f32x4 r0, r1;
                        if (RES_BF16) { const u32x4 w = *(const u32x4*)(resb + off + bj * HALF);
                            r0 = (f32x4){__uint_as_float(w.x << 16), __uint_as_float(w.x & 0xffff0000u), __uint_as_float(w.y << 16), __uint_as_float(w.y & 0xffff0000u)};
                            r1 = (f32x4){__uint_as_float(w.z << 16), __uint_as_float(w.z & 0xffff0000u), __uint_as_float(w.w << 16), __uint_as_float(w.w & 0xffff0000u)}; }
                        else { const float* rp = resf + off; if constexpr (SPLIT < (1 << 30)) { if (u.pm * BM >= SPLIT) rp = resf2 + (off - (size_t)SPLIT * ldc); }
                            r0 = *(const f32x4*)(rp + bj * HALF); r1 = *(const f32x4*)(rp + bj * HALF + 4); }
                        const f32x4 h0 = r0 + acc[ai][bj][m][0] * scale, h1 = r1 + acc[ai][bj][m][1] * scale;
                        u32x4 o; o.x = cvtpk(h0[0], h0[1]); o.y = cvtpk(h0[2], h0[3]); o.z = cvtpk(h1[0], h1[1]); o.w = cvtpk(h1[2], h1[3]);
                        *(u32x4*)(hb + off + bj * HALF) = o; }
                    asm volatile("" ::: "memory"); }
        } else {
#pragma unroll
            for (int ai = 0; ai < 2; ++ai)
#pragma unroll
                for (int m = 0; m < 4; ++m) { bf16_t* op = sb + (size_t)(row0 + ai * HALF + m * 16) * ldc + col0;
#pragma unroll
                    for (int bj = 0; bj < 2; ++bj) { const f32x4 p0 = acc[ai][bj][m][0] * scale, p1 = acc[ai][bj][m][1] * scale;
                        u32x4 o; o.x = cvtpk(p0[0], p0[1]); o.y = cvtpk(p0[2], p0[3]); o.z = cvtpk(p1[0], p1[1]); o.w = cvtpk(p1[2], p1[3]); *(u32x4*)(op + bj * HALF) = o; } }
        }
    }
};
template <bool I8IN> struct EpiPLE {
    static constexpr bool PERM = true, AFTER_DRAIN = false;
    const bf16_t* hb; float* out; const bf16_t* T; int ldc; const float* rstd; float dscale; const float* cs;
    __device__ __forceinline__ void operator()(const f32x4 (&acc)[2][2][4][2], const Unit& u, int wr, int wc, int fr, int fq) const {
        const int row0 = u.pm * BM + (u.half == 2 ? HALF : 0) + wr * 64 + fr, col0 = u.pn * BM + wc * 32 + 8 * fq;
        f32x4 csv[2][2]; float rsv[2][4];
        if constexpr (I8IN) {
#pragma unroll
            for (int bj = 0; bj < 2; ++bj) { csv[bj][0] = *(const f32x4*)(cs + col0 + bj * HALF); csv[bj][1] = *(const f32x4*)(cs + col0 + bj * HALF + 4); } }
#pragma unroll
        for (int ai = 0; ai < 2; ++ai)
#pragma unroll
            for (int m = 0; m < 4; ++m) rsv[ai][m] = rstd[row0 + ai * HALF + m * 16] * dscale;
#pragma unroll
        for (int ai = 0; ai < 2; ++ai) if (ai == 0 || u.half == 0)
#pragma unroll
            for (int m = 0; m < 4; ++m) { const size_t off = (size_t)(row0 + ai * HALF + m * 16) * ldc + col0; const float rs = rsv[ai][m];
#pragma unroll
                for (int bj = 0; bj < 2; ++bj) { const size_t o = off + bj * HALF; const u32x4 hw = *(const u32x4*)(hb + o), tw = *(const u32x4*)(T + o); f32x4 a0, a1;
                    if constexpr (I8IN) { a0 = __builtin_convertvector(__builtin_bit_cast(i32x4, acc[ai][bj][m][0]), f32x4) * (csv[bj][0] * rs);
                                          a1 = __builtin_convertvector(__builtin_bit_cast(i32x4, acc[ai][bj][m][1]), f32x4) * (csv[bj][1] * rs); }
                    else { a0 = acc[ai][bj][m][0] * rs; a1 = acc[ai][bj][m][1] * rs; }
                    const f32x4 h0 = (f32x4){__uint_as_float(hw.x << 16), __uint_as_float(hw.x & 0xffff0000u), __uint_as_float(hw.y << 16), __uint_as_float(hw.y & 0xffff0000u)};
                    const f32x4 h1 = (f32x4){__uint_as_float(hw.z << 16), __uint_as_float(hw.z & 0xffff0000u), __uint_as_float(hw.w << 16), __uint_as_float(hw.w & 0xffff0000u)};
                    const f32x4 t0 = (f32x4){__uint_as_float(tw.x << 16), __uint_as_float(tw.x & 0xffff0000u), __uint_as_float(tw.y << 16), __uint_as_float(tw.y & 0xffff0000u)};
                    const f32x4 t1 = (f32x4){__uint_as_float(tw.z << 16), __uint_as_float(tw.z & 0xffff0000u), __uint_as_float(tw.w << 16), __uint_as_float(tw.w & 0xffff0000u)};
                    const f32x4 y0 = h0 + sigmoid4(a0) * t0, y1 = h1 + sigmoid4(a1) * t1;
                    *(f32x4*)(out + o) = y0; *(f32x4*)(out + o + 4) = y1; }
                asm volatile("" ::: "memory"); }
    }
};

template <class Epi, class Sched, bool ALIGN_EPI = false, bool SP2 = false, bool F8 = false, bool MH = false, bool I8 = false>
__device__ __forceinline__ void gemm_phase(PG8_LAS unsigned char* lds, const Gemm g, const Sched& S, const Epi& E) {
    const int tid = threadIdx.x, wid = __builtin_amdgcn_readfirstlane(tid >> 6), lane = tid & 63, wr = wid >> 2, wc = wid & 3, fr = lane & 15, fq = lane >> 4;
    const int K = g.K, ntot = K / BK, ld = g.ld;
    unsigned voffA[2], voffB[2];
#pragma unroll
    for (int i = 0; i < 2; ++i) { int R, C; stage_rc(tid * 16 + i * 8192, R, C); const int Rb = Epi::PERM ? ((R & ~31) + perm32(R & 31)) : R;
        voffA[i] = (unsigned)(R * ld + C) * 2u; voffB[i] = (unsigned)(Rb * ld + C) * 2u; }
    const size_t kstep = (size_t)(BK * 2);
    const size_t hstep = (size_t)HALF * ld * 2;
    const size_t tstep = 2 * hstep;
    const unsigned ldsw = (unsigned)wid * 1024u;
    const int aoff = lds_byte(wr * 64 + fr, fq * 8), boff = lds_byte(wc * 32 + fr, fq * 8);
#define PG8_SA(b, h) (((b) * 2 + (h)) * HTB)
#define PG8_SB(b, h) ((4 + (b) * 2 + (h)) * HTB)
#define PG8_STAGE(bufoff, gbase, voff) do { _Pragma("unroll") for (int _i = 0; _i < 2; ++_i) \
        __builtin_amdgcn_global_load_lds((const unsigned*)((const char*)(gbase) + (voff)[_i]), (PG8_LAS unsigned*)(lds + (bufoff) + ldsw + _i * 8192), 16, 0, 0); } while (0)
#define PG8_RD(off) (*(const PG8_LAS bf16x8*)(lds + (off)))
#define PG8_CAT(x, y) __builtin_bit_cast(i32x8, __builtin_shufflevector((x), (y), 0, 1, 2, 3, 4, 5, 6, 7, 8, 9, 10, 11, 12, 13, 14, 15))
#define PG8_LDA(dst, b, h) do { _Pragma("unroll") for (int m = 0; m < 4; ++m) { if constexpr (F8) dst##8[m] = PG8_CAT(PG8_RD(PG8_SA(b, h) + aoff + m * 2048), PG8_RD(PG8_SA(b, h) + aoff + m * 2048 + 1024)); \
        else { _Pragma("unroll") for (int k = 0; k < 2; ++k) dst[m][k] = PG8_RD(PG8_SA(b, h) + aoff + m * 2048 + k * 1024); } } } while (0)
#define PG8_LDB(dst, b, h) do { _Pragma("unroll") for (int n = 0; n < 2; ++n) { if constexpr (F8) dst##8[n] = PG8_CAT(PG8_RD(PG8_SB(b, h) + boff + n * 2048), PG8_RD(PG8_SB(b, h) + boff + n * 2048 + 1024)); \
        else { _Pragma("unroll") for (int k = 0; k < 2; ++k) dst[n][k] = PG8_RD(PG8_SB(b, h) + boff + n * 2048 + k * 1024); } } } while (0)
#define PG8_MMA(ai, bj, At, Bt) do { __builtin_amdgcn_s_setprio(1); _Pragma("unroll") for (int m = 0; m < 4; ++m) _Pragma("unroll") for (int n = 0; n < 2; ++n) { \
        if constexpr (F8) acc[ai][bj][m][n] = __builtin_amdgcn_mfma_scale_f32_16x16x128_f8f6f4(Bt##8[n], At##8[m], acc[ai][bj][m][n], 0, 0, 0, 0, 0, 0); \
        else if constexpr (I8) { _Pragma("unroll") for (int k = 0; k < 2; ++k) acc[ai][bj][m][n] = __builtin_bit_cast(f32x4, __builtin_amdgcn_mfma_i32_16x16x64_i8(__builtin_bit_cast(i32x4, Bt[n][k]), __builtin_bit_cast(i32x4, At[m][k]), __builtin_bit_cast(i32x4, acc[ai][bj][m][n]), 0, 0, 0)); } \
        else { _Pragma("unroll") for (int k = 0; k < 2; ++k) acc[ai][bj][m][n] = __builtin_amdgcn_mfma_f32_16x16x32_bf16(Bt[n][k], At[m][k], acc[ai][bj][m][n], 0, 0, 0); } } \
        __builtin_amdgcn_s_setprio(0); } while (0)
#define PG8_WAIT_V(n) asm volatile("s_waitcnt vmcnt(" #n ")" ::: "memory")
#define PG8_WAIT_L(n) asm volatile("s_waitcnt lgkmcnt(" #n ")" ::: "memory")
#define PG8_BAR __builtin_amdgcn_s_barrier()
#define PG8_SCHED __builtin_amdgcn_sched_barrier(0)
    Unit cur, nxt; int ui = 0;
    if (!S.next(0, cur)) return;
    f32x4 acc[2][2][4][2];
#pragma unroll
    for (int a = 0; a < 2; ++a)
#pragma unroll
        for (int b = 0; b < 2; ++b)
#pragma unroll
            for (int m = 0; m < 4; ++m)
#pragma unroll
                for (int n = 0; n < 2; ++n) acc[a][b][m][n] = (f32x4){0.f, 0.f, 0.f, 0.f};
    bf16x8 At[4][2], B0[2][2], B1[2][2]; i32x8 At8[4], B08[2], B18[2];
    const char* cA = (const char*)g.A + (size_t)cur.pm * tstep + (cur.kh ? (size_t)g.ksplit * (BK * 2) : (size_t)0) + (cur.half == 2 ? hstep : (size_t)0); const char* cB = (const char*)g.Bt + (size_t)cur.pn * tstep + (cur.kh ? (size_t)g.ksplit * (BK * 2) : (size_t)0);
    S.a_ready(cur);
    if constexpr (SP2) {
        PG8_STAGE(PG8_SB(0, 0), cB, voffB); PG8_STAGE(PG8_SB(0, 1), cB + hstep, voffB); PG8_STAGE(PG8_SA(0, 0), cA, voffA); PG8_STAGE(PG8_SA(0, 1), cA + hstep, voffA);
        if (wr == 1) PG8_BAR;
        PG8_WAIT_V(2); PG8_BAR;
        PG8_STAGE(PG8_SB(1, 0), cB + kstep, voffB); PG8_STAGE(PG8_SA(1, 0), cA + kstep, voffA); PG8_STAGE(PG8_SB(1, 1), cB + hstep + kstep, voffB);
        PG8_WAIT_V(6); PG8_BAR;
    } else {
        PG8_STAGE(PG8_SB(0, 0), cB, voffB); PG8_STAGE(PG8_SA(0, 0), cA, voffA); PG8_STAGE(PG8_SB(0, 1), cB + hstep, voffB); PG8_STAGE(PG8_SA(0, 1), cA + hstep, voffA);
        if (wr == 1) PG8_BAR;
        PG8_WAIT_V(4); PG8_BAR;
        PG8_STAGE(PG8_SB(1, 0), cB + kstep, voffB); PG8_STAGE(PG8_SA(1, 0), cA + kstep, voffA); PG8_STAGE(PG8_SB(1, 1), cB + hstep + kstep, voffB);
        PG8_WAIT_V(6); PG8_BAR;
    }
    for (;;) {
        const bool has_next = S.next(ui + 1, nxt); const int nt = g.ksplit ? (cur.kh ? ntot - g.ksplit : g.ksplit) : ntot; const bool mhalf = MH || cur.half != 0;
        const char* nA = has_next ? (const char*)g.A + (size_t)nxt.pm * tstep + (nxt.kh ? (size_t)g.ksplit * (BK * 2) : (size_t)0) + (nxt.half == 2 ? hstep : (size_t)0) : cA; const char* nB = has_next ? (const char*)g.Bt + (size_t)nxt.pn * tstep + (nxt.kh ? (size_t)g.ksplit * (BK * 2) : (size_t)0) : cB;
        for (int t = 0; t < nt; t += 2) {
            const bool last = (t == nt - 2);
            const char* a1 = cA + (size_t)(t + 1) * kstep;
            const char* a2 = last ? nA : cA + (size_t)(t + 2) * kstep; const char* b2 = last ? nB : cB + (size_t)(t + 2) * kstep;
            const char* a3 = a2 + kstep; const char* b3 = b2 + kstep;
            if (last && has_next) S.a_ready(nxt);
            if constexpr (SP2) {
            PG8_LDB(B0, 0, 0); PG8_LDB(B1, 0, 1); PG8_SCHED; PG8_LDA(At, 0, 0); PG8_STAGE(PG8_SA(1, 1), a1 + hstep, voffA);
            PG8_WAIT_V(8); PG8_WAIT_L(0); PG8_BAR; PG8_MMA(0, 0, At, B0); PG8_MMA(0, 1, At, B1); PG8_BAR; PG8_SCHED;
            if constexpr (!MH) PG8_LDA(At, 0, 1); PG8_STAGE(PG8_SB(0, 0), b2, voffB); PG8_STAGE(PG8_SB(0, 1), b2 + hstep, voffB); PG8_STAGE(PG8_SA(0, 0), a2, voffA);
            PG8_WAIT_V(8); PG8_WAIT_L(0); PG8_BAR; if constexpr (!MH) { if (!mhalf) { PG8_MMA(1, 0, At, B0); PG8_MMA(1, 1, At, B1); } } PG8_BAR; PG8_SCHED;
            PG8_LDB(B0, 1, 0); PG8_LDB(B1, 1, 1); PG8_SCHED; PG8_LDA(At, 1, 0); PG8_STAGE(PG8_SA(0, 1), a2 + hstep, voffA);
            PG8_WAIT_V(8); PG8_WAIT_L(0); PG8_BAR; PG8_MMA(0, 0, At, B0); PG8_MMA(0, 1, At, B1); PG8_BAR; PG8_SCHED;
            if constexpr (!MH) PG8_LDA(At, 1, 1); PG8_STAGE(PG8_SB(1, 0), b3, voffB); PG8_STAGE(PG8_SB(1, 1), b3 + hstep, voffB); PG8_STAGE(PG8_SA(1, 0), a3, voffA);
            PG8_WAIT_V(8); PG8_WAIT_L(0); PG8_BAR; if constexpr (!MH) { if (!mhalf) { PG8_MMA(1, 0, At, B0); PG8_MMA(1, 1, At, B1); } } PG8_BAR; PG8_SCHED;
            } else {
            PG8_LDB(B0, 0, 0); PG8_SCHED; PG8_LDA(At, 0, 0); PG8_STAGE(PG8_SA(1, 1), a1 + hstep, voffA);
            PG8_WAIT_L(8); PG8_BAR; PG8_WAIT_L(0); PG8_MMA(0, 0, At, B0); PG8_BAR; PG8_SCHED;
            PG8_LDB(B1, 0, 1); PG8_STAGE(PG8_SB(0, 0), b2, voffB);
            PG8_BAR; PG8_WAIT_L(0); PG8_MMA(0, 1, At, B1); PG8_BAR;
            PG8_LDA(At, 0, 1); PG8_STAGE(PG8_SA(0, 0), a2, voffA);
            PG8_BAR; PG8_WAIT_L(0); PG8_MMA(1, 0, At, B0); PG8_BAR; PG8_SCHED;
            PG8_STAGE(PG8_SB(0, 1), b2 + hstep, voffB);
            PG8_WAIT_V(6); PG8_BAR; PG8_MMA(1, 1, At, B1); PG8_BAR;
            PG8_LDB(B0, 1, 0); PG8_SCHED; PG8_LDA(At, 1, 0); PG8_STAGE(PG8_SA(0, 1), a2 + hstep, voffA);
            PG8_WAIT_L(8); PG8_BAR; PG8_WAIT_L(0); PG8_MMA(0, 0, At, B0); PG8_BAR; PG8_SCHED;
            PG8_LDB(B1, 1, 1); PG8_STAGE(PG8_SB(1, 0), b3, voffB);
            PG8_BAR; PG8_WAIT_L(0); PG8_MMA(0, 1, At, B1); PG8_BAR;
            PG8_LDA(At, 1, 1); PG8_STAGE(PG8_SA(1, 0), a3, voffA);
            PG8_BAR; PG8_WAIT_L(0); PG8_MMA(1, 0, At, B0); PG8_BAR; PG8_SCHED;
            PG8_STAGE(PG8_SB(1, 1), b3 + hstep, voffB);
            PG8_WAIT_V(6); PG8_BAR; PG8_MMA(1, 1, At, B1); PG8_BAR;
            }
        }
        if constexpr (ALIGN_EPI) { if (wr == 0) PG8_BAR; }
        if constexpr (!Epi::AFTER_DRAIN) { E(acc, cur, wr, wc, fr, fq); S.done(cur); }
        if (!has_next) break;
#pragma unroll
        for (int a = 0; a < 2; ++a)
#pragma unroll
            for (int b = 0; b < 2; ++b)
#pragma unroll
                for (int m = 0; m < 4; ++m)
#pragma unroll
                    for (int n = 0; n < 2; ++n) acc[a][b][m][n] = (f32x4){0.f, 0.f, 0.f, 0.f};
        cur = nxt; cA = nA; cB = nB; ++ui;
        if constexpr (ALIGN_EPI) { if (wr == 1) PG8_BAR; }
    }
    PG8_WAIT_V(0);
    if constexpr (!ALIGN_EPI) { if (wr == 0) PG8_BAR; }
    PG8_BAR;
    if constexpr (Epi::AFTER_DRAIN) { E.fused(acc, cur, wr, wc, fr, fq, lds, wid, lane); S.done(cur); }
#undef PG8_SA
#undef PG8_SB
#undef PG8_STAGE
#undef PG8_RD
#undef PG8_CAT
#undef PG8_LDA
#undef PG8_LDB
#undef PG8_MMA
#undef PG8_WAIT_V
#undef PG8_WAIT_L
#undef PG8_BAR
#undef PG8_SCHED
}

template <class Epi, class Sched>
__device__ __forceinline__ void gemm_phase_f8mh(PG8_LAS unsigned char* lds, const Gemm g, const Sched& S, const Epi& E) {
    const int tid = threadIdx.x, wid = __builtin_amdgcn_readfirstlane(tid >> 6), lane = tid & 63, wr = wid >> 2, wc = wid & 3, fr = lane & 15, fq = lane >> 4;
    const int nt = g.K / BK, ld = g.ld;
    unsigned voffA[2], voffB[2];
#pragma unroll
    for (int i = 0; i < 2; ++i) { int R, C; stage_rc(tid * 16 + i * 8192, R, C); const int Rb = Epi::PERM ? ((R & ~31) + perm32(R & 31)) : R;
        voffA[i] = (unsigned)(R * ld + C) * 2u; voffB[i] = (unsigned)(Rb * ld + C) * 2u; }
    const size_t kstep = (size_t)(BK * 2), hstep = (size_t)HALF * ld * 2, tstep = 2 * hstep;
    const unsigned ldsw = (unsigned)wid * 1024u;
    const int aoff = lds_byte(wr * 64 + fr, fq * 8), boff = lds_byte(wc * 32 + fr, fq * 8);
    constexpr unsigned SLOT = 3u * HTB;
#define F8_STAGE1(dstoff, gptr, voff) do { _Pragma("unroll") for (int _i = 0; _i < 2; ++_i) \
        __builtin_amdgcn_global_load_lds((const unsigned*)((const char*)(gptr) + (voff)[_i]), (PG8_LAS unsigned*)(lds + (dstoff) + ldsw + _i * 8192), 16, 0, 0); } while (0)
#define F8_STAGE3(so, gA, gB) do { F8_STAGE1((so), (gB), voffB); F8_STAGE1((so) + HTB, (gB) + hstep, voffB); F8_STAGE1((so) + 2 * HTB, (gA), voffA); } while (0)
#define F8_RD(off) (*(const PG8_LAS bf16x8*)(lds + (off)))
#define F8_CAT(x, y) __builtin_bit_cast(i32x8, __builtin_shufflevector((x), (y), 0, 1, 2, 3, 4, 5, 6, 7, 8, 9, 10, 11, 12, 13, 14, 15))
    Unit cur, nxt; int ui = 0;
    if (!S.next(0, cur)) return;
    f32x4 acc[2][2][4][2];
#pragma unroll
    for (int b = 0; b < 2; ++b)
#pragma unroll
        for (int m = 0; m < 4; ++m)
#pragma unroll
            for (int n = 0; n < 2; ++n) acc[0][b][m][n] = (f32x4){0.f, 0.f, 0.f, 0.f};
    const char* cA = (const char*)g.A + (size_t)cur.pm * tstep + (cur.half == 2 ? hstep : (size_t)0); const char* cB = (const char*)g.Bt + (size_t)cur.pn * tstep;
    F8_STAGE3(0u, cA, cB);
    if (wr == 1) __builtin_amdgcn_s_barrier();
    asm volatile("s_waitcnt vmcnt(0)" ::: "memory"); __builtin_amdgcn_s_barrier();
    F8_STAGE3(SLOT, cA + kstep, cB + kstep);
    __builtin_amdgcn_s_barrier();
    unsigned so = 0u;
    for (;;) {
        const bool has_next = S.next(ui + 1, nxt);
        const char* nA = has_next ? (const char*)g.A + (size_t)nxt.pm * tstep + (nxt.half == 2 ? hstep : (size_t)0) : cA; const char* nB = has_next ? (const char*)g.Bt + (size_t)nxt.pn * tstep : cB;
        for (int t = 0; t < nt; ++t) {
            const bool wrap = (t + 2 >= nt); const size_t k2 = (size_t)(wrap ? t + 2 - nt : t + 2) * kstep;
            const char* a2 = (wrap ? nA : cA) + k2; const char* b2 = (wrap ? nB : cB) + k2;
            const unsigned so2 = (so >= SLOT) ? so - SLOT : so + 2u * SLOT;
            i32x8 B08[2], B18[2], At8[4];
#pragma unroll
            for (int n = 0; n < 2; ++n) { B08[n] = F8_CAT(F8_RD(so + boff + n * 2048), F8_RD(so + boff + n * 2048 + 1024)); B18[n] = F8_CAT(F8_RD(so + HTB + boff + n * 2048), F8_RD(so + HTB + boff + n * 2048 + 1024)); }
            __builtin_amdgcn_sched_barrier(0);
#pragma unroll
            for (int m = 0; m < 4; ++m) At8[m] = F8_CAT(F8_RD(so + 2 * HTB + aoff + m * 2048), F8_RD(so + 2 * HTB + aoff + m * 2048 + 1024));
            F8_STAGE3(so2, a2, b2);
            asm volatile("s_waitcnt vmcnt(6)" ::: "memory"); asm volatile("s_waitcnt lgkmcnt(0)" ::: "memory"); __builtin_amdgcn_s_barrier();
            __builtin_amdgcn_s_setprio(1);
#pragma unroll
            for (int m = 0; m < 4; ++m)
#pragma unroll
                for (int n = 0; n < 2; ++n) { acc[0][0][m][n] = __builtin_amdgcn_mfma_scale_f32_16x16x128_f8f6f4(B08[n], At8[m], acc[0][0][m][n], 0, 0, 0, 0, 0, 0);
                    acc[0][1][m][n] = __builtin_amdgcn_mfma_scale_f32_16x16x128_f8f6f4(B18[n], At8[m], acc[0][1][m][n], 0, 0, 0, 0, 0, 0); }
            __builtin_amdgcn_s_setprio(0);
            __builtin_amdgcn_s_barrier(); __builtin_amdgcn_sched_barrier(0);
            so = (so >= 2u * SLOT) ? 0u : so + SLOT;
        }
        E(acc, cur, wr, wc, fr, fq);
        if (!has_next) break;
#pragma unroll
        for (int b = 0; b < 2; ++b)
#pragma unroll
            for (int m = 0; m < 4; ++m)
#pragma unroll
                for (int n = 0; n < 2; ++n) acc[0][b][m][n] = (f32x4){0.f, 0.f, 0.f, 0.f};
        cur = nxt; cA = nA; cB = nB; ++ui;
    }
    asm volatile("s_waitcnt vmcnt(0)" ::: "memory");
    if (wr == 0) __builtin_amdgcn_s_barrier();
    __builtin_amdgcn_s_barrier();
#undef F8_STAGE1
#undef F8_STAGE3
#undef F8_RD
#undef F8_CAT
}
}

constexpr int NWAVES = 8;
#ifndef MK_ONE_LAUNCH
#define MK_ONE_LAUNCH 1
#endif
constexpr int N_PHASES = 14;

constexpr int D = 4096, DFF = 11008, NTOK = 10240, NPR = 8192, SEQ = 4096, INW = 8704, PLE = 256;
constexpr int C_QA = 0, C_KA = 2048, C_VA = 2304, C_QR = 2560, C_KR = 3584, C_VR = 4608, C_GR = 6656;
constexpr int NPOS = 4160;
constexpr float EPS = 1e-6f;
constexpr size_t O_Y = 0, O_KP = 41943040, O_VP = 42008576, O_SP = 42074112, O_KS = 42598400, O_VS = 43646976, O_SS = 44695552, O_END = 53084160;

constexpr size_t MiB = 1u << 20;
constexpr size_t WS_CTL = 0, CTL_ZERO_BYTES = 1 * MiB;
constexpr size_t WS_ROPE = 2 * MiB;
constexpr size_t WS_PB = 6 * MiB;
constexpr size_t WS_CS = 14 * MiB;
constexpr size_t WS_RSTD = 12 * MiB;
constexpr size_t WS_W1GU = 16 * MiB, WS_W1D = 188 * MiB, WS_WIN = 274 * MiB, WS_WOUT = 342 * MiB, WS_W2GU = 374 * MiB, WS_W2D = 546 * MiB, WS_WPG = 632 * MiB, WS_WPP = 664 * MiB;
constexpr size_t WS_ZN = 666 * MiB;
constexpr size_t WS_HID = 746 * MiB;
constexpr size_t WS_MIX = 961 * MiB;
constexpr size_t WS_TP = 1041 * MiB;
constexpr size_t WS_RS = 1121 * MiB;
constexpr size_t WS_STB = 1249 * MiB;
constexpr size_t WS_SB = 1313 * MiB;
constexpr size_t WS_HB = 1345 * MiB;
constexpr size_t WS_END = 1425 * MiB;
static_assert(WS_W1GU + (size_t)2 * DFF * D * 2 == WS_W1D && WS_W1D + (size_t)D * DFF * 2 == WS_WIN && WS_WIN + (size_t)INW * D * 2 == WS_WOUT && WS_WOUT + (size_t)D * D * 2 == WS_W2GU, "ws map 1");
static_assert(WS_W2GU + (size_t)2 * DFF * D * 2 == WS_W2D && WS_W2D + (size_t)D * DFF * 2 == WS_WPG && WS_WPG + (size_t)D * D * 2 == WS_WPP && WS_WPP + (size_t)D * PLE * 2 == WS_ZN, "ws map 2");
static_assert(WS_ZN + (size_t)NTOK * D * 2 == WS_HID && WS_HID + (size_t)NTOK * DFF * 2 == WS_MIX && WS_MIX + (size_t)NTOK * D * 2 == WS_TP && WS_TP + (size_t)NTOK * D * 2 == WS_RS, "ws map 3");
static_assert(WS_RS + (size_t)1024 * 32768 * 4 == WS_STB && WS_STB + (size_t)1024 * 32768 * 2 == WS_SB && WS_SB + (size_t)(NTOK - NPR) * D * 4 == WS_HB && WS_HB + (size_t)NTOK * D * 2 == WS_END && WS_ROPE + (size_t)NPOS * 64 * 8 <= WS_PB && WS_PB + (size_t)NTOK * PLE * 2 <= WS_RSTD && WS_RSTD + (size_t)NTOK * 4 <= WS_W1GU, "ws map 4");
constexpr int CW_BAR = 4096;
constexpr int CW_CM = 32768;

constexpr int RING_OFF = 0, RING_BYTES = 147456;
constexpr int LDSCTL_OFF = RING_BYTES, MISC_OFF = LDSCTL_OFF + 320;
constexpr int LDS_BYTES = 148480;
static_assert(MISC_OFF + 128 <= LDS_BYTES, "LDS map");

#define GAS __attribute__((address_space(1)))
#define LAS __attribute__((address_space(3)))
typedef unsigned short bf16;
typedef unsigned v4u __attribute__((ext_vector_type(4)));
typedef float f32x4 __attribute__((ext_vector_type(4)));
typedef short bf16x8 __attribute__((ext_vector_type(8)));
typedef GAS unsigned gu32;
typedef GAS unsigned long long gu64;
#define RLX_AGENT __ATOMIC_RELAXED, __HIP_MEMORY_SCOPE_AGENT
#define LDS_WAIT() asm volatile("s_waitcnt lgkmcnt(0)" ::: "memory")
#define VM_WAIT() asm volatile("s_waitcnt vmcnt(0)" ::: "memory")
__device__ __forceinline__ unsigned long long rt() { return __builtin_amdgcn_s_memrealtime(); }
__device__ __forceinline__ unsigned f2bf(float f) { unsigned u = __builtin_bit_cast(unsigned, f); return (u + 0x7fffu + ((u >> 16) & 1u)) >> 16; }
__device__ __forceinline__ unsigned pk2(float lo, float hi) { return f2bf(lo) | (f2bf(hi) << 16); }

#define XB_TMO      128
#define XB_XCNT(j)  (256  + 64 * (j))
#define XB_XSUB(j)  (1280 + 64 * (j))
#define XB_XGEN(j)  (2304 + 64 * (j))
#define XB_TOP      3328
#define XB_TOPGEN   3392
#define XCD_BAR_WORDS 3456
#define XB_SPIN_CAP (1u << 18)

__device__ __forceinline__ unsigned xb_ld(unsigned* p)              { return __hip_atomic_load(p, __ATOMIC_RELAXED, __HIP_MEMORY_SCOPE_AGENT); }
__device__ __forceinline__ unsigned xb_add(unsigned* p, unsigned v) { return __hip_atomic_fetch_add(p, v, __ATOMIC_RELAXED, __HIP_MEMORY_SCOPE_AGENT); }
__device__ __forceinline__ unsigned xb_xcc_id() { return (unsigned)__builtin_amdgcn_s_getreg((3 << 11) | 20) & 0xFu; }
#define XB_SPIN(cond, bar) do { unsigned _sp = 0; while (cond) { __builtin_amdgcn_s_sleep(1); \
    if ((++_sp & 255u) == 0u) { if (xb_ld(&(bar)[XB_TMO])) break; if (_sp > XB_SPIN_CAP) { atomicAdd(&(bar)[XB_TMO], 1u); break; } } } } while (0)

struct XcdBarrier {
    unsigned* bar; unsigned x;
    volatile LAS unsigned* st;
};

__device__ __forceinline__ XcdBarrier xcd_barrier_post(unsigned* bar, volatile LAS unsigned* st) {
    XcdBarrier b; b.bar = bar; b.x = xb_xcc_id(); b.st = st;
    if (threadIdx.x == 0) (void)xb_add(&bar[XB_XCNT(b.x)], 1u);
    return b;
}
__device__ __forceinline__ void xcd_barrier_complete(unsigned* bar, unsigned x, unsigned& nloc, unsigned& nx) {
    const unsigned G = gridDim.x * gridDim.y * gridDim.z;
    unsigned sum, cnt, mine, sp = 0u;
    for (;;) {
        sum = 0u; cnt = 0u; mine = 0u;
#pragma unroll
        for (unsigned j = 0; j < 16; ++j) { const unsigned c = xb_ld(&bar[XB_XCNT(j)]); sum += c; cnt += (c > 0u) ? 1u : 0u; mine = (j == x) ? c : mine; }
        if (sum == G) break;
        __builtin_amdgcn_s_sleep(1);
        if ((++sp & 255u) == 0u) { if (xb_ld(&bar[XB_TMO])) break; if (sp > XB_SPIN_CAP) { atomicAdd(&bar[XB_TMO], 1u); break; } }
    }
    nloc = mine > 0u ? mine : 1u; nx = cnt > 0u ? cnt : 1u;
}

__device__ __forceinline__ void xcd_barrier(const XcdBarrier& b) {
    asm volatile("s_waitcnt vmcnt(0)" ::: "memory");
    __syncthreads();
    if (threadIdx.x == 0) {
        unsigned* bar = b.bar;
        __builtin_amdgcn_s_waitcnt(0);
        unsigned nloc = b.st[0], nx = b.st[1];
        if (nloc == 0u) { xcd_barrier_complete(bar, b.x, nloc, nx); b.st[0] = nloc; b.st[1] = nx; }
        const unsigned old = xb_add(&bar[XB_XSUB(b.x)], 1u);
        const unsigned gen = old / nloc;
        if (old + 1u == (gen + 1u) * nloc) {
            __builtin_amdgcn_fence(__ATOMIC_RELEASE, "agent");
            asm volatile("s_waitcnt vmcnt(0)" ::: "memory");
            const unsigned og = xb_add(&bar[XB_TOP], 1u);
            const unsigned tg = og / nx;
            if (og + 1u == (tg + 1u) * nx) xb_add(&bar[XB_TOPGEN], 1u);
            else XB_SPIN(xb_ld(&bar[XB_TOPGEN]) == tg, bar);
            __builtin_amdgcn_fence(__ATOMIC_ACQUIRE, "agent");
            xb_add(&bar[XB_XGEN(b.x)], 1u);
            asm volatile("s_waitcnt vmcnt(0)" ::: "memory");
        } else {
            XB_SPIN(xb_ld(&bar[XB_XGEN(b.x)]) == gen, bar);
            __builtin_amdgcn_fence(__ATOMIC_ACQUIRE, "agent");
            asm volatile("s_waitcnt vmcnt(0)" ::: "memory");
        }
    }
    __syncthreads();
}


typedef float f32x16 __attribute__((ext_vector_type(16)));
typedef float f32x2 __attribute__((ext_vector_type(2)));
typedef short s16x4 __attribute__((ext_vector_type(4)));
typedef unsigned v2u __attribute__((ext_vector_type(2)));
#define MFMA32(a, b, c) __builtin_amdgcn_mfma_f32_32x32x16_bf16((a), (b), (c), 0, 0, 0)
#define MFMA16(a, b, c) __builtin_amdgcn_mfma_f32_16x16x32_bf16((a), (b), (c), 0, 0, 0)
using pg8::cvtpk;
using pg8::silu_f;

struct Args { const float* in[25]; float* out; unsigned char* ws; int ph_lo, ph_hi; };
struct Frame {
    LAS unsigned char* lds;
    volatile LAS unsigned* MISC;
    gu32* ctl;
    int tid, lane, wave;
    int vcu, G;
};
#define A_x_p      (A.in[0])
#define A_x_s      (A.in[1])
#define A_cache_k  (A.in[2])
#define A_cache_v  (A.in[3])
#define A_state_in (A.in[4])
#define A_p_p      (A.in[5])
#define A_p_s      (A.in[6])
#define A_g_ffn1   (A.in[7])
#define A_w1g      (A.in[8])
#define A_w1u      (A.in[9])
#define A_w1d      (A.in[10])
#define A_g_mix    (A.in[11])
#define A_w_in     (A.in[12])
#define A_g_q      (A.in[13])
#define A_g_k      (A.in[14])
#define A_sinks    (A.in[15])
#define A_g_ret    (A.in[16])
#define A_w_out    (A.in[17])
#define A_g_ffn2   (A.in[18])
#define A_w2g      (A.in[19])
#define A_w2u      (A.in[20])
#define A_w2d      (A.in[21])
#define A_g_ple    (A.in[22])
#define A_w_pg     (A.in[23])
#define A_w_pp     (A.in[24])
#define A_out      (A.out)
#define A_W1GU ((bf16*)(A.ws + WS_W1GU))
#define A_W1D  ((bf16*)(A.ws + WS_W1D))
#define A_WIN  ((bf16*)(A.ws + WS_WIN))
#define A_WOUT ((bf16*)(A.ws + WS_WOUT))
#define A_W2GU ((bf16*)(A.ws + WS_W2GU))
#define A_W2D  ((bf16*)(A.ws + WS_W2D))
#define A_WPG  ((bf16*)(A.ws + WS_WPG))
#define A_WPP  ((bf16*)(A.ws + WS_WPP))
#define A_ZN   ((bf16*)(A.ws + WS_ZN))
#define A_HID  ((bf16*)(A.ws + WS_HID))
#define A_U    ((bf16*)(A.ws + WS_HID))
#define A_MIX  ((bf16*)(A.ws + WS_MIX))
#define A_TP   ((bf16*)(A.ws + WS_TP))
#define A_PB   ((bf16*)(A.ws + WS_PB))
#define A_STB  ((bf16*)(A.ws + WS_STB))
#define A_RS   ((bf16*)(A.ws + WS_RS))
#define A_ROPE ((f32x2*)(A.ws + WS_ROPE))
#define A_SB   ((bf16*)(A.ws + WS_SB))
#define A_HB   ((bf16*)(A.ws + WS_HB))
#define A_RSTD ((float*)(A.ws + WS_RSTD))
#define A_CM2G ((unsigned*)(A.ws + WS_CTL) + CW_CM)
#define A_CM2U ((unsigned*)(A.ws + WS_CTL) + CW_CM + 11264)
#define A_CMPG ((unsigned*)(A.ws + WS_CTL) + CW_CM + 22528)
#define A_CM1G ((unsigned*)(A.ws + WS_CTL) + CW_CM + 26624)
#define A_CM1U ((unsigned*)(A.ws + WS_CTL) + CW_CM + 26624 + 11264)
#define A_CS1G ((float*)(A.ws + WS_CS) + 26624)
#define A_CS1U ((float*)(A.ws + WS_CS) + 26624 + 11264)
#define A_CSPG ((float*)(A.ws + WS_CS) + 22528)
#define A_CS2G ((float*)(A.ws + WS_CS))
#define A_CS2U ((float*)(A.ws + WS_CS) + 11264)
#define A_WINB ((bf16*)(A.ws + WS_WIN))
#define A_WINQ ((unsigned char*)(A.ws + WS_WIN + (size_t)3584 * D * 2))
#define A_CMWIN ((unsigned*)(A.ws + WS_CTL) + CW_CM + 49152)
#define A_CSWIN ((float*)(A.ws + WS_CS) + 49152)
#define A_RSTDQ ((float*)(A.ws + WS_RSTD) + 16384)

__device__ __forceinline__ float wave_sum(float v) {
#pragma unroll
    for (int o = 1; o < 64; o <<= 1) v += __shfl_xor(v, o);
    return v;
}
__device__ __forceinline__ void unpack8(const v4u w, float (&f)[8]) {
    f[0] = __uint_as_float(w.x << 16); f[1] = __uint_as_float(w.x & 0xffff0000u); f[2] = __uint_as_float(w.y << 16); f[3] = __uint_as_float(w.y & 0xffff0000u);
    f[4] = __uint_as_float(w.z << 16); f[5] = __uint_as_float(w.z & 0xffff0000u); f[6] = __uint_as_float(w.w << 16); f[7] = __uint_as_float(w.w & 0xffff0000u);
}
__device__ __forceinline__ v4u pack8(const float (&f)[8]) { v4u w; w.x = cvtpk(f[0], f[1]); w.y = cvtpk(f[2], f[3]); w.z = cvtpk(f[4], f[5]); w.w = cvtpk(f[6], f[7]); return w; }
__device__ __forceinline__ unsigned short bf1(float f) { return (unsigned short)(cvtpk(f, 0.f) & 0xffffu); }
__device__ __forceinline__ unsigned pack4_i8(float a, float b, float c, float d) {
    const int ia = (int)rintf(fminf(fmaxf(a, -127.f), 127.f)), ib = (int)rintf(fminf(fmaxf(b, -127.f), 127.f)), ic = (int)rintf(fminf(fmaxf(c, -127.f), 127.f)), id = (int)rintf(fminf(fmaxf(d, -127.f), 127.f));
    return (unsigned)(ia & 0xff) | ((unsigned)(ib & 0xff) << 8) | ((unsigned)(ic & 0xff) << 16) | ((unsigned)id << 24); }
__device__ __forceinline__ float log2_gamma(int h) {
    float r = -0.04580368961312479f;
    r = (h == 1) ? -0.02272007650008353f : r; r = (h == 2) ? -0.011315313227834146f : r; r = (h == 3) ? -0.005646563141142063f : r;
    r = (h == 4) ? -0.0028205190623786626f : r; r = (h == 5) ? -0.0014095702546713536f : r; r = (h == 6) ? -0.0007046129765893727f : r; r = (h == 7) ? -0.0003522634716290214f : r;
    return r;
}

constexpr int CVT_TP = 72, CVT_TBYTES = 64 * CVT_TP * 2;
__device__ __forceinline__ void cvt_load(const float* W, int N, int item, int lane, f32x4 (&v)[16], const float* g, int ldw = 0) {
    const int nn = N >> 6, kb = item / nn, nb = item - kb * nn, k0 = kb * 64, n0 = nb * 64; if (ldw == 0) ldw = N;
    const GAS f32x4* src = (const GAS f32x4*)(W + (size_t)(k0 + (lane >> 4) * 16) * ldw + n0 + 4 * (lane & 15));
    const size_t rs = (size_t)(ldw >> 2);
#pragma unroll
    for (int j = 0; j < 16; ++j) v[j] = src[(size_t)j * rs];
    if (g) { const GAS f32x4* gp = (const GAS f32x4*)(g + k0 + (lane >> 4) * 16);
#pragma unroll
        for (int j4 = 0; j4 < 4; ++j4) { const f32x4 gv = gp[j4]; v[4 * j4] = v[4 * j4] * gv[0]; v[4 * j4 + 1] = v[4 * j4 + 1] * gv[1]; v[4 * j4 + 2] = v[4 * j4 + 2] * gv[2]; v[4 * j4 + 3] = v[4 * j4 + 3] * gv[3]; } }
}
__device__ __forceinline__ void cvt_store(int K, int N, bf16* WT, int mode, int item, int lane, const f32x4 (&v)[16], LAS bf16* T) {
    const int nn = N >> 6, kb = item / nn, nb = item - kb * nn, k0 = kb * 64, n0 = nb * 64;
    const int kk = lane >> 4, c = lane & 15;
#pragma unroll
    for (int i = 0; i < 4; ++i) {
        v4u o0, o1;
        o0.x = cvtpk(v[0][i], v[1][i]); o0.y = cvtpk(v[2][i], v[3][i]); o0.z = cvtpk(v[4][i], v[5][i]); o0.w = cvtpk(v[6][i], v[7][i]);
        o1.x = cvtpk(v[8][i], v[9][i]); o1.y = cvtpk(v[10][i], v[11][i]); o1.z = cvtpk(v[12][i], v[13][i]); o1.w = cvtpk(v[14][i], v[15][i]);
        LAS bf16* t = T + (4 * c + i) * CVT_TP + 16 * kk;
        *(LAS v4u*)t = o0; *(LAS v4u*)(t + 8) = o1;
    }
    const int r8 = lane >> 3, p = lane & 7;
#pragma unroll
    for (int q = 0; q < 8; ++q) { const int n = 8 * q + r8, nabs = n0 + n;
        const v4u val = *(const LAS v4u*)(T + n * CVT_TP + 8 * p);
        const int drow = (mode == 0) ? nabs : ((nabs >> 7) * 256 + (nabs & 127) + (mode == 2 ? 128 : 0));
        *(GAS v4u*)(WT + (size_t)drow * K + k0 + 8 * p) = val; }
}
constexpr int CVT_TP8 = 80;
__device__ __forceinline__ void cvt_store_f8(int K, int N, unsigned char* WT, int item, int lane, const f32x4 (&v)[16], LAS unsigned char* T) {
    const int nn = N >> 6, kb = item / nn, nb = item - kb * nn, k0 = kb * 64, n0 = nb * 64;
    const int kk = lane >> 4, c = lane & 15; constexpr float S = pg8::F8_WSCALE;
#pragma unroll
    for (int i = 0; i < 4; ++i) { v4u o;
        o.x = pg8::cvt4_fp8(v[0][i] * S, v[1][i] * S, v[2][i] * S, v[3][i] * S); o.y = pg8::cvt4_fp8(v[4][i] * S, v[5][i] * S, v[6][i] * S, v[7][i] * S);
        o.z = pg8::cvt4_fp8(v[8][i] * S, v[9][i] * S, v[10][i] * S, v[11][i] * S); o.w = pg8::cvt4_fp8(v[12][i] * S, v[13][i] * S, v[14][i] * S, v[15][i] * S);
        *(LAS v4u*)(T + (4 * c + i) * CVT_TP8 + 16 * kk) = o; }
    const int r16 = lane >> 2, p = lane & 3;
#pragma unroll
    for (int q = 0; q < 4; ++q) { const int n = 16 * q + r16; const v4u val = *(const LAS v4u*)(T + n * CVT_TP8 + 16 * p);
        *(GAS v4u*)(WT + (size_t)(n0 + n) * K + k0 + 16 * p) = val; }
}
__device__ __forceinline__ void cvt_matrix_f8(const Frame& F, const float* W, int K, int N, unsigned char* WT, int gw, int NGW, const float* g = nullptr) {
    const int nitems = (K >> 6) * (N >> 6); LAS unsigned char* T = (LAS unsigned char*)(F.lds + RING_OFF + F.wave * CVT_TBYTES);
    for (int it = gw; it < nitems; it += 2 * NGW) { f32x4 v0[16], v1[16]; const bool two = it + NGW < nitems;
        cvt_load(W, N, it, F.lane, v0, g); if (two) cvt_load(W, N, it + NGW, F.lane, v1, g);
        cvt_store_f8(K, N, WT, it, F.lane, v0, T); if (two) cvt_store_f8(K, N, WT, it + NGW, F.lane, v1, T); }
}
__device__ __forceinline__ void colmax_matrix(const Frame& F, const float* W, int K, int N, unsigned* cm, int gw, int NGW, const float* g, int ldw = 0) {
    const int nitems = (K >> 6) * (N >> 6);
    for (int it = gw; it < nitems; it += NGW) { f32x4 v[16]; cvt_load(W, N, it, F.lane, v, g, ldw);
        const int nn = N >> 6, kb = it / nn, nb = it - kb * nn, n0 = nb * 64; f32x4 mx = (f32x4){0.f, 0.f, 0.f, 0.f};
#pragma unroll
        for (int j = 0; j < 16; ++j) { mx[0] = fmaxf(mx[0], fabsf(v[j][0])); mx[1] = fmaxf(mx[1], fabsf(v[j][1])); mx[2] = fmaxf(mx[2], fabsf(v[j][2])); mx[3] = fmaxf(mx[3], fabsf(v[j][3])); }
#pragma unroll
        for (int i = 0; i < 4; ++i) { mx[i] = fmaxf(mx[i], __shfl_xor(mx[i], 16)); mx[i] = fmaxf(mx[i], __shfl_xor(mx[i], 32)); }
        if (F.lane < 16) {
#pragma unroll
            for (int i = 0; i < 4; ++i) atomicMax(cm + n0 + 4 * F.lane + i, __float_as_uint(mx[i])); } }
}
__device__ __forceinline__ void cvt_store_i8(int K, int N, unsigned char* WT, int mode, int item, int lane, const f32x4 (&v)[16], LAS unsigned char* T, const unsigned* cm, float* cs) {
    const int nn = N >> 6, kb = item / nn, nb = item - kb * nn, k0 = kb * 64, n0 = nb * 64;
    const int kk = lane >> 4, c = lane & 15;
#pragma unroll
    for (int i = 0; i < 4; ++i) { const float mxv = fmaxf(__uint_as_float(cm[n0 + 4 * c + i]), 1e-30f), S = 127.0f / mxv; v4u o;
        if (kb == 0 && kk == 0) cs[n0 + 4 * c + i] = mxv * (1.0f / 127.0f);
        o.x = pack4_i8(v[0][i] * S, v[1][i] * S, v[2][i] * S, v[3][i] * S); o.y = pack4_i8(v[4][i] * S, v[5][i] * S, v[6][i] * S, v[7][i] * S);
        o.z = pack4_i8(v[8][i] * S, v[9][i] * S, v[10][i] * S, v[11][i] * S); o.w = pack4_i8(v[12][i] * S, v[13][i] * S, v[14][i] * S, v[15][i] * S);
        *(LAS v4u*)(T + (4 * c + i) * CVT_TP8 + 16 * kk) = o; }
    const int r16 = lane >> 2, p = lane & 3;
#pragma unroll
    for (int q = 0; q < 4; ++q) { const int n = 16 * q + r16, nabs = n0 + n; const v4u val = *(const LAS v4u*)(T + n * CVT_TP8 + 16 * p);
        const int drow = (mode == 0) ? nabs : ((nabs >> 7) * 256 + (nabs & 127) + (mode == 2 ? 128 : 0));
        *(GAS v4u*)(WT + (size_t)drow * K + k0 + 16 * p) = val; }
}
__device__ __forceinline__ void cvt_matrix_i8(const Frame& F, const float* W, int K, int N, unsigned char* WT, int mode, int gw, int NGW, const float* g, const unsigned* cm, float* cs, int ldw = 0) {
    const int nitems = (K >> 6) * (N >> 6); LAS unsigned char* T = (LAS unsigned char*)(F.lds + RING_OFF + F.wave * CVT_TBYTES);
    for (int it = gw; it < nitems; it += 2 * NGW) { f32x4 v0[16], v1[16]; const bool two = it + NGW < nitems;
        cvt_load(W, N, it, F.lane, v0, g, ldw); if (two) cvt_load(W, N, it + NGW, F.lane, v1, g, ldw);
        cvt_store_i8(K, N, WT, mode, it, F.lane, v0, T, cm, cs); if (two) cvt_store_i8(K, N, WT, mode, it + NGW, F.lane, v1, T, cm, cs); }
}
__device__ __forceinline__ void cvt_matrix(const Frame& F, const float* W, int K, int N, bf16* WT, int mode, int gw, int NGW, const float* g = nullptr, int ldw = 0) {
    const int nitems = (K >> 6) * (N >> 6); LAS bf16* T = (LAS bf16*)(F.lds + RING_OFF + F.wave * CVT_TBYTES);
    for (int it = gw; it < nitems; it += 2 * NGW) { f32x4 v0[16], v1[16]; const bool two = it + NGW < nitems;
        cvt_load(W, N, it, F.lane, v0, g, ldw); if (two) cvt_load(W, N, it + NGW, F.lane, v1, g, ldw);
        cvt_store(K, N, WT, mode, it, F.lane, v0, T); if (two) cvt_store(K, N, WT, mode, it + NGW, F.lane, v1, T); }
}
__device__ __forceinline__ void row_q8_rstd(const float* xrow, unsigned char* qrow, float* rstd, int lane) {
    f32x4 a[8], b[8]; float s = 0.f, amax = 0.f;
#pragma unroll
    for (int j = 0; j < 8; ++j) { const GAS f32x4* p = (const GAS f32x4*)(xrow + 8 * lane + 512 * j); a[j] = p[0]; b[j] = p[1];
        s += (a[j][0] * a[j][0] + a[j][1] * a[j][1]) + (a[j][2] * a[j][2] + a[j][3] * a[j][3]) + (b[j][0] * b[j][0] + b[j][1] * b[j][1]) + (b[j][2] * b[j][2] + b[j][3] * b[j][3]);
        amax = fmaxf(amax, fmaxf(fmaxf(fmaxf(fabsf(a[j][0]), fabsf(a[j][1])), fmaxf(fabsf(a[j][2]), fabsf(a[j][3]))), fmaxf(fmaxf(fabsf(b[j][0]), fabsf(b[j][1])), fmaxf(fabsf(b[j][2]), fabsf(b[j][3]))))); }
    s = wave_sum(s);
#pragma unroll
    for (int o = 1; o < 64; o <<= 1) amax = fmaxf(amax, __shfl_xor(amax, o));
    amax = fmaxf(amax, 1e-20f); const float inv = 127.0f / amax;
#pragma unroll
    for (int j = 0; j < 8; ++j) { v2u w; w.x = pack4_i8(a[j][0] * inv, a[j][1] * inv, a[j][2] * inv, a[j][3] * inv); w.y = pack4_i8(b[j][0] * inv, b[j][1] * inv, b[j][2] * inv, b[j][3] * inv);
        *(GAS v2u*)(qrow + 8 * lane + 512 * j) = w; }
    if (lane == 0) *rstd = amax * (1.0f / 127.0f) / sqrtf(s * (1.0f / D) + EPS);
}
__device__ __forceinline__ void x_rows_phase(const Frame& F, const Args& A) {
    const int gw = F.vcu * NWAVES + F.wave, NGW = F.G * NWAVES;
    for (int m = gw; m < NTOK; m += NGW) { const float* xr = (m < NPR) ? A_x_p + (size_t)m * D : A_x_s + (size_t)(m - NPR) * D; row_q8_rstd(xr, (unsigned char*)A_ZN + (size_t)m * D, A_RSTD + m, F.lane); }
}
constexpr float F8_ASCALE = 16.0f;
__device__ __forceinline__ void rstd_phase(const Frame& F, const Args& A, bool fix, unsigned char* a8 = nullptr, unsigned char* q8 = nullptr, float* rq = nullptr) {
    const int gw = F.vcu * NWAVES + F.wave, NGW = F.G * NWAVES, lane = F.lane;
    for (int m = gw; m < NTOK; m += NGW) { bf16* hrow = A_HB + (size_t)m * D; float s = 0.f, amax = 0.f; float x[8][8];
#pragma unroll
        for (int j = 0; j < 8; ++j) unpack8(*(const GAS v4u*)(hrow + 8 * lane + 512 * j), x[j]);
        if (fix && m >= NPR) { const bf16* sbrow = A_SB + (size_t)(m - NPR) * D;
#pragma unroll
            for (int j = 0; j < 8; ++j) { float p[8]; unpack8(*(const GAS v4u*)(sbrow + 8 * lane + 512 * j), p);
#pragma unroll
                for (int e = 0; e < 8; ++e) x[j][e] += p[e];
                const v4u w = pack8(x[j]); *(GAS v4u*)(hrow + 8 * lane + 512 * j) = w; unpack8(w, x[j]); } }
#pragma unroll
        for (int j = 0; j < 8; ++j)
#pragma unroll
            for (int e = 0; e < 8; ++e) { s += x[j][e] * x[j][e]; amax = fmaxf(amax, fabsf(x[j][e])); }
        s = wave_sum(s);
        float rs = 1.0f / sqrtf(s * (1.0f / D) + EPS); const float rs0 = rs;
        if (a8) {
#pragma unroll
            for (int j = 0; j < 8; ++j) { constexpr float S8 = F8_ASCALE; v2u w; w.x = pg8::cvt4_fp8(x[j][0] * S8, x[j][1] * S8, x[j][2] * S8, x[j][3] * S8); w.y = pg8::cvt4_fp8(x[j][4] * S8, x[j][5] * S8, x[j][6] * S8, x[j][7] * S8);
                *(GAS v2u*)(a8 + (size_t)m * D + 8 * lane + 512 * j) = w; } }
        if (q8) {
#pragma unroll
            for (int o = 1; o < 64; o <<= 1) amax = fmaxf(amax, __shfl_xor(amax, o));
            amax = fmaxf(amax, 1e-20f); const float inv = 127.0f / amax; rs *= amax * (1.0f / 127.0f);
#pragma unroll
            for (int j = 0; j < 8; ++j) { v2u w; w.x = pack4_i8(x[j][0] * inv, x[j][1] * inv, x[j][2] * inv, x[j][3] * inv); w.y = pack4_i8(x[j][4] * inv, x[j][5] * inv, x[j][6] * inv, x[j][7] * inv);
                *(GAS v2u*)(q8 + (size_t)m * D + 8 * lane + 512 * j) = w; } }
        if (lane == 0) { if (rq) { A_RSTD[m] = rs0; rq[m] = rs; } else A_RSTD[m] = rs; } }
}
#ifndef CONV_PLACE
#define CONV_PLACE 1
#endif
__device__ __forceinline__ void convert_set1(const Frame& F, const Args& A, int gw, int NGW) {
    cvt_matrix(F, A_w1d, DFF, D, A_W1D, 0, gw, NGW); cvt_matrix(F, A_w_in + C_KA, D, 512, A_WINB, 0, gw, NGW, A_g_mix, INW); cvt_matrix(F, A_w_in + C_KR, D, 3072, A_WINB + (size_t)512 * D, 0, gw, NGW, A_g_mix, INW);
    cvt_matrix_i8(F, A_w_in + C_QA, D, 2048, A_WINQ, 0, gw, NGW, A_g_mix, A_CMWIN, A_CSWIN, INW); cvt_matrix_i8(F, A_w_in + C_QR, D, 1024, A_WINQ + (size_t)2048 * D, 0, gw, NGW, A_g_mix, A_CMWIN + 2048, A_CSWIN + 2048, INW);
    cvt_matrix_i8(F, A_w_in + C_GR, D, 2048, A_WINQ + (size_t)3072 * D, 0, gw, NGW, A_g_mix, A_CMWIN + 3072, A_CSWIN + 3072, INW); cvt_matrix(F, A_w_out, D, D, A_WOUT, 0, gw, NGW);
    colmax_matrix(F, A_w2g, D, DFF, A_CM2G, gw, NGW, A_g_ffn2); colmax_matrix(F, A_w2u, D, DFF, A_CM2U, gw, NGW, A_g_ffn2);
    colmax_matrix(F, A_w_pg, D, D, A_CMPG, gw, NGW, A_g_ple); }
__device__ __forceinline__ void convert_set2(const Frame& F, const Args& A, int gw, int NGW) {
    cvt_matrix_i8(F, A_w2g, D, DFF, (unsigned char*)A_W2GU, 1, gw, NGW, A_g_ffn2, A_CM2G, A_CS2G); cvt_matrix_i8(F, A_w2u, D, DFF, (unsigned char*)A_W2GU, 2, gw, NGW, A_g_ffn2, A_CM2U, A_CS2U); }
__device__ __forceinline__ void convert_set4(const Frame& F, const Args& A, int gw, int NGW) {
    cvt_matrix_f8(F, A_w2d, DFF, D, (unsigned char*)A_W2D, gw, NGW); cvt_matrix_i8(F, A_w_pg, D, D, (unsigned char*)A_WPG, 0, gw, NGW, A_g_ple, A_CMPG, A_CSPG); }
__device__ __forceinline__ void p0_stage1(const Frame& F, const Args& A) { const int gw0 = F.vcu * NWAVES + F.wave, NGW0 = F.G * NWAVES; colmax_matrix(F, A_w1g, D, DFF, A_CM1G, gw0, NGW0, A_g_ffn1); }
__device__ __forceinline__ void p0_stage2(const Frame& F, const Args& A) { const int gw0 = F.vcu * NWAVES + F.wave, NGW0 = F.G * NWAVES;
    cvt_matrix_i8(F, A_w1g, D, DFF, (unsigned char*)A_W1GU, 1, gw0, NGW0, A_g_ffn1, A_CM1G, A_CS1G); colmax_matrix(F, A_w1u, D, DFF, A_CM1U, gw0, NGW0, A_g_ffn1); }
__device__ __forceinline__ void p0_prologue(const Frame& F, const Args& A) {
    const int gw0 = F.vcu * NWAVES + F.wave, NGW0 = F.G * NWAVES;
    cvt_matrix_i8(F, A_w1u, D, DFF, (unsigned char*)A_W1GU, 2, gw0, NGW0, A_g_ffn1, A_CM1U, A_CS1U); cvt_matrix(F, A_w_pp, PLE, D, A_WPP, 0, gw0, NGW0);
    colmax_matrix(F, A_w_in + C_QA, D, 2048, A_CMWIN, gw0, NGW0, A_g_mix, INW); colmax_matrix(F, A_w_in + C_QR, D, 1024, A_CMWIN + 2048, gw0, NGW0, A_g_mix, INW); colmax_matrix(F, A_w_in + C_GR, D, 2048, A_CMWIN + 3072, gw0, NGW0, A_g_mix, INW);
    x_rows_phase(F, A);
    const int gt = F.vcu * (NWAVES * 64) + F.tid, NGT = F.G * NWAVES * 64;
    for (int i = gt; i < NTOK * PLE / 8; i += NGT) { const size_t e = (size_t)i * 8; const float* src = (e < (size_t)NPR * PLE) ? A_p_p + e : A_p_s + (e - (size_t)NPR * PLE);
        const f32x4 a = *(const GAS f32x4*)src, b = *(const GAS f32x4*)(src + 4); v4u o; o.x = cvtpk(a[0], a[1]); o.y = cvtpk(a[2], a[3]); o.z = cvtpk(b[0], b[1]); o.w = cvtpk(b[2], b[3]);
        *(GAS v4u*)(A_PB + e) = o; }
    for (int e = gt; e < NPOS * 64; e += NGT) { const int pos = e >> 6, i = e & 63;
        const double ang = (double)pos * exp2((double)i * (-13.287712379549449 / 64.0));
        const double k = rint(ang * 0.63661977236758134); double r = fma(-k, 1.5707963267948966, ang); r = fma(-k, 6.123233995736766e-17, r);
        const int q = ((int)k) & 3; const double r2 = r * r;
        const double sn = r * (1.0 + r2 * (-1.0 / 6 + r2 * (1.0 / 120 + r2 * (-1.0 / 5040 + r2 * (1.0 / 362880 + r2 * (-1.0 / 39916800 + r2 * (1.0 / 6227020800.0)))))));
        const double cs = 1.0 + r2 * (-0.5 + r2 * (1.0 / 24 + r2 * (-1.0 / 720 + r2 * (1.0 / 40320 + r2 * (-1.0 / 3628800 + r2 * (1.0 / 479001600.0 + r2 * (-1.0 / 87178291200.0)))))));
        const double c = (q == 0) ? cs : (q == 1) ? -sn : (q == 2) ? -cs : sn, s = (q == 0) ? sn : (q == 1) ? cs : (q == 2) ? -sn : -cs;
        A_ROPE[e] = (f32x2){(float)c, (float)s}; }
}

constexpr int AT_KS = 0, AT_KP = 72, AT_VT = 27648, AT_VP = 200;
__device__ __forceinline__ void attn_unit(const Frame& F, const Args& A, int ua) {
    const int tid = F.tid, lane = F.lane, wave = F.wave;
    const bool prompt = ua < 512;
    const int b = prompt ? (ua >> 8) : ((ua - 512) >> 2), c = prompt ? ((ua >> 2) & 63) : 0, kvh = ua & 3;
    const int row0 = prompt ? b * SEQ + c * 64 : NPR + b * 64;
    LAS bf16* Ks = (LAS bf16*)(F.lds + AT_KS); LAS bf16* Vt = (LAS bf16*)(F.lds + AT_VT);
    const int hh = kvh * 8 + wave, r = lane & 31, h = lane >> 5;
    v4u qraw0[4], qraw1[4];
    {   const bf16* q0p = A_U + (size_t)(row0 + r) * INW + C_QA + hh * 64 + 8 * h; const bf16* q1p = q0p + (size_t)32 * INW;
#pragma unroll
        for (int ks = 0; ks < 4; ++ks) { qraw0[ks] = *(const GAS v4u*)(q0p + 16 * ks); qraw1[ks] = *(const GAS v4u*)(q1p + 16 * ks); } }
    const int t = tid >> 3, dp = tid & 7;
    v4u kraw[3], vraw[3]; f32x4 ck[2][2], cv[2][2];
#pragma unroll
    for (int i = 0; i < 3; ++i) {
        if (prompt || i == 2) {
            const int kc = c - 2 + i; const bool valid = (!prompt) || kc >= 0;
            const int row = prompt ? b * SEQ + kc * 64 + t : row0 + t;
            kraw[i] = (v4u){0u, 0u, 0u, 0u}; vraw[i] = (v4u){0u, 0u, 0u, 0u};
            if (valid) { const bf16* up = A_U + (size_t)row * INW + kvh * 64 + 8 * dp; kraw[i] = *(const GAS v4u*)(up + C_KA); vraw[i] = *(const GAS v4u*)(up + C_VA); }
        } else if (i < 2) {
            const size_t ci = ((size_t)(b * 128 + i * 64 + t) * 4 + kvh) * 64 + 8 * dp;
            ck[i][0] = *(const GAS f32x4*)(A_cache_k + ci); ck[i][1] = *(const GAS f32x4*)(A_cache_k + ci + 4); cv[i][0] = *(const GAS f32x4*)(A_cache_v + ci); cv[i][1] = *(const GAS f32x4*)(A_cache_v + ci + 4);
        }
    }
    __syncthreads();
    {   const f32x4 gk0 = *(const GAS f32x4*)(A_g_k + 8 * dp), gk1 = *(const GAS f32x4*)(A_g_k + 8 * dp + 4);
#pragma unroll
        for (int i = 0; i < 3; ++i) {
            float kv[8], vv[8]; bool donorm;
            if (prompt || i == 2) { unpack8(kraw[i], kv); unpack8(vraw[i], vv); donorm = true; }
            else if (i < 2) {
#pragma unroll
                for (int e = 0; e < 4; ++e) { kv[e] = ck[i][0][e]; kv[4 + e] = ck[i][1][e]; vv[e] = cv[i][0][e]; vv[4 + e] = cv[i][1][e]; }
                donorm = false;
            }
            float ss = 0.f;
#pragma unroll
            for (int e = 0; e < 8; ++e) ss += kv[e] * kv[e];
            ss += __shfl_xor(ss, 1); ss += __shfl_xor(ss, 2); ss += __shfl_xor(ss, 4);
            if (donorm) { const float rstd = 1.0f / sqrtf(ss * (1.0f / 64) + EPS);
#pragma unroll
                for (int e = 0; e < 4; ++e) { kv[e] = kv[e] * rstd * gk0[e]; kv[4 + e] = kv[4 + e] * rstd * gk1[e]; } }
            const int key = 64 * i + t;
            *(LAS v4u*)(Ks + key * AT_KP + 8 * dp) = pack8(kv);
#pragma unroll
            for (int e = 0; e < 8; ++e) Vt[(8 * dp + e) * AT_VP + (key ^ (8 * dp))] = bf1(vv[e]);
            float* ok = nullptr; float* ov = nullptr;
            if (prompt) { if (i == 2 && c >= 62) { const size_t o = ((size_t)(b * 128 + (c - 62) * 64 + t) * 4 + kvh) * 64 + 8 * dp; ok = A_out + O_KP + o; ov = A_out + O_VP + o; } }
            else if (i >= 1) { const size_t o = ((size_t)(b * 128 + (i - 1) * 64 + t) * 4 + kvh) * 64 + 8 * dp; ok = A_out + O_KS + o; ov = A_out + O_VS + o; }
            if (ok) { *(GAS f32x4*)ok = (f32x4){kv[0], kv[1], kv[2], kv[3]}; *(GAS f32x4*)(ok + 4) = (f32x4){kv[4], kv[5], kv[6], kv[7]};
                      *(GAS f32x4*)ov = (f32x4){vv[0], vv[1], vv[2], vv[3]}; *(GAS f32x4*)(ov + 4) = (f32x4){vv[4], vv[5], vv[6], vv[7]}; }
        }
    }
    __syncthreads();
    const float sink = A_sinks[hh];
    const int kt_first = prompt ? (c >= 2 ? 0 : (2 - c) * 2) : 0;
    constexpr float L2E = 1.4426950408889634f;
#pragma unroll 1
    for (int qb = 0; qb < 2; ++qb) {
        float qf[4][8]; float ss = 0.f;
#pragma unroll
        for (int ks = 0; ks < 4; ++ks) { v4u qw; qw.x = qb ? qraw1[ks].x : qraw0[ks].x; qw.y = qb ? qraw1[ks].y : qraw0[ks].y; qw.z = qb ? qraw1[ks].z : qraw0[ks].z; qw.w = qb ? qraw1[ks].w : qraw0[ks].w; unpack8(qw, qf[ks]);
#pragma unroll
            for (int e = 0; e < 8; ++e) ss += qf[ks][e] * qf[ks][e]; }
        ss += __shfl_xor(ss, 32);
        const float sc = 0.125f / sqrtf(ss * (1.0f / 64) + EPS);
        bf16x8 Qf[4];
#pragma unroll
        for (int ks = 0; ks < 4; ++ks) { float t8[8];
            const f32x4 g0 = *(const GAS f32x4*)(A_g_q + 16 * ks + 8 * h), g1 = *(const GAS f32x4*)(A_g_q + 16 * ks + 8 * h + 4);
#pragma unroll
            for (int e = 0; e < 4; ++e) { t8[e] = qf[ks][e] * sc * g0[e]; t8[4 + e] = qf[ks][4 + e] * sc * g1[e]; }
            Qf[ks] = __builtin_bit_cast(bf16x8, pack8(t8)); }
        __builtin_amdgcn_sched_barrier(0);
        f32x16 S[6];
#pragma unroll
        for (int kt = 0; kt < 6; ++kt) {
#pragma unroll
            for (int i = 0; i < 16; ++i) S[kt][i] = 0.f;
#pragma unroll
            for (int ks = 0; ks < 4; ++ks) { const bf16x8 Af = *(const LAS bf16x8*)(Ks + (32 * kt + r) * AT_KP + 16 * ks + 8 * h); S[kt] = MFMA32(Af, Qf[ks], S[kt]); } }
        float mx = sink;
#pragma unroll
        for (int kt = 0; kt < 6; ++kt) if (kt >= kt_first) {
#pragma unroll
            for (int i = 0; i < 16; ++i) mx = fmaxf(mx, S[kt][i]); }
        mx = fmaxf(mx, __shfl_xor(mx, 32));
        float sum = 0.f;
#pragma unroll
        for (int kt = 0; kt < 6; ++kt) { const bool on = kt >= kt_first;
#pragma unroll
            for (int i = 0; i < 16; ++i) { const float p = on ? __builtin_amdgcn_exp2f((S[kt][i] - mx) * L2E) : 0.f; S[kt][i] = p; sum += p; } }
        sum += __shfl_xor(sum, 32);
        const float inv = 1.0f / (sum + __builtin_amdgcn_exp2f((sink - mx) * L2E));
        f32x16 O[2];
#pragma unroll
        for (int dt = 0; dt < 2; ++dt)
#pragma unroll
            for (int i = 0; i < 16; ++i) O[dt][i] = 0.f;
#pragma unroll
        for (int kt = 0; kt < 6; ++kt)
#pragma unroll
            for (int s = 0; s < 2; ++s) {
                float t8[8];
#pragma unroll
                for (int e = 0; e < 8; ++e) t8[e] = S[kt][8 * s + e];
                const bf16x8 B = __builtin_bit_cast(bf16x8, pack8(t8));
#pragma unroll
                for (int dt = 0; dt < 2; ++dt) { const LAS bf16* vp = Vt + (32 * dt + r) * AT_VP; const int sw = 8 * (((32 * dt + r) >> 3) & 7), k0 = 32 * kt + 16 * s + 4 * h;
                    const s16x4 lo = *(const LAS s16x4*)(vp + (k0 ^ sw)), hi = *(const LAS s16x4*)(vp + ((k0 + 8) ^ sw));
                    const bf16x8 Af = __builtin_shufflevector(lo, hi, 0, 1, 2, 3, 4, 5, 6, 7); O[dt] = MFMA32(Af, B, O[dt]); }
                __builtin_amdgcn_sched_barrier(0);
            }
        bf16* orow = A_MIX + (size_t)(row0 + qb * 32 + r) * D + hh * 64 + 4 * h;
#pragma unroll
        for (int dt = 0; dt < 2; ++dt)
#pragma unroll
            for (int rg = 0; rg < 4; ++rg) { v2u w; w.x = cvtpk(O[dt][4 * rg] * inv, O[dt][4 * rg + 1] * inv); w.y = cvtpk(O[dt][4 * rg + 2] * inv, O[dt][4 * rg + 3] * inv);
                *(GAS v2u*)(orow + 32 * dt + 8 * rg) = w; }
    }
}

__device__ __forceinline__ void rot_load(const Args& A, const bf16* src  , int pos, int dp, float (&o1)[8], float (&o2)[8]) {
    float x1[8], x2[8]; unpack8(*(const GAS v4u*)(src + 8 * dp), x1); unpack8(*(const GAS v4u*)(src + 64 + 8 * dp), x2);
    const GAS f32x4* tp = (const GAS f32x4*)(A_ROPE + (size_t)pos * 64 + 8 * dp);
#pragma unroll
    for (int e2 = 0; e2 < 4; ++e2) { const f32x4 cs = tp[e2];
        o1[2 * e2] = x1[2 * e2] * cs[0] - x2[2 * e2] * cs[1]; o2[2 * e2] = x2[2 * e2] * cs[0] + x1[2 * e2] * cs[1];
        o1[2 * e2 + 1] = x1[2 * e2 + 1] * cs[2] - x2[2 * e2 + 1] * cs[3]; o2[2 * e2 + 1] = x2[2 * e2 + 1] * cs[2] + x1[2 * e2 + 1] * cs[3]; }
}
constexpr float KSCALE = 0.088388347648318441f;
constexpr int RL_KT = 0, RL_P = 72, RL_VT = 18432;
__device__ __forceinline__ void retloc_unit(const Frame& F, const Args& A, int ur) {
    const int tid = F.tid, lane = F.lane, wave = F.wave;
    const bool prompt = ur < 1024;
    const int b = prompt ? (ur >> 9) : ((ur - 1024) >> 3), c = prompt ? ((ur >> 3) & 63) : 0, hh = ur & 7;
    const int row0 = prompt ? b * SEQ + c * 64 : NPR + b * 64, pos0 = prompt ? c * 64 : SEQ;
    const float l2g = log2_gamma(hh);
    LAS bf16* KT = (LAS bf16*)(F.lds + RL_KT); LAS bf16* VT = (LAS bf16*)(F.lds + RL_VT);
    __syncthreads();
    {   const int m = tid >> 3, dp = tid & 7; float o1[8], o2[8];
        rot_load(A, A_U + (size_t)(row0 + m) * INW + C_KR + hh * 128, pos0 + m, dp, o1, o2);
        const float sc = KSCALE * __builtin_amdgcn_exp2f((float)(63 - m) * l2g);
#pragma unroll
        for (int e = 0; e < 8; ++e) { KT[(8 * dp + e) * RL_P + (m ^ (8 * dp))] = bf1(o1[e] * sc); KT[(64 + 8 * dp + e) * RL_P + (m ^ (8 * dp))] = bf1(o2[e] * sc); }
#pragma unroll
        for (int i = 0; i < 4; ++i) { const int mm = 8 * wave + (lane & 7), vp = (lane >> 3) + 8 * i; float vv[8];
            unpack8(*(const GAS v4u*)(A_U + (size_t)(row0 + mm) * INW + C_VR + hh * 256 + 8 * vp), vv);
#pragma unroll
            for (int e = 0; e < 8; ++e) VT[(8 * vp + e) * RL_P + (mm ^ (8 * (lane >> 3)))] = bf1(vv[e]); }
    }
    __syncthreads();
    const int c16 = lane & 15, q4 = lane >> 4;
    f32x4 acc[8][2];
#pragma unroll
    for (int dt = 0; dt < 8; ++dt)
#pragma unroll
        for (int vt = 0; vt < 2; ++vt) acc[dt][vt] = (f32x4){0.f, 0.f, 0.f, 0.f};
    if (prompt) {
#pragma unroll
        for (int ks = 0; ks < 2; ++ks) { bf16x8 Bv[2];
#pragma unroll
            for (int vt = 0; vt < 2; ++vt) Bv[vt] = *(const LAS bf16x8*)(VT + (32 * wave + 16 * vt + c16) * RL_P + ((32 * ks + 8 * q4) ^ (8 * (((32 * wave + 16 * vt + c16) >> 3) & 7))));
#pragma unroll
            for (int dt = 0; dt < 8; ++dt) { const bf16x8 Af = *(const LAS bf16x8*)(KT + (16 * dt + c16) * RL_P + ((32 * ks + 8 * q4) ^ (8 * (((16 * dt + c16) >> 3) & 7))));
#pragma unroll
                for (int vt = 0; vt < 2; ++vt) acc[dt][vt] = MFMA16(Af, Bv[vt], acc[dt][vt]); } }
        bf16* rs = A_RS + (size_t)ur * 32768;
#pragma unroll
        for (int dt = 0; dt < 8; ++dt)
#pragma unroll
            for (int vt = 0; vt < 2; ++vt) { v2u w; w.x = cvtpk(acc[dt][vt][0], acc[dt][vt][1]); w.y = cvtpk(acc[dt][vt][2], acc[dt][vt][3]);
                *(GAS v2u*)(rs + (32 * wave + 16 * vt + c16) * 128 + 16 * dt + 4 * q4) = w; }
    } else {
#pragma unroll
        for (int ks = 0; ks < 2; ++ks) { bf16x8 Av[2];
#pragma unroll
            for (int vt = 0; vt < 2; ++vt) Av[vt] = *(const LAS bf16x8*)(VT + (32 * wave + 16 * vt + c16) * RL_P + ((32 * ks + 8 * q4) ^ (8 * (((32 * wave + 16 * vt + c16) >> 3) & 7))));
#pragma unroll
            for (int dt = 0; dt < 8; ++dt) { const bf16x8 Bk = *(const LAS bf16x8*)(KT + (16 * dt + c16) * RL_P + ((32 * ks + 8 * q4) ^ (8 * (((16 * dt + c16) >> 3) & 7))));
#pragma unroll
                for (int vt = 0; vt < 2; ++vt) acc[dt][vt] = MFMA16(Av[vt], Bk, acc[dt][vt]); } }
        const float g64 = __builtin_amdgcn_exp2f(64.0f * l2g);
        const size_t sb = (size_t)(b * 8 + hh) * 32768;
#pragma unroll
        for (int dt = 0; dt < 8; ++dt)
#pragma unroll
            for (int vt = 0; vt < 2; ++vt) { const size_t o = sb + (size_t)(16 * dt + c16) * 256 + 32 * wave + 16 * vt + 4 * q4;
                const f32x4 s = *(const GAS f32x4*)(A_state_in + o); *(GAS f32x4*)(A_out + O_SS + o) = s * g64 + acc[dt][vt]; }
    }
}
__device__ __forceinline__ void scan_phase(const Frame& F, const Args& A) {
    const int gt = F.vcu * (NWAVES * 64) + F.tid, NGT = F.G * NWAVES * 64;
    for (int i = gt; i < 16 * 8192; i += NGT) {
        const int ch = i >> 13, e4 = i & 8191, b = ch >> 3, hh = ch & 7;
        const float g64 = __builtin_amdgcn_exp2f(64.0f * log2_gamma(hh));
        f32x4 S = (f32x4){0.f, 0.f, 0.f, 0.f};
#pragma unroll 1
        for (int c0 = 0; c0 < 64; c0 += 8) {
            f32x4 loc[8];
#pragma unroll
            for (int j = 0; j < 8; ++j) { const v2u w = *(const GAS v2u*)(A_RS + (size_t)(b * 512 + (c0 + j) * 8 + hh) * 32768 + 4 * e4);
                loc[j] = (f32x4){__uint_as_float(w.x << 16), __uint_as_float(w.x & 0xffff0000u), __uint_as_float(w.y << 16), __uint_as_float(w.y & 0xffff0000u)}; }
#pragma unroll
            for (int j = 0; j < 8; ++j) { v2u w; w.x = cvtpk(S[0], S[1]); w.y = cvtpk(S[2], S[3]);
                *(GAS v2u*)(A_STB + (size_t)(b * 512 + (c0 + j) * 8 + hh) * 32768 + 4 * e4) = w; S = S * g64 + loc[j]; }
        }
        const int v = e4 >> 5, d0 = (e4 & 31) * 4;
        float* o = A_out + O_SP + (size_t)ch * 32768 + (size_t)d0 * 256 + v;
        o[0] = S[0]; o[256] = S[1]; o[512] = S[2]; o[768] = S[3];
    }
}
constexpr int RO_QP = 0, RO_KP = 17408, RO_DP = 136, RO_VT = 34816, RO_VP = 72, RO_PS = 71680, RO_PP = 72, RO_RED = 80896;
__device__ __forceinline__ void retout_unit(const Frame& F, const Args& A, int ur) {
    const int tid = F.tid, lane = F.lane, wave = F.wave;
    const bool prompt = ur < 1024;
    const int b = prompt ? (ur >> 9) : ((ur - 1024) >> 3), c = prompt ? ((ur >> 3) & 63) : 0, hh = ur & 7;
    const int row0 = prompt ? b * SEQ + c * 64 : NPR + b * 64, pos0 = prompt ? c * 64 : SEQ;
    const float l2g = log2_gamma(hh);
    LAS bf16* QP = (LAS bf16*)(F.lds + RO_QP); LAS bf16* KP = (LAS bf16*)(F.lds + RO_KP); LAS bf16* VT = (LAS bf16*)(F.lds + RO_VT); LAS bf16* PS = (LAS bf16*)(F.lds + RO_PS);
    LAS f32x2* RED = (LAS f32x2*)(F.lds + RO_RED);
    const int c16 = lane & 15, q4 = lane >> 4;
    bf16x8 Sf[4][2]; v2u gwr[4][2]; f32x4 grr[2];
#pragma unroll
    for (int vt = 0; vt < 2; ++vt) { const int v = 32 * wave + 16 * vt + c16; grr[vt] = *(const GAS f32x4*)(A_g_ret + hh * 256 + 32 * wave + 16 * vt + 4 * q4);
#pragma unroll
        for (int ks = 0; ks < 4; ++ks) { Sf[ks][vt] = (bf16x8){0, 0, 0, 0, 0, 0, 0, 0}; if (prompt) Sf[ks][vt] = *(const GAS bf16x8*)(A_STB + (size_t)ur * 32768 + v * 128 + 32 * ks + 8 * q4); }
#pragma unroll
        for (int lt = 0; lt < 4; ++lt) gwr[lt][vt] = *(const GAS v2u*)(A_U + (size_t)(row0 + 16 * lt + c16) * INW + C_GR + hh * 256 + 32 * wave + 16 * vt + 4 * q4); }
    __syncthreads();
    {   const int m = tid >> 3, dp = tid & 7; float o1[8], o2[8];
        const bf16* urow = A_U + (size_t)(row0 + m) * INW;
        rot_load(A, urow + C_QR + hh * 128, pos0 + m, dp, o1, o2);
        *(LAS v4u*)(QP + m * RO_DP + 8 * dp) = pack8(o1); *(LAS v4u*)(QP + m * RO_DP + 64 + 8 * dp) = pack8(o2);
        rot_load(A, urow + C_KR + hh * 128, pos0 + m, dp, o1, o2);
#pragma unroll
        for (int e = 0; e < 8; ++e) { o1[e] *= KSCALE; o2[e] *= KSCALE; }
        *(LAS v4u*)(KP + m * RO_DP + 8 * dp) = pack8(o1); *(LAS v4u*)(KP + m * RO_DP + 64 + 8 * dp) = pack8(o2);
#pragma unroll
        for (int i = 0; i < 4; ++i) { const int mm = 8 * wave + (lane & 7), vp = (lane >> 3) + 8 * i; float vv[8];
            unpack8(*(const GAS v4u*)(A_U + (size_t)(row0 + mm) * INW + C_VR + hh * 256 + 8 * vp), vv);
#pragma unroll
            for (int e = 0; e < 8; ++e) VT[(8 * vp + e) * RO_VP + (mm ^ (8 * (lane >> 3)))] = bf1(vv[e]); }
    }
    __syncthreads();
    {
        const int mt = wave >> 1;
#pragma unroll
        for (int t2 = 0; t2 < 2; ++t2) { const int lt = (wave & 1) * 2 + t2; f32x4 s = (f32x4){0.f, 0.f, 0.f, 0.f};
#pragma unroll
            for (int ks = 0; ks < 4; ++ks) { const bf16x8 Af = *(const LAS bf16x8*)(KP + (16 * mt + c16) * RO_DP + 32 * ks + 8 * q4), B = *(const LAS bf16x8*)(QP + (16 * lt + c16) * RO_DP + 32 * ks + 8 * q4);
                s = MFMA16(Af, B, s); }
            const int l = 16 * lt + c16, m0 = 16 * mt + 4 * q4; float p[4];
#pragma unroll
            for (int e = 0; e < 4; ++e) { const int dist = (l > m0 + e) ? (l - m0 - e) : (m0 + e - l); p[e] = s[e] * __builtin_amdgcn_exp2f((float)dist * l2g); }
            v2u w; w.x = cvtpk(p[0], p[1]); w.y = cvtpk(p[2], p[3]); *(LAS v2u*)(PS + l * RO_PP + m0) = w; }
    }
    __syncthreads();
    f32x4 acc[2][4];
#pragma unroll
    for (int vt = 0; vt < 2; ++vt)
#pragma unroll
        for (int lt = 0; lt < 4; ++lt) acc[vt][lt] = (f32x4){0.f, 0.f, 0.f, 0.f};
#pragma unroll
    for (int ks = 0; ks < 4; ++ks) { bf16x8 Af[2];
#pragma unroll
        for (int vt = 0; vt < 2; ++vt) { const int v = 32 * wave + 16 * vt + c16;
            if (prompt) Af[vt] = Sf[ks][vt];
            else { const float* sp = A_state_in + (size_t)(b * 8 + hh) * 32768 + (size_t)(32 * ks + 8 * q4) * 256 + v; float t8[8];
#pragma unroll
                for (int j = 0; j < 8; ++j) t8[j] = sp[j * 256];
                Af[vt] = __builtin_bit_cast(bf16x8, pack8(t8)); } }
#pragma unroll
        for (int lt = 0; lt < 4; ++lt) { const bf16x8 B = *(const LAS bf16x8*)(QP + (16 * lt + c16) * RO_DP + 32 * ks + 8 * q4);
#pragma unroll
            for (int vt = 0; vt < 2; ++vt) acc[vt][lt] = MFMA16(Af[vt], B, acc[vt][lt]); } }
#pragma unroll
    for (int lt = 0; lt < 4; ++lt) { const float qd = __builtin_amdgcn_exp2f((float)(16 * lt + c16 + 1) * l2g);
#pragma unroll
        for (int vt = 0; vt < 2; ++vt) acc[vt][lt] = acc[vt][lt] * qd; }
#pragma unroll
    for (int ks = 0; ks < 2; ++ks) { bf16x8 Af[2];
#pragma unroll
        for (int vt = 0; vt < 2; ++vt) Af[vt] = *(const LAS bf16x8*)(VT + (32 * wave + 16 * vt + c16) * RO_VP + ((32 * ks + 8 * q4) ^ (8 * (((32 * wave + 16 * vt + c16) >> 3) & 7))));
#pragma unroll
        for (int lt = 0; lt < 4; ++lt) { const bf16x8 B = *(const LAS bf16x8*)(PS + (16 * lt + c16) * RO_PP + 32 * ks + 8 * q4);
#pragma unroll
            for (int vt = 0; vt < 2; ++vt) acc[vt][lt] = MFMA16(Af[vt], B, acc[vt][lt]); } }
#pragma unroll
    for (int lt = 0; lt < 4; ++lt) { float s1 = 0.f, s2 = 0.f;
#pragma unroll
        for (int vt = 0; vt < 2; ++vt)
#pragma unroll
            for (int e = 0; e < 4; ++e) { const float x = acc[vt][lt][e]; s1 += x; s2 += x * x; }
        s1 += __shfl_xor(s1, 16); s2 += __shfl_xor(s2, 16); s1 += __shfl_xor(s1, 32); s2 += __shfl_xor(s2, 32);
        if (q4 == 0) RED[wave * 64 + 16 * lt + c16] = (f32x2){s1, s2}; }
    __syncthreads();
#pragma unroll
    for (int lt = 0; lt < 4; ++lt) { const int l = 16 * lt + c16; float s1 = 0.f, s2 = 0.f;
#pragma unroll
        for (int w = 0; w < 8; ++w) { const f32x2 t = RED[w * 64 + l]; s1 += t[0]; s2 += t[1]; }
        const float mean = s1 * (1.0f / 256), var = fmaxf(s2 * (1.0f / 256) - mean * mean, 0.f), rstd = 1.0f / sqrtf(var + EPS);
#pragma unroll
        for (int vt = 0; vt < 2; ++vt) { const int v0 = 32 * wave + 16 * vt + 4 * q4;
            const f32x4 gr = grr[vt]; const v2u gw = gwr[lt][vt];
            const float g0 = __uint_as_float(gw.x << 16), g1 = __uint_as_float(gw.x & 0xffff0000u), g2 = __uint_as_float(gw.y << 16), g3 = __uint_as_float(gw.y & 0xffff0000u);
            const f32x4 a = acc[vt][lt];
            v2u w; w.x = cvtpk((a[0] - mean) * rstd * gr[0] * silu_f(g0), (a[1] - mean) * rstd * gr[1] * silu_f(g1));
            w.y = cvtpk((a[2] - mean) * rstd * gr[2] * silu_f(g2), (a[3] - mean) * rstd * gr[3] * silu_f(g3));
            *(GAS v2u*)(A_MIX + (size_t)(row0 + l) * D + 2048 + hh * 256 + v0) = w; } }
}

__global__ void __launch_bounds__(NWAVES * 64, 2) fwd(Args args) {
    extern __shared__ __attribute__((aligned(16))) unsigned char lds[];
    Frame F;
    F.lds = (LAS unsigned char*)lds;
    F.MISC = (volatile LAS unsigned*)(F.lds + MISC_OFF);
    F.tid = threadIdx.x; F.lane = F.tid & 63; F.wave = __builtin_amdgcn_readfirstlane(F.tid >> 6);
    F.G = gridDim.x; { const int bx = blockIdx.x; F.vcu = (F.G % 8 == 0) ? (bx % 8) * (F.G / 8) + bx / 8 : bx; }
    const Args& A = args;
    F.ctl = (gu32*)(args.ws + WS_CTL);
    for (int u = F.tid; u < (LDS_BYTES - LDSCTL_OFF) / 4; u += NWAVES * 64) ((LAS unsigned*)(F.lds + LDSCTL_OFF))[u] = 0u;
    __syncthreads();
    XcdBarrier bar; bar.bar = (unsigned*)(F.ctl + CW_BAR); bar.x = 0; bar.st = nullptr;
    if (MK_ONE_LAUNCH) bar = xcd_barrier_post((unsigned*)(F.ctl + CW_BAR), F.MISC + 8);
    const int lo = args.ph_lo, hi = args.ph_hi;
#ifndef ONLY_PHASE
#define ONLY_PHASE -1
#endif
#define IN(k) ((ONLY_PHASE < 0 || ONLY_PHASE == (k)) && lo <= (k) && (k) < hi)
#define SEAM(k) do { if (IN(k) && IN((k) + 1)) xcd_barrier(bar); } while (0)
    const int bx = (int)blockIdx.x;

    if (IN(0)) { p0_stage1(F, A); xcd_barrier(bar); p0_stage2(F, A); xcd_barrier(bar); p0_prologue(F, A); } SEAM(0);
    if (IN(1)) {
        { pg8::Gemm g{A_ZN, A_W1GU, NTOK, 2 * DFF, D / 2, D / 2, 0}; pg8::StaticOrder S; S.init(NTOK, 2 * DFF, F.G, bx); pg8::EpiSwiGLU<false, true> E{A_HID, DFF, A_RSTD, A_CS1G, A_CS1U};
          pg8::gemm_phase<pg8::EpiSwiGLU<false, true>, pg8::StaticOrder, true, true, false, false, true>(F.lds + RING_OFF, g, S, E); }
        __syncthreads();
#if CONV_PLACE != 0
        {
          const int nwg1 = (NTOK / 256) * (2 * DFF / 256), rem = nwg1 % F.G; const bool conv = (rem == 0) || (bx >= rem); const int jc = (rem == 0) ? bx : bx - rem, nconv = (rem == 0) ? F.G : F.G - rem;
          if (conv) convert_set1(F, A, jc * NWAVES + F.wave, nconv * NWAVES);
          if (!conv) {
            int kple = PLE; asm volatile("" : "+s"(kple));
            pg8::Gemm g{A_PB, A_WPP, NTOK, D, kple, kple, 0}; pg8::StaticOrder S; S.init(NTOK, D, rem, bx); pg8::EpiBf16 E{A_TP, D, nullptr};
            pg8::gemm_phase<pg8::EpiBf16, pg8::StaticOrder, true, true>(F.lds + RING_OFF, g, S, E); } }
#endif
    } SEAM(1);
    if (IN(2)) { { pg8::Gemm g{A_HID, A_W1D, NPR, D, DFF, DFF, 0}; pg8::StaticOrder S; S.init(NPR, D, F.G, bx); pg8::EpiRes<false> E{A_x_p, nullptr, A_HB, nullptr, D, 0.5f, nullptr};
          pg8::gemm_phase<pg8::EpiRes<false>, pg8::StaticOrder, true, true>(F.lds + RING_OFF, g, S, E); }
        __syncthreads();
        { pg8::Gemm g{A_HID + (size_t)NPR * DFF, A_W1D, NTOK - NPR, D, DFF, DFF, ((DFF / 64 / 2 + 1) & ~1)}; pg8::SplitKOrder S; S.init(D, F.G, bx); pg8::EpiRes<false> E{A_x_s, nullptr, A_HB + (size_t)NPR * D, A_SB, D, 0.5f, nullptr};
          pg8::gemm_phase<pg8::EpiRes<false>, pg8::SplitKOrder, true, true>(F.lds + RING_OFF, g, S, E); } } SEAM(2);
    if (IN(3)) { rstd_phase(F, A, true, nullptr, (unsigned char*)A_ZN, A_RSTDQ); } SEAM(3);
    if (IN(4)) {
        const int nb4 = (NTOK / 256) * 14, ni4 = (NTOK / 256) * 20, rb = nb4 % F.G, ri = ni4 % F.G; const int bxi = (rb % 8 == 0) ? (bx + F.G - rb) % F.G : bx;
        { pg8::Gemm g{A_HB, A_WINB, NTOK, 3584, D, D, 0}; pg8::StaticOrder S; S.init(NTOK, 3584, F.G, bx); pg8::EpiU<false> E{A_U, INW, A_RSTD, nullptr};
          pg8::gemm_phase<pg8::EpiU<false>, pg8::StaticOrder, true, true>(F.lds + RING_OFF, g, S, E); }
        __syncthreads();
        { pg8::Gemm g{A_ZN, (const bf16*)A_WINQ, NTOK, 5120, D / 2, D / 2, 0}; pg8::StaticOrder S; S.init(NTOK, 5120, F.G, bxi); pg8::EpiU<true> E{A_U, INW, A_RSTDQ, A_CSWIN};
          pg8::gemm_phase<pg8::EpiU<true>, pg8::StaticOrder, true, true, false, false, true>(F.lds + RING_OFF, g, S, E); }
        __syncthreads();
#if CONV_PLACE != 0
        { const bool conv = (bx >= rb) && (bxi >= ri); int jc = 0, nconv = 0;
          for (int b = 0; b < F.G; ++b) { const int bi = (rb % 8 == 0) ? (b + F.G - rb) % F.G : b; const bool cv = (b >= rb) && (bi >= ri); if (cv) { if (b < bx) ++jc; ++nconv; } }
          if (conv) convert_set2(F, A, jc * NWAVES + F.wave, nconv * NWAVES); }
#endif
    } SEAM(4);
    if (IN(5)) { for (int u = F.vcu; u < 1280; u += F.G) retloc_unit(F, A, u); for (int u = F.vcu; u < 640; u += F.G) attn_unit(F, A, u); } SEAM(5);
    if (IN(6)) { scan_phase(F, A); } SEAM(6);
    if (IN(7)) { for (int u = F.vcu; u < 1280; u += F.G) retout_unit(F, A, u); __syncthreads(); } SEAM(7);
    if (IN(8)) { { pg8::Gemm g{A_MIX, A_WOUT, NPR, D, D, D, 0}; pg8::StaticOrder S; S.init(NPR, D, F.G, bx); pg8::EpiRes<true> E{nullptr, A_HB, A_HB, nullptr, D, 1.0f, nullptr};
          pg8::gemm_phase<pg8::EpiRes<true>, pg8::StaticOrder, true, true>(F.lds + RING_OFF, g, S, E); }
        __syncthreads();
        { pg8::Gemm g{A_MIX + (size_t)NPR * D, A_WOUT, NTOK - NPR, D, D, D, ((D / 64 / 2 + 1) & ~1)}; pg8::SplitKOrder S; S.init(D, F.G, bx); pg8::EpiRes<true> E{nullptr, A_HB + (size_t)NPR * D, A_HB + (size_t)NPR * D, A_SB, D, 1.0f, nullptr};
          pg8::gemm_phase<pg8::EpiRes<true>, pg8::SplitKOrder, true, true>(F.lds + RING_OFF, g, S, E); } } SEAM(8);
    if (IN(9)) { rstd_phase(F, A, true, nullptr, (unsigned char*)A_ZN); } SEAM(9);
    if (IN(10)) { { pg8::Gemm g{A_ZN, A_W2GU, NTOK, 2 * DFF, D / 2, D / 2, 0}; pg8::StaticOrder S; S.init(NTOK, 2 * DFF, F.G, bx); pg8::EpiSwiGLU<true, true> E{A_HID, DFF, A_RSTD, A_CS2G, A_CS2U};
        pg8::gemm_phase<pg8::EpiSwiGLU<true, true>, pg8::StaticOrder, true, true, false, false, true>(F.lds + RING_OFF, g, S, E); }
        __syncthreads();
        { const int nwg10 = (NTOK / 256) * (2 * DFF / 256), rem = nwg10 % F.G; const bool conv = (rem == 0) || (bx >= rem); const int jc = (rem == 0) ? bx : bx - rem, nconv = (rem == 0) ? F.G : F.G - rem;
          if (conv) convert_set4(F, A, jc * NWAVES + F.wave, nconv * NWAVES); }
        if (((NTOK / 256) * (2 * DFF / 256)) % F.G == 0) {
          __syncthreads(); int kple = PLE; asm volatile("" : "+s"(kple));
          pg8::Gemm g{A_PB, A_WPP, NTOK, D, kple, kple, 0}; pg8::StaticOrder S; S.init(NTOK, D, F.G, bx); pg8::EpiBf16 E{A_TP, D, nullptr};
          pg8::gemm_phase<pg8::EpiBf16, pg8::StaticOrder, true, true>(F.lds + RING_OFF, g, S, E); }
    } SEAM(10);
    if (IN(11)) { constexpr float DS = 0.5f / (pg8::F8_HSCALE * pg8::F8_WSCALE);
        pg8::Gemm g{A_HID, A_W2D, NTOK, D, DFF / 2, DFF / 2, 0}; pg8::HalfOrder S; S.init(2 * NTOK, D, F.G, bx); pg8::EpiRes<true> E{nullptr, A_HB, A_HB, nullptr, D, DS, nullptr};
        pg8::gemm_phase_f8mh<pg8::EpiRes<true>, pg8::HalfOrder>(F.lds + RING_OFF, g, S, E); } SEAM(11);
    if (IN(12)) { rstd_phase(F, A, false, nullptr, (unsigned char*)A_ZN); } SEAM(12);
    if (IN(13)) {
        pg8::Gemm g{A_ZN, A_WPG, NTOK, D, D / 2, D / 2, 0}; pg8::TailHalfOrder S; S.init(NTOK, D, F.G, bx); pg8::EpiPLE<true> E{A_HB, A_out, A_TP, D, A_RSTD, 1.0f, A_CSPG};
        pg8::gemm_phase<pg8::EpiPLE<true>, pg8::TailHalfOrder, true, true, false, false, true>(F.lds + RING_OFF, g, S, E); }
#undef IN
#undef SEAM
}

extern "C" void kernel_launch(void* const* d_in, const int* in_sizes, int n_in, void* d_out, int out_size, void* d_ws, size_t ws_size, hipStream_t stream) {
    static int grid = 0;
    if (grid == 0) {
        if (n_in != 25 || (size_t)out_size != O_END || ws_size < WS_END) { fprintf(stderr, "kernel_launch: unexpected shapes (n_in %d, out %d, ws %zu); nothing launched\n", n_in, out_size, ws_size); grid = -1; return; }
        int dev = 0, cus = 0, per_cu = 0;
        if (hipGetDevice(&dev) != hipSuccess || hipDeviceGetAttribute(&cus, hipDeviceAttributeMultiprocessorCount, dev) != hipSuccess) { grid = -1; return; }
        if (hipFuncSetAttribute((const void*)fwd, hipFuncAttributeMaxDynamicSharedMemorySize, LDS_BYTES) != hipSuccess) { fprintf(stderr, "kernel_launch: hipFuncSetAttribute failed\n"); grid = -1; return; }
        if (hipOccupancyMaxActiveBlocksPerMultiprocessor(&per_cu, (const void*)fwd, NWAVES * 64, LDS_BYTES) != hipSuccess || per_cu < 1) { fprintf(stderr, "kernel_launch: occupancy query reports %d\n", per_cu); }
        (void)hipGetLastError();
        grid = cus;
    }
    if (grid < 0) return;
    if (hipMemsetAsync((char*)d_ws + WS_CTL, 0, CTL_ZERO_BYTES, stream) != hipSuccess) return;
    Args a{};
    for (int i = 0; i < 25; ++i) a.in[i] = (const float*)d_in[i];
    a.out = (float*)d_out; a.ws = (unsigned char*)d_ws;
#if MK_ONE_LAUNCH
    a.ph_lo = 0; a.ph_hi = N_PHASES;
    hipLaunchKernelGGL(fwd, dim3(grid), dim3(NWAVES * 64), LDS_BYTES, stream, a);
#else
    for (int p = 0; p < N_PHASES; ++p) { a.ph_lo = p; a.ph_hi = p + 1; hipLaunchKernelGGL(fwd, dim3(grid), dim3(NWAVES * 64), LDS_BYTES, stream, a); }
#endif
}
```

```cpp
#define CONV_PLACE 1
#include <hip/hip_runtime.h>
#include <cstdio>
#include <cstdint>
namespace pg8 {
#define PG8_LAS __attribute__((address_space(3)))
typedef unsigned short bf16_t;
typedef short bf16x8 __attribute__((ext_vector_type(8)));
typedef float f32x4 __attribute__((ext_vector_type(4)));
typedef unsigned u32x4 __attribute__((ext_vector_type(4)));
typedef int i32x8 __attribute__((ext_vector_type(8)));
typedef int i32x4 __attribute__((ext_vector_type(4)));
constexpr int BM = 256, BK = 64, HALF = 128, HTB = HALF * BK * 2  , STAGE_BYTES = 8 * HTB, NXCD = 8, WGM = 8;

__host__ __device__ __forceinline__ int lds_byte(int r, int c) { const int st = (r >> 4) * 2 + (c >> 5), rr = r & 15, cc = c & 31, ob = rr * 64 + cc * 2; return st * 1024 + (ob ^ (((ob >> 9) & 1) << 5)); }
__host__ __device__ __forceinline__ void stage_rc(int b, int& R, int& C) { const int st = b / 1024, sb = b % 1024, swz = sb ^ (((sb >> 9) & 1) << 5); R = (st >> 1) * 16 + swz / 64; C = (st & 1) * 32 + (swz % 64) / 2; }
__host__ __device__ __forceinline__ int perm32(int rho) { const int n = rho >> 4, i = rho & 15; return 8 * (i >> 2) + 4 * n + (i & 3); }

struct Unit { int pm, pn, kh, half; };
struct Gemm { const bf16_t* A; const bf16_t* Bt; int M, N, K, ld, ksplit; };

struct StaticOrder {
    int nM, nN, nwg, G, c;
    __host__ __device__ void init(int M, int N, int G_, int c_) { nM = M / BM; nN = N / BM; nwg = nM * nN; G = G_; c = c_; }
    __host__ __device__ bool next(int i, Unit& u) const {
        const long L = (long)i * G + c; if (L >= nwg) return false;
        int wgid = (int)L; { const int q = nwg / NXCD, r = nwg % NXCD, xcd = wgid % NXCD, off = wgid / NXCD; wgid = (xcd < r ? xcd * (q + 1) : r * (q + 1) + (xcd - r) * q) + off; }
        const int nig = WGM * nN, gid = wgid / nig, fm = gid * WGM, gsz = (nM - fm) < WGM ? (nM - fm) : WGM;
        u.pm = fm + ((wgid % nig) % gsz); u.pn = (wgid % nig) / gsz; u.kh = 0; u.half = 0; return true;
    }
    __device__ __forceinline__ void a_ready(const Unit&) const {}
    __device__ __forceinline__ void done(const Unit&) const {}
};

struct RangeOrder : StaticOrder {
    int i0, i1;
    __host__ __device__ bool next(int i, Unit& u) const { return (i0 + i < i1) && StaticOrder::next(i0 + i, u); }
};
struct HalfOrder : StaticOrder {
    __host__ __device__ bool next(int i, Unit& u) const { if (!StaticOrder::next(i, u)) return false; u.half = 1 + (u.pm & 1); u.pm >>= 1; return true; }
};
struct TailHalfOrder : StaticOrder {
    __host__ __device__ bool next(int i, Unit& u) const {
        const int nfull = nwg / G, R = nwg - nfull * G;
        if (i < nfull || R == 0 || 2 * R > G) return StaticOrder::next(i, u);
        if (i > nfull || c >= 2 * R) return false;
        StaticOrder t = *this; t.c = c >> 1; if (!t.StaticOrder::next(nfull, u)) return false; u.half = 1 + (c & 1); return true;
    }
};
struct SplitKOrder {
    int nN, G, c;
    __host__ __device__ void init(int N, int G_, int c_) { nN = N / BM; G = G_; c = c_; }
    __host__ __device__ bool next(int i, Unit& u) const { const long L = (long)i * G + c; if (L >= 16L * nN) return false; const int x = (int)(L & 7), j = (int)((L >> 3) & 31), blk = (int)(L >> 8); u.pm = j & 7; u.kh = x & 1; u.pn = 16 * blk + 4 * (x >> 1) + (j >> 3); u.half = 0; return true; }
    __device__ __forceinline__ void a_ready(const Unit&) const {}
    __device__ __forceinline__ void done(const Unit&) const {}
};

__device__ __forceinline__ unsigned cvt_pk_bf16(float lo, float hi) { unsigned r; asm volatile("v_cvt_pk_bf16_f32 %0, %1, %2" : "=v"(r) : "v"(lo), "v"(hi)); return r; }
typedef float f32x2 __attribute__((ext_vector_type(2)));
typedef __bf16 bf16x2_t __attribute__((ext_vector_type(2)));
__device__ __forceinline__ unsigned cvtpk(float lo, float hi) { f32x2 v = {lo, hi}; bf16x2_t b = __builtin_convertvector(v, bf16x2_t); return __builtin_bit_cast(unsigned, b); }
__device__ __forceinline__ float sigmoid_f(float g) { return __builtin_amdgcn_rcpf(1.0f + __builtin_amdgcn_exp2f(-1.4426950408889634f * g)); }
__device__ __forceinline__ float silu_f(float g) { return g * sigmoid_f(g); }
__device__ __forceinline__ f32x4 sigmoid4(const f32x4 g) {
    const f32x4 t = g * (-1.4426950408889634f); f32x4 e; e[0] = __builtin_amdgcn_exp2f(t[0]); e[1] = __builtin_amdgcn_exp2f(t[1]); e[2] = __builtin_amdgcn_exp2f(t[2]); e[3] = __builtin_amdgcn_exp2f(t[3]);
    const f32x4 d = e + 1.0f; f32x4 r; r[0] = __builtin_amdgcn_rcpf(d[0]); r[1] = __builtin_amdgcn_rcpf(d[1]); r[2] = __builtin_amdgcn_rcpf(d[2]); r[3] = __builtin_amdgcn_rcpf(d[3]); return r; }
__device__ __forceinline__ f32x4 swiglu4(const f32x4 g, const f32x4 u, float s) {
    const f32x4 t = g * (-1.4426950408889634f); f32x4 e; e[0] = __builtin_amdgcn_exp2f(t[0]); e[1] = __builtin_amdgcn_exp2f(t[1]); e[2] = __builtin_amdgcn_exp2f(t[2]); e[3] = __builtin_amdgcn_exp2f(t[3]);
    const f32x4 d = e + 1.0f; f32x4 r; r[0] = __builtin_amdgcn_rcpf(d[0]); r[1] = __builtin_amdgcn_rcpf(d[1]); r[2] = __builtin_amdgcn_rcpf(d[2]); r[3] = __builtin_amdgcn_rcpf(d[3]);
    return (g * r) * (u * s); }

struct EpiBf16 {
    static constexpr bool PERM = true, AFTER_DRAIN = false;
    bf16_t* O; int ldc; const float* rstd;
    __device__ __forceinline__ void operator()(const f32x4 (&acc)[2][2][4][2], const Unit& u, int wr, int wc, int fr, int fq) const {
        const int row0 = u.pm * BM + wr * 64 + fr, col0 = u.pn * BM + wc * 32 + 8 * fq;
        float rsv[2][4];
#pragma unroll
        for (int ai = 0; ai < 2; ++ai)
#pragma unroll
            for (int m = 0; m < 4; ++m) rsv[ai][m] = rstd ? rstd[row0 + ai * HALF + m * 16] : 1.0f;
#pragma unroll
        for (int ai = 0; ai < 2; ++ai)
#pragma unroll
            for (int m = 0; m < 4; ++m) { bf16_t* rowp = O + (size_t)(row0 + ai * HALF + m * 16) * ldc + col0; const float rs = rsv[ai][m];
#pragma unroll
                for (int bj = 0; bj < 2; ++bj) { const f32x4 v0 = acc[ai][bj][m][0] * rs, v1 = acc[ai][bj][m][1] * rs;
                    u32x4 w; w.x = cvtpk(v0[0], v0[1]); w.y = cvtpk(v0[2], v0[3]); w.z = cvtpk(v1[0], v1[1]); w.w = cvtpk(v1[2], v1[3]);
                    *(u32x4*)(rowp + bj * HALF) = w; } }
    }
};
template <bool I8IN> struct EpiU {
    static constexpr bool PERM = true, AFTER_DRAIN = false;
    bf16_t* O; int ldc; const float* rstd; const float* cs;
    __device__ __forceinline__ void operator()(const f32x4 (&acc)[2][2][4][2], const Unit& u, int wr, int wc, int fr, int fq) const {
        const int tile = I8IN ? (u.pn < 8 ? u.pn : (u.pn < 12 ? u.pn + 2 : u.pn + 14)) : (u.pn < 2 ? u.pn + 8 : u.pn + 12);
        const int row0 = u.pm * BM + wr * 64 + fr, cc0 = u.pn * BM + wc * 32 + 8 * fq, col0 = tile * BM + wc * 32 + 8 * fq;
        f32x4 csv[2][2]; float rsv[2][4];
        if constexpr (I8IN) {
#pragma unroll
            for (int bj = 0; bj < 2; ++bj) { csv[bj][0] = *(const f32x4*)(cs + cc0 + bj * HALF); csv[bj][1] = *(const f32x4*)(cs + cc0 + bj * HALF + 4); } }
#pragma unroll
        for (int ai = 0; ai < 2; ++ai)
#pragma unroll
            for (int m = 0; m < 4; ++m) rsv[ai][m] = rstd[row0 + ai * HALF + m * 16];
#pragma unroll
        for (int ai = 0; ai < 2; ++ai)
#pragma unroll
            for (int m = 0; m < 4; ++m) { bf16_t* rowp = O + (size_t)(row0 + ai * HALF + m * 16) * ldc + col0; const float rs = rsv[ai][m];
#pragma unroll
                for (int bj = 0; bj < 2; ++bj) { f32x4 v0, v1;
                    if constexpr (I8IN) { v0 = __builtin_convertvector(__builtin_bit_cast(i32x4, acc[ai][bj][m][0]), f32x4) * (csv[bj][0] * rs); v1 = __builtin_convertvector(__builtin_bit_cast(i32x4, acc[ai][bj][m][1]), f32x4) * (csv[bj][1] * rs); }
                    else { v0 = acc[ai][bj][m][0] * rs; v1 = acc[ai][bj][m][1] * rs; }
                    u32x4 w; w.x = cvtpk(v0[0], v0[1]); w.y = cvtpk(v0[2], v0[3]); w.z = cvtpk(v1[0], v1[1]); w.w = cvtpk(v1[2], v1[3]);
                    *(u32x4*)(rowp + bj * HALF) = w; } }
    }
};
constexpr float F8_HSCALE = 8.0f, F8_WSCALE = 256.0f, F8_MAX = 448.0f;
__device__ __forceinline__ unsigned cvt4_fp8(float a, float b, float c, float d) {
    a = __builtin_amdgcn_fmed3f(a, -F8_MAX, F8_MAX); b = __builtin_amdgcn_fmed3f(b, -F8_MAX, F8_MAX); c = __builtin_amdgcn_fmed3f(c, -F8_MAX, F8_MAX); d = __builtin_amdgcn_fmed3f(d, -F8_MAX, F8_MAX);
    int r = 0; r = __builtin_amdgcn_cvt_pk_fp8_f32(a, b, r, false); r = __builtin_amdgcn_cvt_pk_fp8_f32(c, d, r, true); return (unsigned)r; }
template <bool F8OUT, bool I8IN = false> struct EpiSwiGLU {
    static constexpr bool PERM = true, AFTER_DRAIN = false;
    bf16_t* O; int ldc; const float* rstd; const float* csg; const float* csu;
    __device__ __forceinline__ void operator()(const f32x4 (&acc)[2][2][4][2], const Unit& u, int wr, int wc, int fr, int fq) const {
        typedef unsigned u32x2v __attribute__((ext_vector_type(2)));
        const int row0 = u.pm * BM + (u.half == 2 ? HALF : 0) + wr * 64 + fr, col0 = u.pn * HALF + wc * 32 + 8 * fq;
        f32x4 cg0, cg1, cu0, cu1;
        if constexpr (I8IN) { cg0 = *(const f32x4*)(csg + col0); cg1 = *(const f32x4*)(csg + col0 + 4); cu0 = *(const f32x4*)(csu + col0); cu1 = *(const f32x4*)(csu + col0 + 4); }
        float rsv[2][4];
#pragma unroll
        for (int ai = 0; ai < 2; ++ai)
#pragma unroll
            for (int m = 0; m < 4; ++m) rsv[ai][m] = rstd[row0 + ai * HALF + m * 16];
#pragma unroll
        for (int ai = 0; ai < 2; ++ai) if (ai == 0 || u.half == 0)
#pragma unroll
            for (int m = 0; m < 4; ++m) {
                const float rs = rsv[ai][m];
                f32x4 g0, g1, u0, u1;
                if constexpr (I8IN) { const f32x4 sg0 = cg0 * rs, sg1 = cg1 * rs, su0 = cu0 * rs, su1 = cu1 * rs;
                    g0 = __builtin_convertvector(__builtin_bit_cast(i32x4, acc[ai][0][m][0]), f32x4) * sg0; g1 = __builtin_convertvector(__builtin_bit_cast(i32x4, acc[ai][0][m][1]), f32x4) * sg1;
                    u0 = __builtin_convertvector(__builtin_bit_cast(i32x4, acc[ai][1][m][0]), f32x4) * su0; u1 = __builtin_convertvector(__builtin_bit_cast(i32x4, acc[ai][1][m][1]), f32x4) * su1; }
                else { g0 = acc[ai][0][m][0] * rs; g1 = acc[ai][0][m][1] * rs; u0 = acc[ai][1][m][0] * rs; u1 = acc[ai][1][m][1] * rs; }
                if constexpr (F8OUT) { unsigned char* rowp = (unsigned char*)O + (size_t)(row0 + ai * HALF + m * 16) * ldc + col0; const f32x4 h0 = swiglu4(g0, u0, F8_HSCALE), h1 = swiglu4(g1, u1, F8_HSCALE);
                    u32x2v w; w.x = cvt4_fp8(h0[0], h0[1], h0[2], h0[3]); w.y = cvt4_fp8(h1[0], h1[1], h1[2], h1[3]);
                    *(u32x2v*)rowp = w; }
                else { bf16_t* rowp = O + (size_t)(row0 + ai * HALF + m * 16) * ldc + col0; const f32x4 h0 = swiglu4(g0, u0, 1.0f), h1 = swiglu4(g1, u1, 1.0f);
                    u32x4 w; w.x = cvtpk(h0[0], h0[1]); w.y = cvtpk(h0[2], h0[3]); w.z = cvtpk(h1[0], h1[1]); w.w = cvtpk(h1[2], h1[3]);
                    *(u32x4*)rowp = w; } }
    }
};
template <bool RES_BF16, int SPLIT = (1 << 30)> struct EpiRes {
    static constexpr bool PERM = true, AFTER_DRAIN = false;
    const float* resf; const bf16_t* resb; bf16_t* hb; bf16_t* sb; int ldc; float scale; const float* resf2;
    __device__ __forceinline__ void operator()(const f32x4 (&acc)[2][2][4][2], const Unit& u, int wr, int wc, int fr, int fq) const {
        const int row0 = u.pm * BM + (u.half == 2 ? HALF : 0) + wr * 64 + fr, col0 = u.pn * BM + wc * 32 + 8 * fq;
        if (u.kh == 0) {
#pragma unroll
            for (int ai = 0; ai < 2; ++ai) if (ai == 0 || u.half == 0)
#pragma unroll
                for (int m = 0; m < 4; ++m) { const size_t off = (size_t)(row0 + ai * HALF + m * 16) * ldc + col0;
#pragma unroll
                    for (int bj = 0; bj < 2; ++bj) { f32x4 r0, r1;
                        if (RES_BF16) { const u32x4 w = *(const u32x4*)(resb + off + bj * HALF);
                            r0 = (f32x4){__uint_as_float(w.x << 16), __uint_as_float(w.x & 0xffff0000u), __uint_as_float(w.y << 16), __uint_as_float(w.y & 0xffff0000u)};
                            r1 = (f32x4){__uint_as_float(w.z << 16), __uint_as_float(w.z & 0xffff0000u), __uint_as_float(w.w << 16), __uint_as_float(w.w & 0xffff0000u)}; }
                        else { const float* rp = resf + off; if constexpr (SPLIT < (1 << 30)) { if (u.pm * BM >= SPLIT) rp = resf2 + (off - (size_t)SPLIT * ldc); }
                            r0 = *(const f32x4*)(rp + bj * HALF); r1 = *(const f32x4*)(rp + bj * HALF + 4); }
                        const f32x4 h0 = r0 + acc[ai][bj][m][0] * scale, h1 = r1 + acc[ai][bj][m][1] * scale;
                        u32x4 o; o.x = cvtpk(h0[0], h0[1]); o.y = cvtpk(h0[2], h0[3]); o.z = cvtpk(h1[0], h1[1]); o.w = cvtpk(h1[2], h1[3]);
                        *(u32x4*)(hb + off + bj * HALF) = o; }
                    asm volatile("" ::: "memory"); }
        } else {
#pragma unroll
            for (int ai = 0; ai < 2; ++ai)
#pragma unroll
                for (int m = 0; m < 4; ++m) { bf16_t* op = sb + (size_t)(row0 + ai * HALF + m * 16) * ldc + col0;
#pragma unroll
                    for (int bj = 0; bj < 2; ++bj) { const f32x4 p0 = acc[ai][bj][m][0] * scale, p1 = acc[ai][bj][m][1] * scale;
                        u32x4 o; o.x = cvtpk(p0[0], p0[1]); o.y = cvtpk(p0[2], p0[3]); o.z = cvtpk(p1[0], p1[1]); o.w = cvtpk(p1[2], p1[3]); *(u32x4*)(op + bj * HALF) = o; } }
        }
    }
};
template <bool I8IN> struct EpiPLE {
    static constexpr bool PERM = true, AFTER_DRAIN = false;
    const bf16_t* hb; float* out; const bf16_t* T; int ldc; const float* rstd; float dscale; const float* cs;
    __device__ __forceinline__ void operator()(const f32x4 (&acc)[2][2][4][2], const Unit& u, int wr, int wc, int fr, int fq) const {
        const int row0 = u.pm * BM + (u.half == 2 ? HALF : 0) + wr * 64 + fr, col0 = u.pn * BM + wc * 32 + 8 * fq;
        f32x4 csv[2][2]; float rsv[2][4];
        if constexpr (I8IN) {
#pragma unroll
            for (int bj = 0; bj < 2; ++bj) { csv[bj][0] = *(const f32x4*)(cs + col0 + bj * HALF); csv[bj][1] = *(const f32x4*)(cs + col0 + bj * HALF + 4); } }
#pragma unroll
        for (int ai = 0; ai < 2; ++ai)
#pragma unroll
            for (int m = 0; m < 4; ++m) rsv[ai][m] = rstd[row0 + ai * HALF + m * 16] * dscale;
#pragma unroll
        for (int ai = 0; ai < 2; ++ai) if (ai == 0 || u.half == 0)
#pragma unroll
            for (int m = 0; m < 4; ++m) { const size_t off = (size_t)(row0 + ai * HALF + m * 16) * ldc + col0; const float rs = rsv[ai][m];
#pragma unroll
                for (int bj = 0; bj < 2; ++bj) { const size_t o = off + bj * HALF; const u32x4 hw = *(const u32x4*)(hb + o), tw = *(const u32x4*)(T + o); f32x4 a0, a1;
                    if constexpr (I8IN) { a0 = __builtin_convertvector(__builtin_bit_cast(i32x4, acc[ai][bj][m][0]), f32x4) * (csv[bj][0] * rs);
                                          a1 = __builtin_convertvector(__builtin_bit_cast(i32x4, acc[ai][bj][m][1]), f32x4) * (csv[bj][1] * rs); }
                    else { a0 = acc[ai][bj][m][0] * rs; a1 = acc[ai][bj][m][1] * rs; }
                    const f32x4 h0 = (f32x4){__uint_as_float(hw.x << 16), __uint_as_float(hw.x & 0xffff0000u), __uint_as_float(hw.y << 16), __uint_as_float(hw.y & 0xffff0000u)};
                    const f32x4 h1 = (f32x4){__uint_as_float(hw.z << 16), __uint_as_float(hw.z & 0xffff0000u), __uint_as_float(hw.w << 16), __uint_as_float(hw.w & 0xffff0000u)};
                    const f32x4 t0 = (f32x4){__uint_as_float(tw.x << 16), __uint_as_float(tw.x & 0xffff0000u), __uint_as_float(tw.y << 16), __uint_as_float(tw.y & 0xffff0000u)};
                    const f32x4 t1 = (f32x4){__uint_as_float(tw.z << 16), __uint_as_float(tw.z & 0xffff0000u), __uint_as_float(tw.w << 16), __uint_as_float(tw.w & 0xffff0000u)};
                    const f32x4 y0 = h0 + sigmoid4(a0) * t0, y1 = h1 + sigmoid4(a1) * t1;
                    *(f32x4*)(out + o) = y0; *(f32x4*)(out + o + 4) = y1; }
                asm volatile("" ::: "memory"); }
    }
};

template <class Epi, class Sched, bool ALIGN_EPI = false, bool SP2 = false, bool F8 = false, bool MH = false, bool I8 = false>
__device__ __forceinline__ void gemm_phase(PG8_LAS unsigned char* lds, const Gemm g, const Sched& S, const Epi& E) {
    const int tid = threadIdx.x, wid = __builtin_amdgcn_readfirstlane(tid >> 6), lane = tid & 63, wr = wid >> 2, wc = wid & 3, fr = lane & 15, fq = lane >> 4;
    const int K = g.K, ntot = K / BK, ld = g.ld;
    unsigned voffA[2], voffB[2];
#pragma unroll
    for (int i = 0; i < 2; ++i) { int R, C; stage_rc(tid * 16 + i * 8192, R, C); const int Rb = Epi::PERM ? ((R & ~31) + perm32(R & 31)) : R;
        voffA[i] = (unsigned)(R * ld + C) * 2u; voffB[i] = (unsigned)(Rb * ld + C) * 2u; }
    const size_t kstep = (size_t)(BK * 2);
    const size_t hstep = (size_t)HALF * ld * 2;
    const size_t tstep = 2 * hstep;
    const unsigned ldsw = (unsigned)wid * 1024u;
    const int aoff = lds_byte(wr * 64 + fr, fq * 8), boff = lds_byte(wc * 32 + fr, fq * 8);
#define PG8_SA(b, h) (((b) * 2 + (h)) * HTB)
#define PG8_SB(b, h) ((4 + (b) * 2 + (h)) * HTB)
#define PG8_STAGE(bufoff, gbase, voff) do { _Pragma("unroll") for (int _i = 0; _i < 2; ++_i) \
        __builtin_amdgcn_global_load_lds((const unsigned*)((const char*)(gbase) + (voff)[_i]), (PG8_LAS unsigned*)(lds + (bufoff) + ldsw + _i * 8192), 16, 0, 0); } while (0)
#define PG8_RD(off) (*(const PG8_LAS bf16x8*)(lds + (off)))
#define PG8_CAT(x, y) __builtin_bit_cast(i32x8, __builtin_shufflevector((x), (y), 0, 1, 2, 3, 4, 5, 6, 7, 8, 9, 10, 11, 12, 13, 14, 15))
#define PG8_LDA(dst, b, h) do { _Pragma("unroll") for (int m = 0; m < 4; ++m) { if constexpr (F8) dst##8[m] = PG8_CAT(PG8_RD(PG8_SA(b, h) + aoff + m * 2048), PG8_RD(PG8_SA(b, h) + aoff + m * 2048 + 1024)); \
        else { _Pragma("unroll") for (int k = 0; k < 2; ++k) dst[m][k] = PG8_RD(PG8_SA(b, h) + aoff + m * 2048 + k * 1024); } } } while (0)
#define PG8_LDB(dst, b, h) do { _Pragma("unroll") for (int n = 0; n < 2; ++n) { if constexpr (F8) dst##8[n] = PG8_CAT(PG8_RD(PG8_SB(b, h) + boff + n * 2048), PG8_RD(PG8_SB(b, h) + boff + n * 2048 + 1024)); \
        else { _Pragma("unroll") for (int k = 0; k < 2; ++k) dst[n][k] = PG8_RD(PG8_SB(b, h) + boff + n * 2048 + k * 1024); } } } while (0)
#define PG8_MMA(ai, bj, At, Bt) do { __builtin_amdgcn_s_setprio(1); _Pragma("unroll") for (int m = 0; m < 4; ++m) _Pragma("unroll") for (int n = 0; n < 2; ++n) { \
        if constexpr (F8) acc[ai][bj][m][n] = __builtin_amdgcn_mfma_scale_f32_16x16x128_f8f6f4(Bt##8[n], At##8[m], acc[ai][bj][m][n], 0, 0, 0, 0, 0, 0); \
        else if constexpr (I8) { _Pragma("unroll") for (int k = 0; k < 2; ++k) acc[ai][bj][m][n] = __builtin_bit_cast(f32x4, __builtin_amdgcn_mfma_i32_16x16x64_i8(__builtin_bit_cast(i32x4, Bt[n][k]), __builtin_bit_cast(i32x4, At[m][k]), __builtin_bit_cast(i32x4, acc[ai][bj][m][n]), 0, 0, 0)); } \
        else { _Pragma("unroll") for (int k = 0; k < 2; ++k) acc[ai][bj][m][n] = __builtin_amdgcn_mfma_f32_16x16x32_bf16(Bt[n][k], At[m][k], acc[ai][bj][m][n], 0, 0, 0); } } \
        __builtin_amdgcn_s_setprio(0); } while (0)
#define PG8_WAIT_V(n) asm volatile("s_waitcnt vmcnt(" #n ")" ::: "memory")
#define PG8_WAIT_L(n) asm volatile("s_waitcnt lgkmcnt(" #n ")" ::: "memory")
#define PG8_BAR __builtin_amdgcn_s_barrier()
#define PG8_SCHED __builtin_amdgcn_sched_barrier(0)
    Unit cur, nxt; int ui = 0;
    if (!S.next(0, cur)) return;
    f32x4 acc[2][2][4][2];
#pragma unroll
    for (int a = 0; a < 2; ++a)
#pragma unroll
        for (int b = 0; b < 2; ++b)
#pragma unroll
            for (int m = 0; m < 4; ++m)
#pragma unroll
                for (int n = 0; n < 2; ++n) acc[a][b][m][n] = (f32x4){0.f, 0.f, 0.f, 0.f};
    bf16x8 At[4][2], B0[2][2], B1[2][2]; i32x8 At8[4], B08[2], B18[2];
    const char* cA = (const char*)g.A + (size_t)cur.pm * tstep + (cur.kh ? (size_t)g.ksplit * (BK * 2) : (size_t)0) + (cur.half == 2 ? hstep : (size_t)0); const char* cB = (const char*)g.Bt + (size_t)cur.pn * tstep + (cur.kh ? (size_t)g.ksplit * (BK * 2) : (size_t)0);
    S.a_ready(cur);
    if constexpr (SP2) {
        PG8_STAGE(PG8_SB(0, 0), cB, voffB); PG8_STAGE(PG8_SB(0, 1), cB + hstep, voffB); PG8_STAGE(PG8_SA(0, 0), cA, voffA); PG8_STAGE(PG8_SA(0, 1), cA + hstep, voffA);
        if (wr == 1) PG8_BAR;
        PG8_WAIT_V(2); PG8_BAR;
        PG8_STAGE(PG8_SB(1, 0), cB + kstep, voffB); PG8_STAGE(PG8_SA(1, 0), cA + kstep, voffA); PG8_STAGE(PG8_SB(1, 1), cB + hstep + kstep, voffB);
        PG8_WAIT_V(6); PG8_BAR;
    } else {
        PG8_STAGE(PG8_SB(0, 0), cB, voffB); PG8_STAGE(PG8_SA(0, 0), cA, voffA); PG8_STAGE(PG8_SB(0, 1), cB + hstep, voffB); PG8_STAGE(PG8_SA(0, 1), cA + hstep, voffA);
        if (wr == 1) PG8_BAR;
        PG8_WAIT_V(4); PG8_BAR;
        PG8_STAGE(PG8_SB(1, 0), cB + kstep, voffB); PG8_STAGE(PG8_SA(1, 0), cA + kstep, voffA); PG8_STAGE(PG8_SB(1, 1), cB + hstep + kstep, voffB);
        PG8_WAIT_V(6); PG8_BAR;
    }
    for (;;) {
        const bool has_next = S.next(ui + 1, nxt); const int nt = g.ksplit ? (cur.kh ? ntot - g.ksplit : g.ksplit) : ntot; const bool mhalf = MH || cur.half != 0;
        const char* nA = has_next ? (const char*)g.A + (size_t)nxt.pm * tstep + (nxt.kh ? (size_t)g.ksplit * (BK * 2) : (size_t)0) + (nxt.half == 2 ? hstep : (size_t)0) : cA; const char* nB = has_next ? (const char*)g.Bt + (size_t)nxt.pn * tstep + (nxt.kh ? (size_t)g.ksplit * (BK * 2) : (size_t)0) : cB;
        for (int t = 0; t < nt; t += 2) {
            const bool last = (t == nt - 2);
            const char* a1 = cA + (size_t)(t + 1) * kstep;
            const char* a2 = last ? nA : cA + (size_t)(t + 2) * kstep; const char* b2 = last ? nB : cB + (size_t)(t + 2) * kstep;
            const char* a3 = a2 + kstep; const char* b3 = b2 + kstep;
            if (last && has_next) S.a_ready(nxt);
            if constexpr (SP2) {
            PG8_LDB(B0, 0, 0); PG8_LDB(B1, 0, 1); PG8_SCHED; PG8_LDA(At, 0, 0); PG8_STAGE(PG8_SA(1, 1), a1 + hstep, voffA);
            PG8_WAIT_V(8); PG8_WAIT_L(0); PG8_BAR; PG8_MMA(0, 0, At, B0); PG8_MMA(0, 1, At, B1); PG8_BAR; PG8_SCHED;
            if constexpr (!MH) PG8_LDA(At, 0, 1); PG8_STAGE(PG8_SB(0, 0), b2, voffB); PG8_STAGE(PG8_SB(0, 1), b2 + hstep, voffB); PG8_STAGE(PG8_SA(0, 0), a2, voffA);
            PG8_WAIT_V(8); PG8_WAIT_L(0); PG8_BAR; if constexpr (!MH) { if (!mhalf) { PG8_MMA(1, 0, At, B0); PG8_MMA(1, 1, At, B1); } } PG8_BAR; PG8_SCHED;
            PG8_LDB(B0, 1, 0); PG8_LDB(B1, 1, 1); PG8_SCHED; PG8_LDA(At, 1, 0); PG8_STAGE(PG8_SA(0, 1), a2 + hstep, voffA);
            PG8_WAIT_V(8); PG8_WAIT_L(0); PG8_BAR; PG8_MMA(0, 0, At, B0); PG8_MMA(0, 1, At, B1); PG8_BAR; PG8_SCHED;
            if constexpr (!MH) PG8_LDA(At, 1, 1); PG8_STAGE(PG8_SB(1, 0), b3, voffB); PG8_STAGE(PG8_SB(1, 1), b3 + hstep, voffB); PG8_STAGE(PG8_SA(1, 0), a3, voffA);
            PG8_WAIT_V(8); PG8_WAIT_L(0); PG8_BAR; if constexpr (!MH) { if (!mhalf) { PG8_MMA(1, 0, At, B0); PG8_MMA(1, 1, At, B1); } } PG8_BAR; PG8_SCHED;
            } else {
            PG8_LDB(B0, 0, 0); PG8_SCHED; PG8_LDA(At, 0, 0); PG8_STAGE(PG8_SA(1, 1), a1 + hstep, voffA);
            PG8_WAIT_L(8); PG8_BAR; PG8_WAIT_L(0); PG8_MMA(0, 0, At, B0); PG8_BAR; PG8_SCHED;
            PG8_LDB(B1, 0, 1); PG8_STAGE(PG8_SB(0, 0), b2, voffB);
            PG8_BAR; PG8_WAIT_L(0); PG8_MMA(0, 1, At, B1); PG8_BAR;
            PG8_LDA(At, 0, 1); PG8_STAGE(PG8_SA(0, 0), a2, voffA);
            PG8_BAR; PG8_WAIT_L(0); PG8_MMA(1, 0, At, B0); PG8_BAR; PG8_SCHED;
            PG8_STAGE(PG8_SB(0, 1), b2 + hstep, voffB);
            PG8_WAIT_V(6); PG8_BAR; PG8_MMA(1, 1, At, B1); PG8_BAR;
            PG8_LDB(B0, 1, 0); PG8_SCHED; PG8_LDA(At, 1, 0); PG8_STAGE(PG8_SA(0, 1), a2 + hstep, voffA);
            PG8_WAIT_L(8); PG8_BAR; PG8_WAIT_L(0); PG8_MMA(0, 0, At, B0); PG8_BAR; PG8_SCHED;
            PG8_LDB(B1, 1, 1); PG8_STAGE(PG8_SB(1, 0), b3, voffB);
            PG8_BAR; PG8_WAIT_L(0); PG8_MMA(0, 1, At, B1); PG8_BAR;
            PG8_LDA(At, 1, 1); PG8_STAGE(PG8_SA(1, 0), a3, voffA);
            PG8_BAR; PG8_WAIT_L(0); PG8_MMA(1, 0, At, B0); PG8_BAR; PG8_SCHED;
            PG8_STAGE(PG8_SB(1, 1), b3 + hstep, voffB);
            PG8_WAIT_V(6); PG8_BAR; PG8_MMA(1, 1, At, B1); PG8_BAR;
            }
        }
        if constexpr (ALIGN_EPI) { if (wr == 0) PG8_BAR; }
        if constexpr (!Epi::AFTER_DRAIN) { E(acc, cur, wr, wc, fr, fq); S.done(cur); }
        if (!has_next) break;
#pragma unroll
        for (int a = 0; a < 2; ++a)
#pragma unroll
            for (int b = 0; b < 2; ++b)
#pragma unroll
                for (int m = 0; m < 4; ++m)
#pragma unroll
                    for (int n = 0; n < 2; ++n) acc[a][b][m][n] = (f32x4){0.f, 0.f, 0.f, 0.f};
        cur = nxt; cA = nA; cB = nB; ++ui;
        if constexpr (ALIGN_EPI) { if (wr == 1) PG8_BAR; }
    }
    PG8_WAIT_V(0);
    if constexpr (!ALIGN_EPI) { if (wr == 0) PG8_BAR; }
    PG8_BAR;
    if constexpr (Epi::AFTER_DRAIN) { E.fused(acc, cur, wr, wc, fr, fq, lds, wid, lane); S.done(cur); }
#undef PG8_SA
#undef PG8_SB
#undef PG8_STAGE
#undef PG8_RD
#undef PG8_CAT
#undef PG8_LDA
#undef PG8_LDB
#undef PG8_MMA
#undef PG8_WAIT_V
#undef PG8_WAIT_L
#undef PG8_BAR
#undef PG8_SCHED
}

template <class Epi, class Sched>
__device__ __forceinline__ void gemm_phase_f8mh(PG8_LAS unsigned char* lds, const Gemm g, const Sched& S, const Epi& E) {
    const int tid = threadIdx.x, wid = __builtin_amdgcn_readfirstlane(tid >> 6), lane = tid & 63, wr = wid >> 2, wc = wid & 3, fr = lane & 15, fq = lane >> 4;
    const int nt = g.K / BK, ld = g.ld;
    unsigned voffA[2], voffB[2];
#pragma unroll
    for (int i = 0; i < 2; ++i) { int R, C; stage_rc(tid * 16 + i * 8192, R, C); const int Rb = Epi::PERM ? ((R & ~31) + perm32(R & 31)) : R;
        voffA[i] = (unsigned)(R * ld + C) * 2u; voffB[i] = (unsigned)(Rb * ld + C) * 2u; }
    const size_t kstep = (size_t)(BK * 2), hstep = (size_t)HALF * ld * 2, tstep = 2 * hstep;
    const unsigned ldsw = (unsigned)wid * 1024u;
    const int aoff = lds_byte(wr * 64 + fr, fq * 8), boff = lds_byte(wc * 32 + fr, fq * 8);
    constexpr unsigned SLOT = 3u * HTB;
#define F8_STAGE1(dstoff, gptr, voff) do { _Pragma("unroll") for (int _i = 0; _i < 2; ++_i) \
        __builtin_amdgcn_global_load_lds((const unsigned*)((const char*)(gptr) + (voff)[_i]), (PG8_LAS unsigned*)(lds + (dstoff) + ldsw + _i * 8192), 16, 0, 0); } while (0)
#define F8_STAGE3(so, gA, gB) do { F8_STAGE1((so), (gB), voffB); F8_STAGE1((so) + HTB, (gB) + hstep, voffB); F8_STAGE1((so) + 2 * HTB, (gA), voffA); } while (0)
#define F8_RD(off) (*(const PG8_LAS bf16x8*)(lds + (off)))
#define F8_CAT(x, y) __builtin_bit_cast(i32x8, __builtin_shufflevector((x), (y), 0, 1, 2, 3, 4, 5, 6, 7, 8, 9, 10, 11, 12, 13, 14, 15))
    Unit cur, nxt; int ui = 0;
    if (!S.next(0, cur)) return;
    f32x4 acc[2][2][4][2];
#pragma unroll
    for (int b = 0; b < 2; ++b)
#pragma unroll
        for (int m = 0; m < 4; ++m)
#pragma unroll
            for (int n = 0; n < 2; ++n) acc[0][b][m][n] = (f32x4){0.f, 0.f, 0.f, 0.f};
    const char* cA = (const char*)g.A + (size_t)cur.pm * tstep + (cur.half == 2 ? hstep : (size_t)0); const char* cB = (const char*)g.Bt + (size_t)cur.pn * tstep;
    F8_STAGE3(0u, cA, cB);
    if (wr == 1) __builtin_amdgcn_s_barrier();
    asm volatile("s_waitcnt vmcnt(0)" ::: "memory"); __builtin_amdgcn_s_barrier();
    F8_STAGE3(SLOT, cA + kstep, cB + kstep);
    __builtin_amdgcn_s_barrier();
    unsigned so = 0u;
    for (;;) {
        const bool has_next = S.next(ui + 1, nxt);
        const char* nA = has_next ? (const char*)g.A + (size_t)nxt.pm * tstep + (nxt.half == 2 ? hstep : (size_t)0) : cA; const char* nB = has_next ? (const char*)g.Bt + (size_t)nxt.pn * tstep : cB;
        for (int t = 0; t < nt; ++t) {
            const bool wrap = (t + 2 >= nt); const size_t k2 = (size_t)(wrap ? t + 2 - nt : t + 2) * kstep;
            const char* a2 = (wrap ? nA : cA) + k2; const char* b2 = (wrap ? nB : cB) + k2;
            const unsigned so2 = (so >= SLOT) ? so - SLOT : so + 2u * SLOT;
            i32x8 B08[2], B18[2], At8[4];
#pragma unroll
            for (int n = 0; n < 2; ++n) { B08[n] = F8_CAT(F8_RD(so + boff + n * 2048), F8_RD(so + boff + n * 2048 + 1024)); B18[n] = F8_CAT(F8_RD(so + HTB + boff + n * 2048), F8_RD(so + HTB + boff + n * 2048 + 1024)); }
            __builtin_amdgcn_sched_barrier(0);
#pragma unroll
            for (int m = 0; m < 4; ++m) At8[m] = F8_CAT(F8_RD(so + 2 * HTB + aoff + m * 2048), F8_RD(so + 2 * HTB + aoff + m * 2048 + 1024));
            F8_STAGE3(so2, a2, b2);
            asm volatile("s_waitcnt vmcnt(6)" ::: "memory"); asm volatile("s_waitcnt lgkmcnt(0)" ::: "memory"); __builtin_amdgcn_s_barrier();
            __builtin_amdgcn_s_setprio(1);
#pragma unroll
            for (int m = 0; m < 4; ++m)
#pragma unroll
                for (int n = 0; n < 2; ++n) { acc[0][0][m][n] = __builtin_amdgcn_mfma_scale_f32_16x16x128_f8f6f4(B08[n], At8[m], acc[0][0][m][n], 0, 0, 0, 0, 0, 0);
                    acc[0][1][m][n] = __builtin_amdgcn_mfma_scale_f32_16x16x128_f8f6f4(B18[n], At8[m], acc[0][1][m][n], 0, 0, 0, 0, 0, 0); }
            __builtin_amdgcn_s_setprio(0);
            __builtin_amdgcn_s_barrier(); __builtin_amdgcn_sched_barrier(0);
            so = (so >= 2u * SLOT) ? 0u : so + SLOT;
        }
        E(acc, cur, wr, wc, fr, fq);
        if (!has_next) break;
#pragma unroll
        for (int b = 0; b < 2; ++b)
#pragma unroll
            for (int m = 0; m < 4; ++m)
#pragma unroll
                for (int n = 0; n < 2; ++n) acc[0][b][m][n] = (f32x4){0.f, 0.f, 0.f, 0.f};
        cur = nxt; cA = nA; cB = nB; ++ui;
    }
    asm volatile("s_waitcnt vmcnt(0)" ::: "memory");
    if (wr == 0) __builtin_amdgcn_s_barrier();
    __builtin_amdgcn_s_barrier();
#undef F8_STAGE1
#undef F8_STAGE3
#undef F8_RD
#undef F8_CAT
}
}

constexpr int NWAVES = 8;
#ifndef MK_ONE_LAUNCH
#define MK_ONE_LAUNCH 1
#endif
constexpr int N_PHASES = 14;

constexpr int D = 4096, DFF = 11008, NTOK = 10240, NPR = 8192, SEQ = 4096, INW = 8704, PLE = 256;
constexpr int C_QA = 0, C_KA = 2048, C_VA = 2304, C_QR = 2560, C_KR = 3584, C_VR = 4608, C_GR = 6656;
constexpr int NPOS = 4160;
constexpr float EPS = 1e-6f;
constexpr size_t O_Y = 0, O_KP = 41943040, O_VP = 42008576, O_SP = 42074112, O_KS = 42598400, O_VS = 43646976, O_SS = 44695552, O_END = 53084160;

constexpr size_t MiB = 1u << 20;
constexpr size_t WS_CTL = 0, CTL_ZERO_BYTES = 1 * MiB;
constexpr size_t WS_ROPE = 2 * MiB;
constexpr size_t WS_PB = 6 * MiB;
constexpr size_t WS_CS = 14 * MiB;
constexpr size_t WS_RSTD = 12 * MiB;
constexpr size_t WS_W1GU = 16 * MiB, WS_W1D = 188 * MiB, WS_WIN = 274 * MiB, WS_WOUT = 342 * MiB, WS_W2GU = 374 * MiB, WS_W2D = 546 * MiB, WS_WPG = 632 * MiB, WS_WPP = 664 * MiB;
constexpr size_t WS_ZN = 666 * MiB;
constexpr size_t WS_HID = 746 * MiB;
constexpr size_t WS_MIX = 961 * MiB;
constexpr size_t WS_TP = 1041 * MiB;
constexpr size_t WS_RS = 1121 * MiB;
constexpr size_t WS_STB = 1249 * MiB;
constexpr size_t WS_SB = 1313 * MiB;
constexpr size_t WS_HB = 1345 * MiB;
constexpr size_t WS_END = 1425 * MiB;
static_assert(WS_W1GU + (size_t)2 * DFF * D * 2 == WS_W1D && WS_W1D + (size_t)D * DFF * 2 == WS_WIN && WS_WIN + (size_t)INW * D * 2 == WS_WOUT && WS_WOUT + (size_t)D * D * 2 == WS_W2GU, "ws map 1");
static_assert(WS_W2GU + (size_t)2 * DFF * D * 2 == WS_W2D && WS_W2D + (size_t)D * DFF * 2 == WS_WPG && WS_WPG + (size_t)D * D * 2 == WS_WPP && WS_WPP + (size_t)D * PLE * 2 == WS_ZN, "ws map 2");
static_assert(WS_ZN + (size_t)NTOK * D * 2 == WS_HID && WS_HID + (size_t)NTOK * DFF * 2 == WS_MIX && WS_MIX + (size_t)NTOK * D * 2 == WS_TP && WS_TP + (size_t)NTOK * D * 2 == WS_RS, "ws map 3");
static_assert(WS_RS + (size_t)1024 * 32768 * 4 == WS_STB && WS_STB + (size_t)1024 * 32768 * 2 == WS_SB && WS_SB + (size_t)(NTOK - NPR) * D * 4 == WS_HB && WS_HB + (size_t)NTOK * D * 2 == WS_END && WS_ROPE + (size_t)NPOS * 64 * 8 <= WS_PB && WS_PB + (size_t)NTOK * PLE * 2 <= WS_RSTD && WS_RSTD + (size_t)NTOK * 4 <= WS_W1GU, "ws map 4");
constexpr int CW_BAR = 4096;
constexpr int CW_CM = 32768;

constexpr int RING_OFF = 0, RING_BYTES = 147456;
constexpr int LDSCTL_OFF = RING_BYTES, MISC_OFF = LDSCTL_OFF + 320;
constexpr int LDS_BYTES = 148480;
static_assert(MISC_OFF + 128 <= LDS_BYTES, "LDS map");

#define GAS __attribute__((address_space(1)))
#define LAS __attribute__((address_space(3)))
typedef unsigned short bf16;
typedef unsigned v4u __attribute__((ext_vector_type(4)));
typedef float f32x4 __attribute__((ext_vector_type(4)));
typedef short bf16x8 __attribute__((ext_vector_type(8)));
typedef GAS unsigned gu32;
typedef GAS unsigned long long gu64;
#define RLX_AGENT __ATOMIC_RELAXED, __HIP_MEMORY_SCOPE_AGENT
#define LDS_WAIT() asm volatile("s_waitcnt lgkmcnt(0)" ::: "memory")
#define VM_WAIT() asm volatile("s_waitcnt vmcnt(0)" ::: "memory")
__device__ __forceinline__ unsigned long long rt() { return __builtin_amdgcn_s_memrealtime(); }
__device__ __forceinline__ unsigned f2bf(float f) { unsigned u = __builtin_bit_cast(unsigned, f); return (u + 0x7fffu + ((u >> 16) & 1u)) >> 16; }
__device__ __forceinline__ unsigned pk2(float lo, float hi) { return f2bf(lo) | (f2bf(hi) << 16); }

#define XB_TMO      128
#define XB_XCNT(j)  (256  + 64 * (j))
#define XB_XSUB(j)  (1280 + 64 * (j))
#define XB_XGEN(j)  (2304 + 64 * (j))
#define XB_TOP      3328
#define XB_TOPGEN   3392
#define XCD_BAR_WORDS 3456
#define XB_SPIN_CAP (1u << 18)

__device__ __forceinline__ unsigned xb_ld(unsigned* p)              { return __hip_atomic_load(p, __ATOMIC_RELAXED, __HIP_MEMORY_SCOPE_AGENT); }
__device__ __forceinline__ unsigned xb_add(unsigned* p, unsigned v) { return __hip_atomic_fetch_add(p, v, __ATOMIC_RELAXED, __HIP_MEMORY_SCOPE_AGENT); }
__device__ __forceinline__ unsigned xb_xcc_id() { return (unsigned)__builtin_amdgcn_s_getreg((3 << 11) | 20) & 0xFu; }
#define XB_SPIN(cond, bar) do { unsigned _sp = 0; while (cond) { __builtin_amdgcn_s_sleep(1); \
    if ((++_sp & 255u) == 0u) { if (xb_ld(&(bar)[XB_TMO])) break; if (_sp > XB_SPIN_CAP) { atomicAdd(&(bar)[XB_TMO], 1u); break; } } } } while (0)

struct XcdBarrier {
    unsigned* bar; unsigned x;
    volatile LAS unsigned* st;
};

__device__ __forceinline__ XcdBarrier xcd_barrier_post(unsigned* bar, volatile LAS unsigned* st) {
    XcdBarrier b; b.bar = bar; b.x = xb_xcc_id(); b.st = st;
    if (threadIdx.x == 0) (void)xb_add(&bar[XB_XCNT(b.x)], 1u);
    return b;
}
__device__ __forceinline__ void xcd_barrier_complete(unsigned* bar, unsigned x, unsigned& nloc, unsigned& nx) {
    const unsigned G = gridDim.x * gridDim.y * gridDim.z;
    unsigned sum, cnt, mine, sp = 0u;
    for (;;) {
        sum = 0u; cnt = 0u; mine = 0u;
#pragma unroll
        for (unsigned j = 0; j < 16; ++j) { const unsigned c = xb_ld(&bar[XB_XCNT(j)]); sum += c; cnt += (c > 0u) ? 1u : 0u; mine = (j == x) ? c : mine; }
        if (sum == G) break;
        __builtin_amdgcn_s_sleep(1);
        if ((++sp & 255u) == 0u) { if (xb_ld(&bar[XB_TMO])) break; if (sp > XB_SPIN_CAP) { atomicAdd(&bar[XB_TMO], 1u); break; } }
    }
    nloc = mine > 0u ? mine : 1u; nx = cnt > 0u ? cnt : 1u;
}

__device__ __forceinline__ void xcd_barrier(const XcdBarrier& b) {
    asm volatile("s_waitcnt vmcnt(0)" ::: "memory");
    __syncthreads();
    if (threadIdx.x == 0) {
        unsigned* bar = b.bar;
        __builtin_amdgcn_s_waitcnt(0);
        unsigned nloc = b.st[0], nx = b.st[1];
        if (nloc == 0u) { xcd_barrier_complete(bar, b.x, nloc, nx); b.st[0] = nloc; b.st[1] = nx; }
        const unsigned old = xb_add(&bar[XB_XSUB(b.x)], 1u);
        const unsigned gen = old / nloc;
        if (old + 1u == (gen + 1u) * nloc) {
            __builtin_amdgcn_fence(__ATOMIC_RELEASE, "agent");
            asm volatile("s_waitcnt vmcnt(0)" ::: "memory");
            const unsigned og = xb_add(&bar[XB_TOP], 1u);
            const unsigned tg = og / nx;
            if (og + 1u == (tg + 1u) * nx) xb_add(&bar[XB_TOPGEN], 1u);
            else XB_SPIN(xb_ld(&bar[XB_TOPGEN]) == tg, bar);
            __builtin_amdgcn_fence(__ATOMIC_ACQUIRE, "agent");
            xb_add(&bar[XB_XGEN(b.x)], 1u);
            asm volatile("s_waitcnt vmcnt(0)" ::: "memory");
        } else {
            XB_SPIN(xb_ld(&bar[XB_XGEN(b.x)]) == gen, bar);
            __builtin_amdgcn_fence(__ATOMIC_ACQUIRE, "agent");
            asm volatile("s_waitcnt vmcnt(0)" ::: "memory");
        }
    }
    __syncthreads();
}


typedef float f32x16 __attribute__((ext_vector_type(16)));
typedef float f32x2 __attribute__((ext_vector_type(2)));
typedef short s16x4 __attribute__((ext_vector_type(4)));
typedef unsigned v2u __attribute__((ext_vector_type(2)));
#define MFMA32(a, b, c) __builtin_amdgcn_mfma_f32_32x32x16_bf16((a), (b), (c), 0, 0, 0)
#define MFMA16(a, b, c) __builtin_amdgcn_mfma_f32_16x16x32_bf16((a), (b), (c), 0, 0, 0)
using pg8::cvtpk;
using pg8::silu_f;

struct Args { const float* in[25]; float* out; unsigned char* ws; int ph_lo, ph_hi; };
struct Frame {
    LAS unsigned char* lds;
    volatile LAS unsigned* MISC;
    gu32* ctl;
    int tid, lane, wave;
    int vcu, G;
};
#define A_x_p      (A.in[0])
#define A_x_s      (A.in[1])
#define A_cache_k  (A.in[2])
#define A_cache_v  (A.in[3])
#define A_state_in (A.in[4])
#define A_p_p      (A.in[5])
#define A_p_s      (A.in[6])
#define A_g_ffn1   (A.in[7])
#define A_w1g      (A.in[8])
#define A_w1u      (A.in[9])
#define A_w1d      (A.in[10])
#define A_g_mix    (A.in[11])
#define A_w_in     (A.in[12])
#define A_g_q      (A.in[13])
#define A_g_k      (A.in[14])
#define A_sinks    (A.in[15])
#define A_g_ret    (A.in[16])
#define A_w_out    (A.in[17])
#define A_g_ffn2   (A.in[18])
#define A_w2g      (A.in[19])
#define A_w2u      (A.in[20])
#define A_w2d      (A.in[21])
#define A_g_ple    (A.in[22])
#define A_w_pg     (A.in[23])
#define A_w_pp     (A.in[24])
#define A_out      (A.out)
#define A_W1GU ((bf16*)(A.ws + WS_W1GU))
#define A_W1D  ((bf16*)(A.ws + WS_W1D))
#define A_WIN  ((bf16*)(A.ws + WS_WIN))
#define A_WOUT ((bf16*)(A.ws + WS_WOUT))
#define A_W2GU ((bf16*)(A.ws + WS_W2GU))
#define A_W2D  ((bf16*)(A.ws + WS_W2D))
#define A_WPG  ((bf16*)(A.ws + WS_WPG))
#define A_WPP  ((bf16*)(A.ws + WS_WPP))
#define A_ZN   ((bf16*)(A.ws + WS_ZN))
#define A_HID  ((bf16*)(A.ws + WS_HID))
#define A_U    ((bf16*)(A.ws + WS_HID))
#define A_MIX  ((bf16*)(A.ws + WS_MIX))
#define A_TP   ((bf16*)(A.ws + WS_TP))
#define A_PB   ((bf16*)(A.ws + WS_PB))
#define A_STB  ((bf16*)(A.ws + WS_STB))
#define A_RS   ((bf16*)(A.ws + WS_RS))
#define A_ROPE ((f32x2*)(A.ws + WS_ROPE))
#define A_SB   ((bf16*)(A.ws + WS_SB))
#define A_HB   ((bf16*)(A.ws + WS_HB))
#define A_RSTD ((float*)(A.ws + WS_RSTD))
#define A_CM2G ((unsigned*)(A.ws + WS_CTL) + CW_CM)
#define A_CM2U ((unsigned*)(A.ws + WS_CTL) + CW_CM + 11264)
#define A_CMPG ((unsigned*)(A.ws + WS_CTL) + CW_CM + 22528)
#define A_CM1G ((unsigned*)(A.ws + WS_CTL) + CW_CM + 26624)
#define A_CM1U ((unsigned*)(A.ws + WS_CTL) + CW_CM + 26624 + 11264)
#define A_CS1G ((float*)(A.ws + WS_CS) + 26624)
#define A_CS1U ((float*)(A.ws + WS_CS) + 26624 + 11264)
#define A_CSPG ((float*)(A.ws + WS_CS) + 22528)
#define A_CS2G ((float*)(A.ws + WS_CS))
#define A_CS2U ((float*)(A.ws + WS_CS) + 11264)
#define A_WINB ((bf16*)(A.ws + WS_WIN))
#define A_WINQ ((unsigned char*)(A.ws + WS_WIN + (size_t)3584 * D * 2))
#define A_CMWIN ((unsigned*)(A.ws + WS_CTL) + CW_CM + 49152)
#define A_CSWIN ((float*)(A.ws + WS_CS) + 49152)
#define A_RSTDQ ((float*)(A.ws + WS_RSTD) + 16384)

__device__ __forceinline__ float wave_sum(float v) {
#pragma unroll
    for (int o = 1; o < 64; o <<= 1) v += __shfl_xor(v, o);
    return v;
}
__device__ __forceinline__ void unpack8(const v4u w, float (&f)[8]) {
    f[0] = __uint_as_float(w.x << 16); f[1] = __uint_as_float(w.x & 0xffff0000u); f[2] = __uint_as_float(w.y << 16); f[3] = __uint_as_float(w.y & 0xffff0000u);
    f[4] = __uint_as_float(w.z << 16); f[5] = __uint_as_float(w.z & 0xffff0000u); f[6] = __uint_as_float(w.w << 16); f[7] = __uint_as_float(w.w & 0xffff0000u);
}
__device__ __forceinline__ v4u pack8(const float (&f)[8]) { v4u w; w.x = cvtpk(f[0], f[1]); w.y = cvtpk(f[2], f[3]); w.z = cvtpk(f[4], f[5]); w.w = cvtpk(f[6], f[7]); return w; }
__device__ __forceinline__ unsigned short bf1(float f) { return (unsigned short)(cvtpk(f, 0.f) & 0xffffu); }
__device__ __forceinline__ unsigned pack4_i8(float a, float b, float c, float d) {
    const int ia = (int)rintf(fminf(fmaxf(a, -127.f), 127.f)), ib = (int)rintf(fminf(fmaxf(b, -127.f), 127.f)), ic = (int)rintf(fminf(fmaxf(c, -127.f), 127.f)), id = (int)rintf(fminf(fmaxf(d, -127.f), 127.f));
    return (unsigned)(ia & 0xff) | ((unsigned)(ib & 0xff) << 8) | ((unsigned)(ic & 0xff) << 16) | ((unsigned)id << 24); }
__device__ __forceinline__ float log2_gamma(int h) {
    float r = -0.04580368961312479f;
    r = (h == 1) ? -0.02272007650008353f : r; r = (h == 2) ? -0.011315313227834146f : r; r = (h == 3) ? -0.005646563141142063f : r;
    r = (h == 4) ? -0.0028205190623786626f : r; r = (h == 5) ? -0.0014095702546713536f : r; r = (h == 6) ? -0.0007046129765893727f : r; r = (h == 7) ? -0.0003522634716290214f : r;
    return r;
}

constexpr int CVT_TP = 72, CVT_TBYTES = 64 * CVT_TP * 2;
__device__ __forceinline__ void cvt_load(const float* W, int N, int item, int lane, f32x4 (&v)[16], const float* g, int ldw = 0) {
    const int nn = N >> 6, kb = item / nn, nb = item - kb * nn, k0 = kb * 64, n0 = nb * 64; if (ldw == 0) ldw = N;
    const GAS f32x4* src = (const GAS f32x4*)(W + (size_t)(k0 + (lane >> 4) * 16) * ldw + n0 + 4 * (lane & 15));
    const size_t rs = (size_t)(ldw >> 2);
#pragma unroll
    for (int j = 0; j < 16; ++j) v[j] = src[(size_t)j * rs];
    if (g) { const GAS f32x4* gp = (const GAS f32x4*)(g + k0 + (lane >> 4) * 16);
#pragma unroll
        for (int j4 = 0; j4 < 4; ++j4) { const f32x4 gv = gp[j4]; v[4 * j4] = v[4 * j4] * gv[0]; v[4 * j4 + 1] = v[4 * j4 + 1] * gv[1]; v[4 * j4 + 2] = v[4 * j4 + 2] * gv[2]; v[4 * j4 + 3] = v[4 * j4 + 3] * gv[3]; } }
}
__device__ __forceinline__ void cvt_store(int K, int N, bf16* WT, int mode, int item, int lane, const f32x4 (&v)[16], LAS bf16* T) {
    const int nn = N >> 6, kb = item / nn, nb = item - kb * nn, k0 = kb * 64, n0 = nb * 64;
    const int kk = lane >> 4, c = lane & 15;
#pragma unroll
    for (int i = 0; i < 4; ++i) {
        v4u o0, o1;
        o0.x = cvtpk(v[0][i], v[1][i]); o0.y = cvtpk(v[2][i], v[3][i]); o0.z = cvtpk(v[4][i], v[5][i]); o0.w = cvtpk(v[6][i], v[7][i]);
        o1.x = cvtpk(v[8][i], v[9][i]); o1.y = cvtpk(v[10][i], v[11][i]); o1.z = cvtpk(v[12][i], v[13][i]); o1.w = cvtpk(v[14][i], v[15][i]);
        LAS bf16* t = T + (4 * c + i) * CVT_TP + 16 * kk;
        *(LAS v4u*)t = o0; *(LAS v4u*)(t + 8) = o1;
    }
    const int r8 = lane >> 3, p = lane & 7;
#pragma unroll
    for (int q = 0; q < 8; ++q) { const int n = 8 * q + r8, nabs = n0 + n;
        const v4u val = *(const LAS v4u*)(T + n * CVT_TP + 8 * p);
        const int drow = (mode == 0) ? nabs : ((nabs >> 7) * 256 + (nabs & 127) + (mode == 2 ? 128 : 0));
        *(GAS v4u*)(WT + (size_t)drow * K + k0 + 8 * p) = val; }
}
constexpr int CVT_TP8 = 80;
__device__ __forceinline__ void cvt_store_f8(int K, int N, unsigned char* WT, int item, int lane, const f32x4 (&v)[16], LAS unsigned char* T) {
    const int nn = N >> 6, kb = item / nn, nb = item - kb * nn, k0 = kb * 64, n0 = nb * 64;
    const int kk = lane >> 4, c = lane & 15; constexpr float S = pg8::F8_WSCALE;
#pragma unroll
    for (int i = 0; i < 4; ++i) { v4u o;
        o.x = pg8::cvt4_fp8(v[0][i] * S, v[1][i] * S, v[2][i] * S, v[3][i] * S); o.y = pg8::cvt4_fp8(v[4][i] * S, v[5][i] * S, v[6][i] * S, v[7][i] * S);
        o.z = pg8::cvt4_fp8(v[8][i] * S, v[9][i] * S, v[10][i] * S, v[11][i] * S); o.w = pg8::cvt4_fp8(v[12][i] * S, v[13][i] * S, v[14][i] * S, v[15][i] * S);
        *(LAS v4u*)(T + (4 * c + i) * CVT_TP8 + 16 * kk) = o; }
    const int r16 = lane >> 2, p = lane & 3;
#pragma unroll
    for (int q = 0; q < 4; ++q) { const int n = 16 * q + r16; const v4u val = *(const LAS v4u*)(T + n * CVT_TP8 + 16 * p);
        *(GAS v4u*)(WT + (size_t)(n0 + n) * K + k0 + 16 * p) = val; }
}
__device__ __forceinline__ void cvt_matrix_f8(const Frame& F, const float* W, int K, int N, unsigned char* WT, int gw, int NGW, const float* g = nullptr) {
    const int nitems = (K >> 6) * (N >> 6); LAS unsigned char* T = (LAS unsigned char*)(F.lds + RING_OFF + F.wave * CVT_TBYTES);
    for (int it = gw; it < nitems; it += 2 * NGW) { f32x4 v0[16], v1[16]; const bool two = it + NGW < nitems;
        cvt_load(W, N, it, F.lane, v0, g); if (two) cvt_load(W, N, it + NGW, F.lane, v1, g);
        cvt_store_f8(K, N, WT, it, F.lane, v0, T); if (two) cvt_store_f8(K, N, WT, it + NGW, F.lane, v1, T); }
}
__device__ __forceinline__ void colmax_matrix(const Frame& F, const float* W, int K, int N, unsigned* cm, int gw, int NGW, const float* g, int ldw = 0) {
    const int nitems = (K >> 6) * (N >> 6);
    for (int it = gw; it < nitems; it += NGW) { f32x4 v[16]; cvt_load(W, N, it, F.lane, v, g, ldw);
        const int nn = N >> 6, kb = it / nn, nb = it - kb * nn, n0 = nb * 64; f32x4 mx = (f32x4){0.f, 0.f, 0.f, 0.f};
#pragma unroll
        for (int j = 0; j < 16; ++j) { mx[0] = fmaxf(mx[0], fabsf(v[j][0])); mx[1] = fmaxf(mx[1], fabsf(v[j][1])); mx[2] = fmaxf(mx[2], fabsf(v[j][2])); mx[3] = fmaxf(mx[3], fabsf(v[j][3])); }
#pragma unroll
        for (int i = 0; i < 4; ++i) { mx[i] = fmaxf(mx[i], __shfl_xor(mx[i], 16)); mx[i] = fmaxf(mx[i], __shfl_xor(mx[i], 32)); }
        if (F.lane < 16) {
#pragma unroll
            for (int i = 0; i < 4; ++i) atomicMax(cm + n0 + 4 * F.lane + i, __float_as_uint(mx[i])); } }
}
__device__ __forceinline__ void cvt_store_i8(int K, int N, unsigned char* WT, int mode, int item, int lane, const f32x4 (&v)[16], LAS unsigned char* T, const unsigned* cm, float* cs) {
    const int nn = N >> 6, kb = item / nn, nb = item - kb * nn, k0 = kb * 64, n0 = nb * 64;
    const int kk = lane >> 4, c = lane & 15;
#pragma unroll
    for (int i = 0; i < 4; ++i) { const float mxv = fmaxf(__uint_as_float(cm[n0 + 4 * c + i]), 1e-30f), S = 127.0f / mxv; v4u o;
        if (kb == 0 && kk == 0) cs[n0 + 4 * c + i] = mxv * (1.0f / 127.0f);
        o.x = pack4_i8(v[0][i] * S, v[1][i] * S, v[2][i] * S, v[3][i] * S); o.y = pack4_i8(v[4][i] * S, v[5][i] * S, v[6][i] * S, v[7][i] * S);
        o.z = pack4_i8(v[8][i] * S, v[9][i] * S, v[10][i] * S, v[11][i] * S); o.w = pack4_i8(v[12][i] * S, v[13][i] * S, v[14][i] * S, v[15][i] * S);
        *(LAS v4u*)(T + (4 * c + i) * CVT_TP8 + 16 * kk) = o; }
    const int r16 = lane >> 2, p = lane & 3;
#pragma unroll
    for (int q = 0; q < 4; ++q) { const int n = 16 * q + r16, nabs = n0 + n; const v4u val = *(const LAS v4u*)(T + n * CVT_TP8 + 16 * p);
        const int drow = (mode == 0) ? nabs : ((nabs >> 7) * 256 + (nabs & 127) + (mode == 2 ? 128 : 0));
        *(GAS v4u*)(WT + (size_t)drow * K + k0 + 16 * p) = val; }
}
__device__ __forceinline__ void cvt_matrix_i8(const Frame& F, const float* W, int K, int N, unsigned char* WT, int mode, int gw, int NGW, const float* g, const unsigned* cm, float* cs, int ldw = 0) {
    const int nitems = (K >> 6) * (N >> 6); LAS unsigned char* T = (LAS unsigned char*)(F.lds + RING_OFF + F.wave * CVT_TBYTES);
    for (int it = gw; it < nitems; it += 2 * NGW) { f32x4 v0[16], v1[16]; const bool two = it + NGW < nitems;
        cvt_load(W, N, it, F.lane, v0, g, ldw); if (two) cvt_load(W, N, it + NGW, F.lane, v1, g, ldw);
        cvt_store_i8(K, N, WT, mode, it, F.lane, v0, T, cm, cs); if (two) cvt_store_i8(K, N, WT, mode, it + NGW, F.lane, v1, T, cm, cs); }
}
__device__ __forceinline__ void cvt_matrix(const Frame& F, const float* W, int K, int N, bf16* WT, int mode, int gw, int NGW, const float* g = nullptr, int ldw = 0) {
    const int nitems = (K >> 6) * (N >> 6); LAS bf16* T = (LAS bf16*)(F.lds + RING_OFF + F.wave * CVT_TBYTES);
    for (int it = gw; it < nitems; it += 2 * NGW) { f32x4 v0[16], v1[16]; const bool two = it + NGW < nitems;
        cvt_load(W, N, it, F.lane, v0, g, ldw); if (two) cvt_load(W, N, it + NGW, F.lane, v1, g, ldw);
        cvt_store(K, N, WT, mode, it, F.lane, v0, T); if (two) cvt_store(K, N, WT, mode, it + NGW, F.lane, v1, T); }
}
__device__ __forceinline__ void row_q8_rstd(const float* xrow, unsigned char* qrow, float* rstd, int lane) {
    f32x4 a[8], b[8]; float s = 0.f, amax = 0.f;
#pragma unroll
    for (int j = 0; j < 8; ++j) { const GAS f32x4* p = (const GAS f32x4*)(xrow + 8 * lane + 512 * j); a[j] = p[0]; b[j] = p[1];
        s += (a[j][0] * a[j][0] + a[j][1] * a[j][1]) + (a[j][2] * a[j][2] + a[j][3] * a[j][3]) + (b[j][0] * b[j][0] + b[j][1] * b[j][1]) + (b[j][2] * b[j][2] + b[j][3] * b[j][3]);
        amax = fmaxf(amax, fmaxf(fmaxf(fmaxf(fabsf(a[j][0]), fabsf(a[j][1])), fmaxf(fabsf(a[j][2]), fabsf(a[j][3]))), fmaxf(fmaxf(fabsf(b[j][0]), fabsf(b[j][1])), fmaxf(fabsf(b[j][2]), fabsf(b[j][3]))))); }
    s = wave_sum(s);
#pragma unroll
    for (int o = 1; o < 64; o <<= 1) amax = fmaxf(amax, __shfl_xor(amax, o));
    amax = fmaxf(amax, 1e-20f); const float inv = 127.0f / amax;
#pragma unroll
    for (int j = 0; j < 8; ++j) { v2u w; w.x = pack4_i8(a[j][0] * inv, a[j][1] * inv, a[j][2] * inv, a[j][3] * inv); w.y = pack4_i8(b[j][0] * inv, b[j][1] * inv, b[j][2] * inv, b[j][3] * inv);
        *(GAS v2u*)(qrow + 8 * lane + 512 * j) = w; }
    if (lane == 0) *rstd = amax * (1.0f / 127.0f) / sqrtf(s * (1.0f / D) + EPS);
}
__device__ __forceinline__ void x_rows_phase(const Frame& F, const Args& A) {
    const int gw = F.vcu * NWAVES + F.wave, NGW = F.G * NWAVES;
    for (int m = gw; m < NTOK; m += NGW) { const float* xr = (m < NPR) ? A_x_p + (size_t)m * D : A_x_s + (size_t)(m - NPR) * D; row_q8_rstd(xr, (unsigned char*)A_ZN + (size_t)m * D, A_RSTD + m, F.lane); }
}
constexpr float F8_ASCALE = 16.0f;
__device__ __forceinline__ void rstd_phase(const Frame& F, const Args& A, bool fix, unsigned char* a8 = nullptr, unsigned char* q8 = nullptr, float* rq = nullptr) {
    const int gw = F.vcu * NWAVES + F.wave, NGW = F.G * NWAVES, lane = F.lane;
    for (int m = gw; m < NTOK; m += NGW) { bf16* hrow = A_HB + (size_t)m * D; float s = 0.f, amax = 0.f; float x[8][8];
#pragma unroll
        for (int j = 0; j < 8; ++j) unpack8(*(const GAS v4u*)(hrow + 8 * lane + 512 * j), x[j]);
        if (fix && m >= NPR) { const bf16* sbrow = A_SB + (size_t)(m - NPR) * D;
#pragma unroll
            for (int j = 0; j < 8; ++j) { float p[8]; unpack8(*(const GAS v4u*)(sbrow + 8 * lane + 512 * j), p);
#pragma unroll
                for (int e = 0; e < 8; ++e) x[j][e] += p[e];
                const v4u w = pack8(x[j]); *(GAS v4u*)(hrow + 8 * lane + 512 * j) = w; unpack8(w, x[j]); } }
#pragma unroll
        for (int j = 0; j < 8; ++j)
#pragma unroll
            for (int e = 0; e < 8; ++e) { s += x[j][e] * x[j][e]; amax = fmaxf(amax, fabsf(x[j][e])); }
        s = wave_sum(s);
        float rs = 1.0f / sqrtf(s * (1.0f / D) + EPS); const float rs0 = rs;
        if (a8) {
#pragma unroll
            for (int j = 0; j < 8; ++j) { constexpr float S8 = F8_ASCALE; v2u w; w.x = pg8::cvt4_fp8(x[j][0] * S8, x[j][1] * S8, x[j][2] * S8, x[j][3] * S8); w.y = pg8::cvt4_fp8(x[j][4] * S8, x[j][5] * S8, x[j][6] * S8, x[j][7] * S8);
                *(GAS v2u*)(a8 + (size_t)m * D + 8 * lane + 512 * j) = w; } }
        if (q8) {
#pragma unroll
            for (int o = 1; o < 64; o <<= 1) amax = fmaxf(amax, __shfl_xor(amax, o));
            amax = fmaxf(amax, 1e-20f); const float inv = 127.0f / amax; rs *= amax * (1.0f / 127.0f);
#pragma unroll
            for (int j = 0; j < 8; ++j) { v2u w; w.x = pack4_i8(x[j][0] * inv, x[j][1] * inv, x[j][2] * inv, x[j][3] * inv); w.y = pack4_i8(x[j][4] * inv, x[j][5] * inv, x[j][6] * inv, x[j][7] * inv);
                *(GAS v2u*)(q8 + (size_t)m * D + 8 * lane + 512 * j) = w; } }
        if (lane == 0) { if (rq) { A_RSTD[m] = rs0; rq[m] = rs; } else A_RSTD[m] = rs; } }
}
#ifndef CONV_PLACE
#define CONV_PLACE 1
#endif
__device__ __forceinline__ void convert_set1(const Frame& F, const Args& A, int gw, int NGW) {
    cvt_matrix(F, A_w1d, DFF, D, A_W1D, 0, gw, NGW); cvt_matrix(F, A_w_in + C_KA, D, 512, A_WINB, 0, gw, NGW, A_g_mix, INW); cvt_matrix(F, A_w_in + C_KR, D, 3072, A_WINB + (size_t)512 * D, 0, gw, NGW, A_g_mix, INW);
    cvt_matrix_i8(F, A_w_in + C_QA, D, 2048, A_WINQ, 0, gw, NGW, A_g_mix, A_CMWIN, A_CSWIN, INW); cvt_matrix_i8(F, A_w_in + C_QR, D, 1024, A_WINQ + (size_t)2048 * D, 0, gw, NGW, A_g_mix, A_CMWIN + 2048, A_CSWIN + 2048, INW);
    cvt_matrix_i8(F, A_w_in + C_GR, D, 2048, A_WINQ + (size_t)3072 * D, 0, gw, NGW, A_g_mix, A_CMWIN + 3072, A_CSWIN + 3072, INW); cvt_matrix(F, A_w_out, D, D, A_WOUT, 0, gw, NGW);
    colmax_matrix(F, A_w2g, D, DFF, A_CM2G, gw, NGW, A_g_ffn2); colmax_matrix(F, A_w2u, D, DFF, A_CM2U, gw, NGW, A_g_ffn2);
    colmax_matrix(F, A_w_pg, D, D, A_CMPG, gw, NGW, A_g_ple); }
__device__ __forceinline__ void convert_set2(const Frame& F, const Args& A, int gw, int NGW) {
    cvt_matrix_i8(F, A_w2g, D, DFF, (unsigned char*)A_W2GU, 1, gw, NGW, A_g_ffn2, A_CM2G, A_CS2G); cvt_matrix_i8(F, A_w2u, D, DFF, (unsigned char*)A_W2GU, 2, gw, NGW, A_g_ffn2, A_CM2U, A_CS2U); }
__device__ __forceinline__ void convert_set4(const Frame& F, const Args& A, int gw, int NGW) {
    cvt_matrix_f8(F, A_w2d, DFF, D, (unsigned char*)A_W2D, gw, NGW); cvt_matrix_i8(F, A_w_pg, D, D, (unsigned char*)A_WPG, 0, gw, NGW, A_g_ple, A_CMPG, A_CSPG); }
__device__ __forceinline__ void p0_stage1(const Frame& F, const Args& A) { const int gw0 = F.vcu * NWAVES + F.wave, NGW0 = F.G * NWAVES; colmax_matrix(F, A_w1g, D, DFF, A_CM1G, gw0, NGW0, A_g_ffn1); }
__device__ __forceinline__ void p0_stage2(const Frame& F, const Args& A) { const int gw0 = F.vcu * NWAVES + F.wave, NGW0 = F.G * NWAVES;
    cvt_matrix_i8(F, A_w1g, D, DFF, (unsigned char*)A_W1GU, 1, gw0, NGW0, A_g_ffn1, A_CM1G, A_CS1G); colmax_matrix(F, A_w1u, D, DFF, A_CM1U, gw0, NGW0, A_g_ffn1); }
__device__ __forceinline__ void p0_prologue(const Frame& F, const Args& A) {
    const int gw0 = F.vcu * NWAVES + F.wave, NGW0 = F.G * NWAVES;
    cvt_matrix_i8(F, A_w1u, D, DFF, (unsigned char*)A_W1GU, 2, gw0, NGW0, A_g_ffn1, A_CM1U, A_CS1U); cvt_matrix(F, A_w_pp, PLE, D, A_WPP, 0, gw0, NGW0);
    colmax_matrix(F, A_w_in + C_QA, D, 2048, A_CMWIN, gw0, NGW0, A_g_mix, INW); colmax_matrix(F, A_w_in + C_QR, D, 1024, A_CMWIN + 2048, gw0, NGW0, A_g_mix, INW); colmax_matrix(F, A_w_in + C_GR, D, 2048, A_CMWIN + 3072, gw0, NGW0, A_g_mix, INW);
    x_rows_phase(F, A);
    const int gt = F.vcu * (NWAVES * 64) + F.tid, NGT = F.G * NWAVES * 64;
    for (int i = gt; i < NTOK * PLE / 8; i += NGT) { const size_t e = (size_t)i * 8; const float* src = (e < (size_t)NPR * PLE) ? A_p_p + e : A_p_s + (e - (size_t)NPR * PLE);
        const f32x4 a = *(const GAS f32x4*)src, b = *(const GAS f32x4*)(src + 4); v4u o; o.x = cvtpk(a[0], a[1]); o.y = cvtpk(a[2], a[3]); o.z = cvtpk(b[0], b[1]); o.w = cvtpk(b[2], b[3]);
        *(GAS v4u*)(A_PB + e) = o; }
    for (int e = gt; e < NPOS * 64; e += NGT) { const int pos = e >> 6, i = e & 63;
        const double ang = (double)pos * exp2((double)i * (-13.287712379549449 / 64.0));
        const double k = rint(ang * 0.63661977236758134); double r = fma(-k, 1.5707963267948966, ang); r = fma(-k, 6.123233995736766e-17, r);
        const int q = ((int)k) & 3; const double r2 = r * r;
        const double sn = r * (1.0 + r2 * (-1.0 / 6 + r2 * (1.0 / 120 + r2 * (-1.0 / 5040 + r2 * (1.0 / 362880 + r2 * (-1.0 / 39916800 + r2 * (1.0 / 6227020800.0)))))));
        const double cs = 1.0 + r2 * (-0.5 + r2 * (1.0 / 24 + r2 * (-1.0 / 720 + r2 * (1.0 / 40320 + r2 * (-1.0 / 3628800 + r2 * (1.0 / 479001600.0 + r2 * (-1.0 / 87178291200.0)))))));
        const double c = (q == 0) ? cs : (q == 1) ? -sn : (q == 2) ? -cs : sn, s = (q == 0) ? sn : (q == 1) ? cs : (q == 2) ? -sn : -cs;
        A_ROPE[e] = (f32x2){(float)c, (float)s}; }
}

constexpr int AT_KS = 0, AT_KP = 72, AT_VT = 27648, AT_VP = 200;
__device__ __forceinline__ void attn_unit(const Frame& F, const Args& A, int ua) {
    const int tid = F.tid, lane = F.lane, wave = F.wave;
    const bool prompt = ua < 512;
    const int b = prompt ? (ua >> 8) : ((ua - 512) >> 2), c = prompt ? ((ua >> 2) & 63) : 0, kvh = ua & 3;
    const int row0 = prompt ? b * SEQ + c * 64 : NPR + b * 64;
    LAS bf16* Ks = (LAS bf16*)(F.lds + AT_KS); LAS bf16* Vt = (LAS bf16*)(F.lds + AT_VT);
    const int hh = kvh * 8 + wave, r = lane & 31, h = lane >> 5;
    v4u qraw0[4], qraw1[4];
    {   const bf16* q0p = A_U + (size_t)(row0 + r) * INW + C_QA + hh * 64 + 8 * h; const bf16* q1p = q0p + (size_t)32 * INW;
#pragma unroll
        for (int ks = 0; ks < 4; ++ks) { qraw0[ks] = *(const GAS v4u*)(q0p + 16 * ks); qraw1[ks] = *(const GAS v4u*)(q1p + 16 * ks); } }
    const int t = tid >> 3, dp = tid & 7;
    v4u kraw[3], vraw[3]; f32x4 ck[2][2], cv[2][2];
#pragma unroll
    for (int i = 0; i < 3; ++i) {
        if (prompt || i == 2) {
            const int kc = c - 2 + i; const bool valid = (!prompt) || kc >= 0;
            const int row = prompt ? b * SEQ + kc * 64 + t : row0 + t;
            kraw[i] = (v4u){0u, 0u, 0u, 0u}; vraw[i] = (v4u){0u, 0u, 0u, 0u};
            if (valid) { const bf16* up = A_U + (size_t)row * INW + kvh * 64 + 8 * dp; kraw[i] = *(const GAS v4u*)(up + C_KA); vraw[i] = *(const GAS v4u*)(up + C_VA); }
        } else if (i < 2) {
            const size_t ci = ((size_t)(b * 128 + i * 64 + t) * 4 + kvh) * 64 + 8 * dp;
            ck[i][0] = *(const GAS f32x4*)(A_cache_k + ci); ck[i][1] = *(const GAS f32x4*)(A_cache_k + ci + 4); cv[i][0] = *(const GAS f32x4*)(A_cache_v + ci); cv[i][1] = *(const GAS f32x4*)(A_cache_v + ci + 4);
        }
    }
    __syncthreads();
    {   const f32x4 gk0 = *(const GAS f32x4*)(A_g_k + 8 * dp), gk1 = *(const GAS f32x4*)(A_g_k + 8 * dp + 4);
#pragma unroll
        for (int i = 0; i < 3; ++i) {
            float kv[8], vv[8]; bool donorm;
            if (prompt || i == 2) { unpack8(kraw[i], kv); unpack8(vraw[i], vv); donorm = true; }
            else if (i < 2) {
#pragma unroll
                for (int e = 0; e < 4; ++e) { kv[e] = ck[i][0][e]; kv[4 + e] = ck[i][1][e]; vv[e] = cv[i][0][e]; vv[4 + e] = cv[i][1][e]; }
                donorm = false;
            }
            float ss = 0.f;
#pragma unroll
            for (int e = 0; e < 8; ++e) ss += kv[e] * kv[e];
            ss += __shfl_xor(ss, 1); ss += __shfl_xor(ss, 2); ss += __shfl_xor(ss, 4);
            if (donorm) { const float rstd = 1.0f / sqrtf(ss * (1.0f / 64) + EPS);
#pragma unroll
                for (int e = 0; e < 4; ++e) { kv[e] = kv[e] * rstd * gk0[e]; kv[4 + e] = kv[4 + e] * rstd * gk1[e]; } }
            const int key = 64 * i + t;
            *(LAS v4u*)(Ks + key * AT_KP + 8 * dp) = pack8(kv);
#pragma unroll
            for (int e = 0; e < 8; ++e) Vt[(8 * dp + e) * AT_VP + (key ^ (8 * dp))] = bf1(vv[e]);
            float* ok = nullptr; float* ov = nullptr;
            if (prompt) { if (i == 2 && c >= 62) { const size_t o = ((size_t)(b * 128 + (c - 62) * 64 + t) * 4 + kvh) * 64 + 8 * dp; ok = A_out + O_KP + o; ov = A_out + O_VP + o; } }
            else if (i >= 1) { const size_t o = ((size_t)(b * 128 + (i - 1) * 64 + t) * 4 + kvh) * 64 + 8 * dp; ok = A_out + O_KS + o; ov = A_out + O_VS + o; }
            if (ok) { *(GAS f32x4*)ok = (f32x4){kv[0], kv[1], kv[2], kv[3]}; *(GAS f32x4*)(ok + 4) = (f32x4){kv[4], kv[5], kv[6], kv[7]};
                      *(GAS f32x4*)ov = (f32x4){vv[0], vv[1], vv[2], vv[3]}; *(GAS f32x4*)(ov + 4) = (f32x4){vv[4], vv[5], vv[6], vv[7]}; }
        }
    }
    __syncthreads();
    const float sink = A_sinks[hh];
    const int kt_first = prompt ? (c >= 2 ? 0 : (2 - c) * 2) : 0;
    constexpr float L2E = 1.4426950408889634f;
#pragma unroll 1
    for (int qb = 0; qb < 2; ++qb) {
        float qf[4][8]; float ss = 0.f;
#pragma unroll
        for (int ks = 0; ks < 4; ++ks) { v4u qw; qw.x = qb ? qraw1[ks].x : qraw0[ks].x; qw.y = qb ? qraw1[ks].y : qraw0[ks].y; qw.z = qb ? qraw1[ks].z : qraw0[ks].z; qw.w = qb ? qraw1[ks].w : qraw0[ks].w; unpack8(qw, qf[ks]);
#pragma unroll
            for (int e = 0; e < 8; ++e) ss += qf[ks][e] * qf[ks][e]; }
        ss += __shfl_xor(ss, 32);
        const float sc = 0.125f / sqrtf(ss * (1.0f / 64) + EPS);
        bf16x8 Qf[4];
#pragma unroll
        for (int ks = 0; ks < 4; ++ks) { float t8[8];
            const f32x4 g0 = *(const GAS f32x4*)(A_g_q + 16 * ks + 8 * h), g1 = *(const GAS f32x4*)(A_g_q + 16 * ks + 8 * h + 4);
#pragma unroll
            for (int e = 0; e < 4; ++e) { t8[e] = qf[ks][e] * sc * g0[e]; t8[4 + e] = qf[ks][4 + e] * sc * g1[e]; }
            Qf[ks] = __builtin_bit_cast(bf16x8, pack8(t8)); }
        __builtin_amdgcn_sched_barrier(0);
        f32x16 S[6];
#pragma unroll
        for (int kt = 0; kt < 6; ++kt) {
#pragma unroll
            for (int i = 0; i < 16; ++i) S[kt][i] = 0.f;
#pragma unroll
            for (int ks = 0; ks < 4; ++ks) { const bf16x8 Af = *(const LAS bf16x8*)(Ks + (32 * kt + r) * AT_KP + 16 * ks + 8 * h); S[kt] = MFMA32(Af, Qf[ks], S[kt]); } }
        float mx = sink;
#pragma unroll
        for (int kt = 0; kt < 6; ++kt) if (kt >= kt_first) {
#pragma unroll
            for (int i = 0; i < 16; ++i) mx = fmaxf(mx, S[kt][i]); }
        mx = fmaxf(mx, __shfl_xor(mx, 32));
        float sum = 0.f;
#pragma unroll
        for (int kt = 0; kt < 6; ++kt) { const bool on = kt >= kt_first;
#pragma unroll
            for (int i = 0; i < 16; ++i) { const float p = on ? __builtin_amdgcn_exp2f((S[kt][i] - mx) * L2E) : 0.f; S[kt][i] = p; sum += p; } }
        sum += __shfl_xor(sum, 32);
        const float inv = 1.0f / (sum + __builtin_amdgcn_exp2f((sink - mx) * L2E));
        f32x16 O[2];
#pragma unroll
        for (int dt = 0; dt < 2; ++dt)
#pragma unroll
            for (int i = 0; i < 16; ++i) O[dt][i] = 0.f;
#pragma unroll
        for (int kt = 0; kt < 6; ++kt)
#pragma unroll
            for (int s = 0; s < 2; ++s) {
                float t8[8];
#pragma unroll
                for (int e = 0; e < 8; ++e) t8[e] = S[kt][8 * s + e];
                const bf16x8 B = __builtin_bit_cast(bf16x8, pack8(t8));
#pragma unroll
                for (int dt = 0; dt < 2; ++dt) { const LAS bf16* vp = Vt + (32 * dt + r) * AT_VP; const int sw = 8 * (((32 * dt + r) >> 3) & 7), k0 = 32 * kt + 16 * s + 4 * h;
                    const s16x4 lo = *(const LAS s16x4*)(vp + (k0 ^ sw)), hi = *(const LAS s16x4*)(vp + ((k0 + 8) ^ sw));
                    const bf16x8 Af = __builtin_shufflevector(lo, hi, 0, 1, 2, 3, 4, 5, 6, 7); O[dt] = MFMA32(Af, B, O[dt]); }
                __builtin_amdgcn_sched_barrier(0);
            }
        bf16* orow = A_MIX + (size_t)(row0 + qb * 32 + r) * D + hh * 64 + 4 * h;
#pragma unroll
        for (int dt = 0; dt < 2; ++dt)
#pragma unroll
            for (int rg = 0; rg < 4; ++rg) { v2u w; w.x = cvtpk(O[dt][4 * rg] * inv, O[dt][4 * rg + 1] * inv); w.y = cvtpk(O[dt][4 * rg + 2] * inv, O[dt][4 * rg + 3] * inv);
                *(GAS v2u*)(orow + 32 * dt + 8 * rg) = w; }
    }
}

__device__ __forceinline__ void rot_load(const Args& A, const bf16* src  , int pos, int dp, float (&o1)[8], float (&o2)[8]) {
    float x1[8], x2[8]; unpack8(*(const GAS v4u*)(src + 8 * dp), x1); unpack8(*(const GAS v4u*)(src + 64 + 8 * dp), x2);
    const GAS f32x4* tp = (const GAS f32x4*)(A_ROPE + (size_t)pos * 64 + 8 * dp);
#pragma unroll
    for (int e2 = 0; e2 < 4; ++e2) { const f32x4 cs = tp[e2];
        o1[2 * e2] = x1[2 * e2] * cs[0] - x2[2 * e2] * cs[1]; o2[2 * e2] = x2[2 * e2] * cs[0] + x1[2 * e2] * cs[1];
        o1[2 * e2 + 1] = x1[2 * e2 + 1] * cs[2] - x2[2 * e2 + 1] * cs[3]; o2[2 * e2 + 1] = x2[2 * e2 + 1] * cs[2] + x1[2 * e2 + 1] * cs[3]; }
}
constexpr float KSCALE = 0.088388347648318441f;
constexpr int RL_KT = 0, RL_P = 72, RL_VT = 18432;
__device__ __forceinline__ void retloc_unit(const Frame& F, const Args& A, int ur) {
    const int tid = F.tid, lane = F.lane, wave = F.wave;
    const bool prompt = ur < 1024;
    const int b = prompt ? (ur >> 9) : ((ur - 1024) >> 3), c = prompt ? ((ur >> 3) & 63) : 0, hh = ur & 7;
    const int row0 = prompt ? b * SEQ + c * 64 : NPR + b * 64, pos0 = prompt ? c * 64 : SEQ;
    const float l2g = log2_gamma(hh);
    LAS bf16* KT = (LAS bf16*)(F.lds + RL_KT); LAS bf16* VT = (LAS bf16*)(F.lds + RL_VT);
    __syncthreads();
    {   const int m = tid >> 3, dp = tid & 7; float o1[8], o2[8];
        rot_load(A, A_U + (size_t)(row0 + m) * INW + C_KR + hh * 128, pos0 + m, dp, o1, o2);
        const float sc = KSCALE * __builtin_amdgcn_exp2f((float)(63 - m) * l2g);
#pragma unroll
        for (int e = 0; e < 8; ++e) { KT[(8 * dp + e) * RL_P + (m ^ (8 * dp))] = bf1(o1[e] * sc); KT[(64 + 8 * dp + e) * RL_P + (m ^ (8 * dp))] = bf1(o2[e] * sc); }
#pragma unroll
        for (int i = 0; i < 4; ++i) { const int mm = 8 * wave + (lane & 7), vp = (lane >> 3) + 8 * i; float vv[8];
            unpack8(*(const GAS v4u*)(A_U + (size_t)(row0 + mm) * INW + C_VR + hh * 256 + 8 * vp), vv);
#pragma unroll
            for (int e = 0; e < 8; ++e) VT[(8 * vp + e) * RL_P + (mm ^ (8 * (lane >> 3)))] = bf1(vv[e]); }
    }
    __syncthreads();
    const int c16 = lane & 15, q4 = lane >> 4;
    f32x4 acc[8][2];
#pragma unroll
    for (int dt = 0; dt < 8; ++dt)
#pragma unroll
        for (int vt = 0; vt < 2; ++vt) acc[dt][vt] = (f32x4){0.f, 0.f, 0.f, 0.f};
    if (prompt) {
#pragma unroll
        for (int ks = 0; ks < 2; ++ks) { bf16x8 Bv[2];
#pragma unroll
            for (int vt = 0; vt < 2; ++vt) Bv[vt] = *(const LAS bf16x8*)(VT + (32 * wave + 16 * vt + c16) * RL_P + ((32 * ks + 8 * q4) ^ (8 * (((32 * wave + 16 * vt + c16) >> 3) & 7))));
#pragma unroll
            for (int dt = 0; dt < 8; ++dt) { const bf16x8 Af = *(const LAS bf16x8*)(KT + (16 * dt + c16) * RL_P + ((32 * ks + 8 * q4) ^ (8 * (((16 * dt + c16) >> 3) & 7))));
#pragma unroll
                for (int vt = 0; vt < 2; ++vt) acc[dt][vt] = MFMA16(Af, Bv[vt], acc[dt][vt]); } }
        bf16* rs = A_RS + (size_t)ur * 32768;
#pragma unroll
        for (int dt = 0; dt < 8; ++dt)
#pragma unroll
            for (int vt = 0; vt < 2; ++vt) { v2u w; w.x = cvtpk(acc[dt][vt][0], acc[dt][vt][1]); w.y = cvtpk(acc[dt][vt][2], acc[dt][vt][3]);
                *(GAS v2u*)(rs + (32 * wave + 16 * vt + c16) * 128 + 16 * dt + 4 * q4) = w; }
    } else {
#pragma unroll
        for (int ks = 0; ks < 2; ++ks) { bf16x8 Av[2];
#pragma unroll
            for (int vt = 0; vt < 2; ++vt) Av[vt] = *(const LAS bf16x8*)(VT + (32 * wave + 16 * vt + c16) * RL_P + ((32 * ks + 8 * q4) ^ (8 * (((32 * wave + 16 * vt + c16) >> 3) & 7))));
#pragma unroll
            for (int dt = 0; dt < 8; ++dt) { const bf16x8 Bk = *(const LAS bf16x8*)(KT + (16 * dt + c16) * RL_P + ((32 * ks + 8 * q4) ^ (8 * (((16 * dt + c16) >> 3) & 7))));
#pragma unroll
                for (int vt = 0; vt < 2; ++vt) acc[dt][vt] = MFMA16(Av[vt], Bk, acc[dt][vt]); } }
        const float g64 = __builtin_amdgcn_exp2f(64.0f * l2g);
        const size_t sb = (size_t)(b * 8 + hh) * 32768;
#pragma unroll
        for (int dt = 0; dt < 8; ++dt)
#pragma unroll
            for (int vt = 0; vt < 2; ++vt) { const size_t o = sb + (size_t)(16 * dt + c16) * 256 + 32 * wave + 16 * vt + 4 * q4;
                const f32x4 s = *(const GAS f32x4*)(A_state_in + o); *(GAS f32x4*)(A_out + O_SS + o) = s * g64 + acc[dt][vt]; }
    }
}
__device__ __forceinline__ void scan_items(const Args& A, int i0, int i1) {
    const bool two = i1 >= 0; if (!two) i1 = i0;
    const int ch0 = i0 >> 13, e0 = i0 & 8191, b0 = ch0 >> 3, h0 = ch0 & 7, ch1 = i1 >> 13, e1 = i1 & 8191, b1 = ch1 >> 3, h1 = ch1 & 7;
    const float g0 = __builtin_amdgcn_exp2f(64.0f * log2_gamma(h0)), g1 = __builtin_amdgcn_exp2f(64.0f * log2_gamma(h1));
    const bf16* r0 = A_RS + (size_t)(b0 * 512 + h0) * 32768 + 4 * e0; const bf16* r1 = A_RS + (size_t)(b1 * 512 + h1) * 32768 + 4 * e1;
    bf16* w0 = A_STB + (size_t)(b0 * 512 + h0) * 32768 + 4 * e0; bf16* w1 = A_STB + (size_t)(b1 * 512 + h1) * 32768 + 4 * e1;
    f32x4 S0 = (f32x4){0.f, 0.f, 0.f, 0.f}, S1 = S0;
#pragma unroll 1
    for (int c0 = 0; c0 < 64; c0 += 16) {
        v2u l0[16], l1[16];
#pragma unroll
        for (int j = 0; j < 16; ++j) { l0[j] = *(const GAS v2u*)(r0 + (size_t)(c0 + j) * 8 * 32768); l1[j] = *(const GAS v2u*)(r1 + (size_t)(c0 + j) * 8 * 32768); }
#pragma unroll
        for (int j = 0; j < 16; ++j) { v2u w; w.x = cvtpk(S0[0], S0[1]); w.y = cvtpk(S0[2], S0[3]); *(GAS v2u*)(w0 + (size_t)(c0 + j) * 8 * 32768) = w;
            S0 = S0 * g0 + (f32x4){__uint_as_float(l0[j].x << 16), __uint_as_float(l0[j].x & 0xffff0000u), __uint_as_float(l0[j].y << 16), __uint_as_float(l0[j].y & 0xffff0000u)};
            if (two) { v2u x; x.x = cvtpk(S1[0], S1[1]); x.y = cvtpk(S1[2], S1[3]); *(GAS v2u*)(w1 + (size_t)(c0 + j) * 8 * 32768) = x; }
            S1 = S1 * g1 + (f32x4){__uint_as_float(l1[j].x << 16), __uint_as_float(l1[j].x & 0xffff0000u), __uint_as_float(l1[j].y << 16), __uint_as_float(l1[j].y & 0xffff0000u)}; }
    }
    { const int v = e0 >> 5, d0 = (e0 & 31) * 4; float* o = A_out + O_SP + (size_t)ch0 * 32768 + (size_t)d0 * 256 + v; o[0] = S0[0]; o[256] = S0[1]; o[512] = S0[2]; o[768] = S0[3]; }
    if (two) { const int v = e1 >> 5, d0 = (e1 & 31) * 4; float* o = A_out + O_SP + (size_t)ch1 * 32768 + (size_t)d0 * 256 + v; o[0] = S1[0]; o[256] = S1[1]; o[512] = S1[2]; o[768] = S1[3]; }
}
__device__ __forceinline__ void scan_phase(const Frame& F, const Args& A, int jl, int nl) {
    const int NT = nl * NWAVES * 64;
    for (int i = jl * (NWAVES * 64) + F.tid; i < 16 * 8192; i += 2 * NT) scan_items(A, i, (i + NT < 16 * 8192) ? i + NT : -1);
}
constexpr int RO_QP = 0, RO_KP = 17408, RO_DP = 136, RO_VT = 34816, RO_VP = 72, RO_PS = 71680, RO_PP = 72, RO_RED = 80896;
__device__ __forceinline__ void retout_unit(const Frame& F, const Args& A, int ur) {
    const int tid = F.tid, lane = F.lane, wave = F.wave;
    const bool prompt = ur < 1024;
    const int b = prompt ? (ur >> 9) : ((ur - 1024) >> 3), c = prompt ? ((ur >> 3) & 63) : 0, hh = ur & 7;
    const int row0 = prompt ? b * SEQ + c * 64 : NPR + b * 64, pos0 = prompt ? c * 64 : SEQ;
    const float l2g = log2_gamma(hh);
    LAS bf16* QP = (LAS bf16*)(F.lds + RO_QP); LAS bf16* KP = (LAS bf16*)(F.lds + RO_KP); LAS bf16* VT = (LAS bf16*)(F.lds + RO_VT); LAS bf16* PS = (LAS bf16*)(F.lds + RO_PS);
    LAS f32x2* RED = (LAS f32x2*)(F.lds + RO_RED);
    const int c16 = lane & 15, q4 = lane >> 4;
    bf16x8 Sf[4][2]; v2u gwr[4][2]; f32x4 grr[2];
#pragma unroll
    for (int vt = 0; vt < 2; ++vt) { const int v = 32 * wave + 16 * vt + c16; grr[vt] = *(const GAS f32x4*)(A_g_ret + hh * 256 + 32 * wave + 16 * vt + 4 * q4);
#pragma unroll
        for (int ks = 0; ks < 4; ++ks) { Sf[ks][vt] = (bf16x8){0, 0, 0, 0, 0, 0, 0, 0}; if (prompt) Sf[ks][vt] = *(const GAS bf16x8*)(A_STB + (size_t)ur * 32768 + v * 128 + 32 * ks + 8 * q4); }
#pragma unroll
        for (int lt = 0; lt < 4; ++lt) gwr[lt][vt] = *(const GAS v2u*)(A_U + (size_t)(row0 + 16 * lt + c16) * INW + C_GR + hh * 256 + 32 * wave + 16 * vt + 4 * q4); }
    __syncthreads();
    {   const int m = tid >> 3, dp = tid & 7; float o1[8], o2[8];
        const bf16* urow = A_U + (size_t)(row0 + m) * INW;
        rot_load(A, urow + C_QR + hh * 128, pos0 + m, dp, o1, o2);
        *(LAS v4u*)(QP + m * RO_DP + 8 * dp) = pack8(o1); *(LAS v4u*)(QP + m * RO_DP + 64 + 8 * dp) = pack8(o2);
        rot_load(A, urow + C_KR + hh * 128, pos0 + m, dp, o1, o2);
#pragma unroll
        for (int e = 0; e < 8; ++e) { o1[e] *= KSCALE; o2[e] *= KSCALE; }
        *(LAS v4u*)(KP + m * RO_DP + 8 * dp) = pack8(o1); *(LAS v4u*)(KP + m * RO_DP + 64 + 8 * dp) = pack8(o2);
#pragma unroll
        for (int i = 0; i < 4; ++i) { const int mm = 8 * wave + (lane & 7), vp = (lane >> 3) + 8 * i; float vv[8];
            unpack8(*(const GAS v4u*)(A_U + (size_t)(row0 + mm) * INW + C_VR + hh * 256 + 8 * vp), vv);
#pragma unroll
            for (int e = 0; e < 8; ++e) VT[(8 * vp + e) * RO_VP + (mm ^ (8 * (lane >> 3)))] = bf1(vv[e]); }
    }
    __syncthreads();
    {
        const int mt = wave >> 1;
#pragma unroll
        for (int t2 = 0; t2 < 2; ++t2) { const int lt = (wave & 1) * 2 + t2; f32x4 s = (f32x4){0.f, 0.f, 0.f, 0.f};
#pragma unroll
            for (int ks = 0; ks < 4; ++ks) { const bf16x8 Af = *(const LAS bf16x8*)(KP + (16 * mt + c16) * RO_DP + 32 * ks + 8 * q4), B = *(const LAS bf16x8*)(QP + (16 * lt + c16) * RO_DP + 32 * ks + 8 * q4);
                s = MFMA16(Af, B, s); }
            const int l = 16 * lt + c16, m0 = 16 * mt + 4 * q4; float p[4];
#pragma unroll
            for (int e = 0; e < 4; ++e) { const int dist = (l > m0 + e) ? (l - m0 - e) : (m0 + e - l); p[e] = s[e] * __builtin_amdgcn_exp2f((float)dist * l2g); }
            v2u w; w.x = cvtpk(p[0], p[1]); w.y = cvtpk(p[2], p[3]); *(LAS v2u*)(PS + l * RO_PP + m0) = w; }
    }
    __syncthreads();
    f32x4 acc[2][4];
#pragma unroll
    for (int vt = 0; vt < 2; ++vt)
#pragma unroll
        for (int lt = 0; lt < 4; ++lt) acc[vt][lt] = (f32x4){0.f, 0.f, 0.f, 0.f};
#pragma unroll
    for (int ks = 0; ks < 4; ++ks) { bf16x8 Af[2];
#pragma unroll
        for (int vt = 0; vt < 2; ++vt) { const int v = 32 * wave + 16 * vt + c16;
            if (prompt) Af[vt] = Sf[ks][vt];
            else { const float* sp = A_state_in + (size_t)(b * 8 + hh) * 32768 + (size_t)(32 * ks + 8 * q4) * 256 + v; float t8[8];
#pragma unroll
                for (int j = 0; j < 8; ++j) t8[j] = sp[j * 256];
                Af[vt] = __builtin_bit_cast(bf16x8, pack8(t8)); } }
#pragma unroll
        for (int lt = 0; lt < 4; ++lt) { const bf16x8 B = *(const LAS bf16x8*)(QP + (16 * lt + c16) * RO_DP + 32 * ks + 8 * q4);
#pragma unroll
            for (int vt = 0; vt < 2; ++vt) acc[vt][lt] = MFMA16(Af[vt], B, acc[vt][lt]); } }
#pragma unroll
    for (int lt = 0; lt < 4; ++lt) { const float qd = __builtin_amdgcn_exp2f((float)(16 * lt + c16 + 1) * l2g);
#pragma unroll
        for (int vt = 0; vt < 2; ++vt) acc[vt][lt] = acc[vt][lt] * qd; }
#pragma unroll
    for (int ks = 0; ks < 2; ++ks) { bf16x8 Af[2];
#pragma unroll
        for (int vt = 0; vt < 2; ++vt) Af[vt] = *(const LAS bf16x8*)(VT + (32 * wave + 16 * vt + c16) * RO_VP + ((32 * ks + 8 * q4) ^ (8 * (((32 * wave + 16 * vt + c16) >> 3) & 7))));
#pragma unroll
        for (int lt = 0; lt < 4; ++lt) { const bf16x8 B = *(const LAS bf16x8*)(PS + (16 * lt + c16) * RO_PP + 32 * ks + 8 * q4);
#pragma unroll
            for (int vt = 0; vt < 2; ++vt) acc[vt][lt] = MFMA16(Af[vt], B, acc[vt][lt]); } }
#pragma unroll
    for (int lt = 0; lt < 4; ++lt) { float s1 = 0.f, s2 = 0.f;
#pragma unroll
        for (int vt = 0; vt < 2; ++vt)
#pragma unroll
            for (int e = 0; e < 4; ++e) { const float x = acc[vt][lt][e]; s1 += x; s2 += x * x; }
        s1 += __shfl_xor(s1, 16); s2 += __shfl_xor(s2, 16); s1 += __shfl_xor(s1, 32); s2 += __shfl_xor(s2, 32);
        if (q4 == 0) RED[wave * 64 + 16 * lt + c16] = (f32x2){s1, s2}; }
    __syncthreads();
#pragma unroll
    for (int lt = 0; lt < 4; ++lt) { const int l = 16 * lt + c16; float s1 = 0.f, s2 = 0.f;
#pragma unroll
        for (int w = 0; w < 8; ++w) { const f32x2 t = RED[w * 64 + l]; s1 += t[0]; s2 += t[1]; }
        const float mean = s1 * (1.0f / 256), var = fmaxf(s2 * (1.0f / 256) - mean * mean, 0.f), rstd = 1.0f / sqrtf(var + EPS);
#pragma unroll
        for (int vt = 0; vt < 2; ++vt) { const int v0 = 32 * wave + 16 * vt + 4 * q4;
            const f32x4 gr = grr[vt]; const v2u gw = gwr[lt][vt];
            const float g0 = __uint_as_float(gw.x << 16), g1 = __uint_as_float(gw.x & 0xffff0000u), g2 = __uint_as_float(gw.y << 16), g3 = __uint_as_float(gw.y & 0xffff0000u);
            const f32x4 a = acc[vt][lt];
            v2u w; w.x = cvtpk((a[0] - mean) * rstd * gr[0] * silu_f(g0), (a[1] - mean) * rstd * gr[1] * silu_f(g1));
            w.y = cvtpk((a[2] - mean) * rstd * gr[2] * silu_f(g2), (a[3] - mean) * rstd * gr[3] * silu_f(g3));
            *(GAS v2u*)(A_MIX + (size_t)(row0 + l) * D + 2048 + hh * 256 + v0) = w; } }
}

__global__ void __launch_bounds__(NWAVES * 64, 2) fwd(Args args) {
    extern __shared__ __attribute__((aligned(16))) unsigned char lds[];
    Frame F;
    F.lds = (LAS unsigned char*)lds;
    F.MISC = (volatile LAS unsigned*)(F.lds + MISC_OFF);
    F.tid = threadIdx.x; F.lane = F.tid & 63; F.wave = __builtin_amdgcn_readfirstlane(F.tid >> 6);
    F.G = gridDim.x; { const int bx = blockIdx.x; F.vcu = (F.G % 8 == 0) ? (bx % 8) * (F.G / 8) + bx / 8 : bx; }
    const Args& A = args;
    F.ctl = (gu32*)(args.ws + WS_CTL);
    for (int u = F.tid; u < (LDS_BYTES - LDSCTL_OFF) / 4; u += NWAVES * 64) ((LAS unsigned*)(F.lds + LDSCTL_OFF))[u] = 0u;
    __syncthreads();
    XcdBarrier bar; bar.bar = (unsigned*)(F.ctl + CW_BAR); bar.x = 0; bar.st = nullptr;
    if (MK_ONE_LAUNCH) bar = xcd_barrier_post((unsigned*)(F.ctl + CW_BAR), F.MISC + 8);
    const int lo = args.ph_lo, hi = args.ph_hi;
#ifndef ONLY_PHASE
#define ONLY_PHASE -1
#endif
#define IN(k) ((ONLY_PHASE < 0 || ONLY_PHASE == (k)) && lo <= (k) && (k) < hi)
#define SEAM(k) do { if (IN(k) && IN((k) + 1)) xcd_barrier(bar); } while (0)
    const int bx = (int)blockIdx.x;

    if (IN(0)) { p0_stage1(F, A); xcd_barrier(bar); p0_stage2(F, A); xcd_barrier(bar); p0_prologue(F, A); } SEAM(0);
    if (IN(1)) {
        { pg8::Gemm g{A_ZN, A_W1GU, NTOK, 2 * DFF, D / 2, D / 2, 0}; pg8::StaticOrder S; S.init(NTOK, 2 * DFF, F.G, bx); pg8::EpiSwiGLU<false, true> E{A_HID, DFF, A_RSTD, A_CS1G, A_CS1U};
          pg8::gemm_phase<pg8::EpiSwiGLU<false, true>, pg8::StaticOrder, true, true, false, false, true>(F.lds + RING_OFF, g, S, E); }
        __syncthreads();
#if CONV_PLACE != 0
        {
          const int nwg1 = (NTOK / 256) * (2 * DFF / 256), rem = nwg1 % F.G; const bool conv = (rem == 0) || (bx >= rem); const int jc = (rem == 0) ? bx : bx - rem, nconv = (rem == 0) ? F.G : F.G - rem;
          if (conv) convert_set1(F, A, jc * NWAVES + F.wave, nconv * NWAVES);
          if (!conv) {
            int kple = PLE; asm volatile("" : "+s"(kple));
            pg8::Gemm g{A_PB, A_WPP, NTOK, D, kple, kple, 0}; pg8::StaticOrder S; S.init(NTOK, D, rem, bx); pg8::EpiBf16 E{A_TP, D, nullptr};
            pg8::gemm_phase<pg8::EpiBf16, pg8::StaticOrder, true, true>(F.lds + RING_OFF, g, S, E); } }
#endif
    } SEAM(1);
    if (IN(2)) { { pg8::Gemm g{A_HID, A_W1D, NPR, D, DFF, DFF, 0}; pg8::StaticOrder S; S.init(NPR, D, F.G, bx); pg8::EpiRes<false> E{A_x_p, nullptr, A_HB, nullptr, D, 0.5f, nullptr};
          pg8::gemm_phase<pg8::EpiRes<false>, pg8::StaticOrder, true, true>(F.lds + RING_OFF, g, S, E); }
        __syncthreads();
        { pg8::Gemm g{A_HID + (size_t)NPR * DFF, A_W1D, NTOK - NPR, D, DFF, DFF, ((DFF / 64 / 2 + 1) & ~1)}; pg8::SplitKOrder S; S.init(D, F.G, bx); pg8::EpiRes<false> E{A_x_s, nullptr, A_HB + (size_t)NPR * D, A_SB, D, 0.5f, nullptr};
          pg8::gemm_phase<pg8::EpiRes<false>, pg8::SplitKOrder, true, true>(F.lds + RING_OFF, g, S, E); } } SEAM(2);
    if (IN(3)) { rstd_phase(F, A, true, nullptr, (unsigned char*)A_ZN, A_RSTDQ); } SEAM(3);
    if (IN(4)) {
        const int nb4 = (NTOK / 256) * 14, ni4 = (NTOK / 256) * 20, rb = nb4 % F.G, ri = ni4 % F.G; const int bxi = (rb % 8 == 0) ? (bx + F.G - rb) % F.G : bx;
        { pg8::Gemm g{A_HB, A_WINB, NTOK, 3584, D, D, 0}; pg8::StaticOrder S; S.init(NTOK, 3584, F.G, bx); pg8::EpiU<false> E{A_U, INW, A_RSTD, nullptr};
          pg8::gemm_phase<pg8::EpiU<false>, pg8::StaticOrder, true, true>(F.lds + RING_OFF, g, S, E); }
        __syncthreads();
        { pg8::Gemm g{A_ZN, (const bf16*)A_WINQ, NTOK, 5120, D / 2, D / 2, 0}; pg8::StaticOrder S; S.init(NTOK, 5120, F.G, bxi); pg8::EpiU<true> E{A_U, INW, A_RSTDQ, A_CSWIN};
          pg8::gemm_phase<pg8::EpiU<true>, pg8::StaticOrder, true, true, false, false, true>(F.lds + RING_OFF, g, S, E); }
        __syncthreads();
#if CONV_PLACE != 0
        { const bool conv = (bx >= rb) && (bxi >= ri); int jc = 0, nconv = 0;
          for (int b = 0; b < F.G; ++b) { const int bi = (rb % 8 == 0) ? (b + F.G - rb) % F.G : b; const bool cv = (b >= rb) && (bi >= ri); if (cv) { if (b < bx) ++jc; ++nconv; } }
          if (conv) convert_set2(F, A, jc * NWAVES + F.wave, nconv * NWAVES); }
#endif
    } SEAM(4);
    if (IN(5)) { for (int u = F.vcu; u < 1280; u += F.G) retloc_unit(F, A, u); } SEAM(5);
    if (IN(6)) { const int rem6 = 640 % F.G; const bool light = (rem6 == 0) || (F.vcu >= rem6);
        if (light) scan_phase(F, A, (rem6 == 0) ? F.vcu : F.vcu - rem6, (rem6 == 0) ? F.G : F.G - rem6);
        for (int u = F.vcu; u < 640; u += F.G) attn_unit(F, A, u); } SEAM(6);
    if (IN(7)) { for (int u = F.vcu; u < 1280; u += F.G) retout_unit(F, A, u); __syncthreads(); } SEAM(7);
    if (IN(8)) { { pg8::Gemm g{A_MIX, A_WOUT, NPR, D, D, D, 0}; pg8::StaticOrder S; S.init(NPR, D, F.G, bx); pg8::EpiRes<true> E{nullptr, A_HB, A_HB, nullptr, D, 1.0f, nullptr};
          pg8::gemm_phase<pg8::EpiRes<true>, pg8::StaticOrder, true, true>(F.lds + RING_OFF, g, S, E); }
        __syncthreads();
        { pg8::Gemm g{A_MIX + (size_t)NPR * D, A_WOUT, NTOK - NPR, D, D, D, ((D / 64 / 2 + 1) & ~1)}; pg8::SplitKOrder S; S.init(D, F.G, bx); pg8::EpiRes<true> E{nullptr, A_HB + (size_t)NPR * D, A_HB + (size_t)NPR * D, A_SB, D, 1.0f, nullptr};
          pg8::gemm_phase<pg8::EpiRes<true>, pg8::SplitKOrder, true, true>(F.lds + RING_OFF, g, S, E); } } SEAM(8);
    if (IN(9)) { rstd_phase(F, A, true, nullptr, (unsigned char*)A_ZN); } SEAM(9);
    if (IN(10)) { { pg8::Gemm g{A_ZN, A_W2GU, NTOK, 2 * DFF, D / 2, D / 2, 0}; pg8::StaticOrder S; S.init(NTOK, 2 * DFF, F.G, bx); pg8::EpiSwiGLU<true, true> E{A_HID, DFF, A_RSTD, A_CS2G, A_CS2U};
        pg8::gemm_phase<pg8::EpiSwiGLU<true, true>, pg8::StaticOrder, true, true, false, false, true>(F.lds + RING_OFF, g, S, E); }
        __syncthreads();
        { const int nwg10 = (NTOK / 256) * (2 * DFF / 256), rem = nwg10 % F.G; const bool conv = (rem == 0) || (bx >= rem); const int jc = (rem == 0) ? bx : bx - rem, nconv = (rem == 0) ? F.G : F.G - rem;
          if (conv) convert_set4(F, A, jc * NWAVES + F.wave, nconv * NWAVES); }
        if (((NTOK / 256) * (2 * DFF / 256)) % F.G == 0) {
          __syncthreads(); int kple = PLE; asm volatile("" : "+s"(kple));
          pg8::Gemm g{A_PB, A_WPP, NTOK, D, kple, kple, 0}; pg8::StaticOrder S; S.init(NTOK, D, F.G, bx); pg8::EpiBf16 E{A_TP, D, nullptr};
          pg8::gemm_phase<pg8::EpiBf16, pg8::StaticOrder, true, true>(F.lds + RING_OFF, g, S, E); }
    } SEAM(10);
    if (IN(11)) { constexpr float DS = 0.5f / (pg8::F8_HSCALE * pg8::F8_WSCALE);
        pg8::Gemm g{A_HID, A_W2D, NTOK, D, DFF / 2, DFF / 2, 0}; pg8::HalfOrder S; S.init(2 * NTOK, D, F.G, bx); pg8::EpiRes<true> E{nullptr, A_HB, A_HB, nullptr, D, DS, nullptr};
        pg8::gemm_phase_f8mh<pg8::EpiRes<true>, pg8::HalfOrder>(F.lds + RING_OFF, g, S, E); } SEAM(11);
    if (IN(12)) { rstd_phase(F, A, false, nullptr, (unsigned char*)A_ZN); } SEAM(12);
    if (IN(13)) {
        pg8::Gemm g{A_ZN, A_WPG, NTOK, D, D / 2, D / 2, 0}; pg8::TailHalfOrder S; S.init(NTOK, D, F.G, bx); pg8::EpiPLE<true> E{A_HB, A_out, A_TP, D, A_RSTD, 1.0f, A_CSPG};
        pg8::gemm_phase<pg8::EpiPLE<true>, pg8::TailHalfOrder, true, true, false, false, true>(F.lds + RING_OFF, g, S, E); }
#undef IN
#undef SEAM
}

extern "C" void kernel_launch(void* const* d_in, const int* in_sizes, int n_in, void* d_out, int out_size, void* d_ws, size_t ws_size, hipStream_t stream) {
    static int grid = 0;
    if (grid == 0) {
        if (n_in != 25 || (size_t)out_size != O_END || ws_size < WS_END) { fprintf(stderr, "kernel_launch: unexpected shapes (n_in %d, out %d, ws %zu); nothing launched\n", n_in, out_size, ws_size); grid = -1; return; }
        int dev = 0, cus = 0, per_cu = 0;
        if (hipGetDevice(&dev) != hipSuccess || hipDeviceGetAttribute(&cus, hipDeviceAttributeMultiprocessorCount, dev) != hipSuccess) { grid = -1; return; }
        if (hipFuncSetAttribute((const void*)fwd, hipFuncAttributeMaxDynamicSharedMemorySize, LDS_BYTES) != hipSuccess) { fprintf(stderr, "kernel_launch: hipFuncSetAttribute failed\n"); grid = -1; return; }
        if (hipOccupancyMaxActiveBlocksPerMultiprocessor(&per_cu, (const void*)fwd, NWAVES * 64, LDS_BYTES) != hipSuccess || per_cu < 1) { fprintf(stderr, "kernel_launch: occupancy query reports %d\n", per_cu); }
        (void)hipGetLastError();
        grid = cus;
    }
    if (grid < 0) return;
    if (hipMemsetAsync((char*)d_ws + WS_CTL, 0, CTL_ZERO_BYTES, stream) != hipSuccess) return;
    Args a{};
    for (int i = 0; i < 25; ++i) a.in[i] = (const float*)d_in[i];
    a.out = (float*)d_out; a.ws = (unsigned char*)d_ws;
#if MK_ONE_LAUNCH
    a.ph_lo = 0; a.ph_hi = N_PHASES;
    hipLaunchKernelGGL(fwd, dim3(grid), dim3(NWAVES * 64), LDS_BYTES, stream, a);
#else
    for (int p = 0; p < N_PHASES; ++p) { a.ph_lo = p; a.ph_hi = p + 1; hipLaunchKernelGGL(fwd, dim3(grid), dim3(NWAVES * 64), LDS_BYTES, stream, a); }
#endif
}
```
